# Optimizing an MI355X kernel written in HIP

```python
import jax, jax.numpy as jnp
from jax import lax
import numpy as np

D_MODEL = 1024
BATCH = 32
SEQ = 2048
DEPTH = 1
DEC_BATCH = 4
DEC_SEQ = 4096
PAST_LEN = 128

GRID_W = 64
N_ATTN_HEADS = 8
HEAD_DIM = 64
D_ATTN = N_ATTN_HEADS * HEAD_DIM
D_CONV = D_MODEL - D_ATTN
N_CONV_GROUPS = 8
CONV_WIDTH = 3
NA_ROWS = 8
NA_COLS = 16
D_FF = 2816
D_IN = 3 * D_ATTN + 3 * D_CONV
EPS = 1e-6

kernel_name = "hymba_natten_shortconv_macaron_encoder"


def rms_norm(x, g):
    xf = x.astype(jnp.float32)
    y = xf * lax.rsqrt(jnp.mean(xf * xf, axis=-1, keepdims=True) + EPS)
    return (y * g.astype(jnp.float32)).astype(x.dtype)


def swiglu(x, w_gate, w_up, w_down):
    return (jax.nn.silu(x @ w_gate) * (x @ w_up)) @ w_down


def neighborhood_attention(q, k, v, rpb):
    b, s, h, dh = q.shape
    rows = s // GRID_W
    kh = min(NA_ROWS, rows)
    kw = NA_COLS
    qg = q.reshape(b, rows, GRID_W, h, dh)
    kg = k.reshape(b, rows, GRID_W, h, dh)
    vg = v.reshape(b, rows, GRID_W, h, dh)
    cols = jnp.arange(GRID_W)
    col_start = jnp.clip(cols - kw // 2, 0, GRID_W - kw)
    col_idx = col_start[:, None] + jnp.arange(kw)[None, :]
    col_off = col_idx - cols[:, None]
    bias_cols = rpb[:, :, col_off + NA_COLS - 1]
    scale = HEAD_DIM ** -0.5

    def one_row(r):
        rs = jnp.clip(r - kh // 2, 0, rows - kh)
        q_r = lax.dynamic_index_in_dim(qg, r, axis=1, keepdims=False)
        k_blk = lax.dynamic_slice_in_dim(kg, rs, kh, axis=1)
        v_blk = lax.dynamic_slice_in_dim(vg, rs, kh, axis=1)
        k_win = k_blk[:, :, col_idx]
        v_win = v_blk[:, :, col_idx]
        row_off = rs + jnp.arange(kh) - r
        bias = jnp.transpose(bias_cols[:, row_off + NA_ROWS - 1], (0, 2, 1, 3))
        sc = jnp.einsum('bchd,bicjhd->bhcij', q_r, k_win).astype(jnp.float32) * scale
        sc = sc + bias[None].astype(jnp.float32)
        p = jax.nn.softmax(sc.reshape(b, h, GRID_W, kh * kw), axis=-1)
        p = p.reshape(b, h, GRID_W, kh, kw).astype(v.dtype)
        return jnp.einsum('bhcij,bicjhd->bchd', p, v_win)

    out = lax.map(one_row, jnp.arange(rows))
    return jnp.transpose(out, (1, 0, 2, 3, 4)).reshape(b, s, h, dh)


def short_gated_conv(gb, gc, xin, conv_w):
    s = xin.shape[1]
    u = gc * xin
    half = CONV_WIDTH // 2
    up = jnp.pad(u, ((0, 0), (half, CONV_WIDTH - 1 - half), (0, 0)))
    y = up[:, 0:s] * conv_w[0]
    for j in range(1, CONV_WIDTH):
        y = y + up[:, j:j + s] * conv_w[j]
    return gb * y


def encoder_layer(x, ffn1_norm, ffn1_w_gate, ffn1_w_up, ffn1_w_down, mix_norm, w_in,
                  q_norm, k_norm, rel_pos_bias, conv_w, attn_out_norm, conv_out_norm, w_out,
                  ffn2_norm, ffn2_w_gate, ffn2_w_up, ffn2_w_down, final_norm):
    b, s, _ = x.shape
    h = x + 0.5 * swiglu(rms_norm(x, ffn1_norm), ffn1_w_gate, ffn1_w_up, ffn1_w_down)
    u = rms_norm(h, mix_norm)
    z = u @ w_in
    q, k, v, gb, gc, xin = jnp.split(
        z, [D_ATTN, 2 * D_ATTN, 3 * D_ATTN, 3 * D_ATTN + D_CONV, 3 * D_ATTN + 2 * D_CONV], axis=-1)
    q = rms_norm(q.reshape(b, s, N_ATTN_HEADS, HEAD_DIM), q_norm)
    k = rms_norm(k.reshape(b, s, N_ATTN_HEADS, HEAD_DIM), k_norm)
    v = v.reshape(b, s, N_ATTN_HEADS, HEAD_DIM)
    a = neighborhood_attention(q, k, v, rel_pos_bias)
    a = rms_norm(a, attn_out_norm.reshape(N_ATTN_HEADS, HEAD_DIM)).reshape(b, s, D_ATTN)
    c = short_gated_conv(gb, gc, xin, conv_w)
    gdim = D_CONV // N_CONV_GROUPS
    c = rms_norm(c.reshape(b, s, N_CONV_GROUPS, gdim),
                 conv_out_norm.reshape(N_CONV_GROUPS, gdim)).reshape(b, s, D_CONV)
    h = h + jnp.concatenate([a, c], axis=-1) @ w_out
    h = h + 0.5 * swiglu(rms_norm(h, ffn2_norm), ffn2_w_gate, ffn2_w_up, ffn2_w_down)
    return rms_norm(h, final_norm)


def setup_inputs(seed: int = 0) -> dict:
    key = jax.random.key(seed)
    ks = jax.random.split(key, 24)

    def w(k, shape, fan_in):
        return jax.random.normal(k, shape, jnp.float32) * (fan_in ** -0.5)

    def gain(k, shape):
        return 1.0 + 0.02 * jax.random.normal(k, shape, jnp.float32)

    L = DEPTH
    return {
        "x_prompt": jax.random.normal(ks[0], (BATCH, SEQ, D_MODEL), jnp.float32),
        "x_sample": jax.random.normal(ks[1], (DEC_BATCH, DEC_SEQ, D_MODEL), jnp.float32),
        "ffn1_norm": gain(ks[2], (L, D_MODEL)),
        "ffn1_w_gate": w(ks[3], (L, D_MODEL, D_FF), D_MODEL),
        "ffn1_w_up": w(ks[4], (L, D_MODEL, D_FF), D_MODEL),
        "ffn1_w_down": w(ks[5], (L, D_FF, D_MODEL), D_FF),
        "mix_norm": gain(ks[6], (L, D_MODEL)),
        "w_in": w(ks[7], (L, D_MODEL, D_IN), D_MODEL),
        "q_norm": gain(ks[8], (L, HEAD_DIM)),
        "k_norm": gain(ks[9], (L, HEAD_DIM)),
        "rel_pos_bias": 0.1 * jax.random.normal(ks[10], (L, N_ATTN_HEADS, 2 * NA_ROWS - 1, 2 * NA_COLS - 1), jnp.float32),
        "conv_w": w(ks[11], (L, CONV_WIDTH, D_CONV), CONV_WIDTH),
        "attn_out_norm": gain(ks[12], (L, D_ATTN)),
        "conv_out_norm": gain(ks[13], (L, D_CONV)),
        "w_out": w(ks[14], (L, D_MODEL, D_MODEL), D_MODEL),
        "ffn2_norm": gain(ks[15], (L, D_MODEL)),
        "ffn2_w_gate": w(ks[16], (L, D_MODEL, D_FF), D_MODEL),
        "ffn2_w_up": w(ks[17], (L, D_MODEL, D_FF), D_MODEL),
        "ffn2_w_down": w(ks[18], (L, D_FF, D_MODEL), D_FF),
        "final_norm": gain(ks[19], (L, D_MODEL)),
    }


def reference(x_prompt, x_sample, ffn1_norm, ffn1_w_gate, ffn1_w_up, ffn1_w_down, mix_norm, w_in,
              q_norm, k_norm, rel_pos_bias, conv_w, attn_out_norm, conv_out_norm, w_out,
              ffn2_norm, ffn2_w_gate, ffn2_w_up, ffn2_w_down, final_norm):
    y_prompt = x_prompt
    y_sample = x_sample
    for l in range(DEPTH):
        p = (ffn1_norm[l], ffn1_w_gate[l], ffn1_w_up[l], ffn1_w_down[l], mix_norm[l], w_in[l],
             q_norm[l], k_norm[l], rel_pos_bias[l], conv_w[l], attn_out_norm[l], conv_out_norm[l], w_out[l],
             ffn2_norm[l], ffn2_w_gate[l], ffn2_w_up[l], ffn2_w_down[l], final_norm[l])
        y_prompt = encoder_layer(y_prompt, *p)
        y_sample = encoder_layer(y_sample, *p)
    return (y_prompt, y_sample)
```

```cpp
#include <hip/hip_runtime.h>
#include <hip/hip_cooperative_groups.h>
#include <cstdio>
#include <cstdint>
#include <cmath>
namespace cg = cooperative_groups;
namespace pg8 {
#define PG8_LAS __attribute__((address_space(3)))
typedef unsigned short bf16_t;
typedef short bf16x8 __attribute__((ext_vector_type(8)));
typedef float f32x4 __attribute__((ext_vector_type(4)));
typedef unsigned u32x4 __attribute__((ext_vector_type(4)));
constexpr int BM = 256, BK = 64, HALF = 128, HTB = HALF * BK * 2  , STAGE_BYTES = 8 * HTB, NXCD = 8, WGM = 8;

__host__ __device__ __forceinline__ int lds_byte(int r, int c) { const int st = (r >> 4) * 2 + (c >> 5), rr = r & 15, cc = c & 31, ob = rr * 64 + cc * 2; return st * 1024 + (ob ^ (((ob >> 9) & 1) << 5)); }
__host__ __device__ __forceinline__ void stage_rc(int b, int& R, int& C) { const int st = b / 1024, sb = b % 1024, swz = sb ^ (((sb >> 9) & 1) << 5); R = (st >> 1) * 16 + swz / 64; C = (st & 1) * 32 + (swz % 64) / 2; }
__host__ __device__ __forceinline__ int perm32(int rho) { const int n = rho >> 4, i = rho & 15; return 8 * (i >> 2) + 4 * n + (i & 3); }

struct Unit { int pm, pn; };
struct Gemm { const bf16_t* A; const bf16_t* Bt; int M, N, K, wid; };

struct StaticOrder {
    int nM, nN, nwg, G, c;
    __host__ __device__ void init(int M, int N, int G_, int c_) { nM = M / BM; nN = N / BM; nwg = nM * nN; G = G_; c = c_; }
    __host__ __device__ bool next(int i, Unit& u) const {
        const long L = (long)i * G + c; if (L >= nwg) return false;
        int wgid = (int)L; { const int q = nwg / NXCD, r = nwg % NXCD, xcd = wgid % NXCD, off = wgid / NXCD; wgid = (xcd < r ? xcd * (q + 1) : r * (q + 1) + (xcd - r) * q) + off; }
        const int nig = WGM * nN, gid = wgid / nig, fm = gid * WGM, gsz = (nM - fm) < WGM ? (nM - fm) : WGM;
        u.pm = fm + ((wgid % nig) % gsz); u.pn = (wgid % nig) / gsz; return true;
    }
    __device__ __forceinline__ void a_ready(const Unit&) const {}
    __device__ __forceinline__ void done(const Unit&) const {}
};
struct RevOrder : StaticOrder {
    __host__ __device__ bool next(int i, Unit& u) const { if (!StaticOrder::next(i, u)) return false; if (nM == 320) u.pm = 40 * (u.pm / 40) + 39 - (u.pm % 40); return true; }
};
__device__ __forceinline__ unsigned cvt_pk_bf16(float lo, float hi) { unsigned r; asm volatile("v_cvt_pk_bf16_f32 %0, %1, %2" : "=v"(r) : "v"(lo), "v"(hi)); return r; }
typedef float f32x2 __attribute__((ext_vector_type(2)));
constexpr float RMS_EPS = 1e-6f;
typedef unsigned u32x2 __attribute__((ext_vector_type(2)));
__device__ __forceinline__ float row_rstd16(const float* ssrow) {
    const f32x4 a = *(const f32x4*)(ssrow), b = *(const f32x4*)(ssrow + 4), c = *(const f32x4*)(ssrow + 8), d = *(const f32x4*)(ssrow + 12);
    const float s = ((a[0] + a[1]) + (a[2] + a[3])) + ((b[0] + b[1]) + (b[2] + b[3])) + ((c[0] + c[1]) + (c[2] + c[3])) + ((d[0] + d[1]) + (d[2] + d[3]));
    return 1.0f / sqrtf(s * (1.0f / 1024.0f) + RMS_EPS);
}
__device__ __forceinline__ float row_rstd16_coop(const float* ssrow, int fq) {
    const f32x4 a = *(const f32x4*)(ssrow + 4 * fq);
    float s = (a[0] + a[1]) + (a[2] + a[3]);
    s += __shfl_xor(s, 16); s += __shfl_xor(s, 32);
    return 1.0f / sqrtf(s * (1.0f / 1024.0f) + RMS_EPS);
}
__device__ __forceinline__ float silu_mul(float g, float u) { return g * u * __builtin_amdgcn_rcpf(1.0f + __builtin_amdgcn_exp2f(-1.4426950408889634f * g)); }

template <bool HAS_RSTD> struct EpiSwiGLU {
    static constexpr bool PERM = true, AFTER_DRAIN = false;
    bf16_t* O; int ldc; const float* ss;
    __device__ __forceinline__ void operator()(const f32x4 (&acc)[2][2][4][2], const Unit& u, int wr, int wc, int fr, int fq) const {
        const int row0 = u.pm * BM + wr * 64 + fr, col0 = u.pn * HALF + wc * 32 + 8 * fq;
        float rsv[8];
#pragma unroll
        for (int i = 0; i < 8; ++i) rsv[i] = HAS_RSTD ? row_rstd16_coop(ss + (size_t)(row0 + (i >> 2) * HALF + (i & 3) * 16) * 16, fq) : 1.0f;
#pragma unroll
        for (int ai = 0; ai < 2; ++ai)
#pragma unroll
            for (int m = 0; m < 4; ++m) {
                const int row = row0 + ai * HALF + m * 16;
                const float rs = rsv[ai * 4 + m];
                const f32x4 g0 = acc[ai][0][m][0] * rs, g1 = acc[ai][0][m][1] * rs, u0 = acc[ai][1][m][0] * rs, u1 = acc[ai][1][m][1] * rs;
                u32x4 w;
                w.x = cvt_pk_bf16(silu_mul(g0[0], u0[0]), silu_mul(g0[1], u0[1])); w.y = cvt_pk_bf16(silu_mul(g0[2], u0[2]), silu_mul(g0[3], u0[3]));
                w.z = cvt_pk_bf16(silu_mul(g1[0], u1[0]), silu_mul(g1[1], u1[1])); w.w = cvt_pk_bf16(silu_mul(g1[2], u1[2]), silu_mul(g1[3], u1[3]));
                *(u32x4*)(O + (size_t)row * ldc + col0) = w;
            }
    }
};

__device__ __forceinline__ u32x4 xchg8(u32x4 v) {
    u32x4 r;
    r.x = (unsigned)__builtin_amdgcn_update_dpp(0, (int)v.x, 0x128, 0xf, 0xf, false); r.y = (unsigned)__builtin_amdgcn_update_dpp(0, (int)v.y, 0x128, 0xf, 0xf, false);
    r.z = (unsigned)__builtin_amdgcn_update_dpp(0, (int)v.z, 0x128, 0xf, 0xf, false); r.w = (unsigned)__builtin_amdgcn_update_dpp(0, (int)v.w, 0x128, 0xf, 0xf, false);
    return r;
}
__device__ __forceinline__ void store_rows16(bf16_t* base, int ld, u32x4 w0, u32x4 w1, int fr, int fq) {
    const bool hi = (fr & 8) != 0;
    const u32x4 rcv = xchg8(hi ? w0 : w1);
    bf16_t* p = base + (size_t)(fr & 7) * ld + (hi ? 32 : 0) + 8 * fq;
    *(u32x4*)p = hi ? rcv : w0; *(u32x4*)(p + (size_t)8 * ld) = hi ? w1 : rcv;
}
__device__ __forceinline__ void load_rows16_issue(const bf16_t* base, int ld, int fr, int fq, u32x4& la, u32x4& lb) {
    const bf16_t* p = base + (size_t)(fr & 7) * ld + ((fr & 8) ? 32 : 0) + 8 * fq;
    la = *(const u32x4*)p; lb = *(const u32x4*)(p + (size_t)8 * ld);
}
__device__ __forceinline__ void load_rows16_finish(u32x4 la, u32x4 lb, int fr, u32x4& r0, u32x4& r1) {
    const bool hi = (fr & 8) != 0;
    const u32x4 rcv = xchg8(hi ? la : lb);
    r0 = hi ? rcv : la; r1 = hi ? lb : rcv;
}

template <int RES_MODE, bool WRITE_SS> struct EpiResid {
    static constexpr bool PERM = true, AFTER_DRAIN = false;
    const float* g; const float* rstd0;
    bf16_t* xb; float* ss; float alpha;
    __device__ __forceinline__ void operator()(const f32x4 (&acc)[2][2][4][2], const Unit& u, int wr, int wc, int fr, int fq) const {
        const int rowg = u.pm * BM + wr * 64, colw = u.pn * BM + wc * 64;
        f32x4 gi[2][2]; float ri[8];
        if (RES_MODE == 2) {
#pragma unroll
            for (int bj = 0; bj < 2; ++bj)
#pragma unroll
                for (int n = 0; n < 2; ++n) { const f32x4 gv = *(const f32x4*)(g + colw + 32 * bj + 8 * fq + 4 * n); gi[bj][n] = (f32x4){1.0f / gv[0], 1.0f / gv[1], 1.0f / gv[2], 1.0f / gv[3]}; }
#pragma unroll
            for (int i = 0; i < 8; ++i) ri[i] = 1.0f / rstd0[rowg + (i >> 2) * HALF + (i & 3) * 16 + fr];
        }
        bf16_t* xw = xb + (size_t)rowg * 1024 + colw;
        u32x4 la[2][4], lb[2][4];
#pragma unroll
        for (int ai = 0; ai < 2; ++ai)
#pragma unroll
            for (int m = 0; m < 4; ++m) load_rows16_issue(xw + (size_t)(ai * HALF + m * 16) * 1024, 1024, fr, fq, la[ai][m], lb[ai][m]);
#pragma unroll
        for (int ai = 0; ai < 2; ++ai)
#pragma unroll
            for (int m = 0; m < 4; ++m) {
                u32x4 q[2]; load_rows16_finish(la[ai][m], lb[ai][m], fr, q[0], q[1]);
                u32x4 w[2]; float s = 0.f;
#pragma unroll
                for (int bj = 0; bj < 2; ++bj) {
                    f32x4 r0 = (f32x4){__builtin_bit_cast(float, q[bj].x << 16), __builtin_bit_cast(float, q[bj].x & 0xffff0000u), __builtin_bit_cast(float, q[bj].y << 16), __builtin_bit_cast(float, q[bj].y & 0xffff0000u)};
                    f32x4 r1 = (f32x4){__builtin_bit_cast(float, q[bj].z << 16), __builtin_bit_cast(float, q[bj].z & 0xffff0000u), __builtin_bit_cast(float, q[bj].w << 16), __builtin_bit_cast(float, q[bj].w & 0xffff0000u)};
                    if (RES_MODE == 2) { r0 = r0 * gi[bj][0] * ri[ai * 4 + m]; r1 = r1 * gi[bj][1] * ri[ai * 4 + m]; }
                    const f32x4 v0 = r0 + acc[ai][bj][m][0] * alpha, v1 = r1 + acc[ai][bj][m][1] * alpha;
                    w[bj].x = cvt_pk_bf16(v0[0], v0[1]); w[bj].y = cvt_pk_bf16(v0[2], v0[3]); w[bj].z = cvt_pk_bf16(v1[0], v1[1]); w[bj].w = cvt_pk_bf16(v1[2], v1[3]);
                    if (WRITE_SS) s += (v0[0] * v0[0] + v0[1] * v0[1]) + (v0[2] * v0[2] + v0[3] * v0[3]) + (v1[0] * v1[0] + v1[1] * v1[1]) + (v1[2] * v1[2] + v1[3] * v1[3]);
                }
                store_rows16(xw + (size_t)(ai * HALF + m * 16) * 1024, 1024, w[0], w[1], fr, fq);
                if (WRITE_SS) { s += __shfl_xor(s, 16); s += __shfl_xor(s, 32); if (fq == 0) ss[(size_t)(rowg + ai * HALF + m * 16 + fr) * 16 + u.pn * 4 + wc] = s; }
            }
    }
};

struct EpiWin {
    static constexpr bool PERM = true, AFTER_DRAIN = false;
    const float* ss; bf16_t *ZQ, *ZK, *VT, *ZC; const float *qg, *kg;
    __device__ __forceinline__ void operator()(const f32x4 (&acc)[2][2][4][2], const Unit& u, int wr, int wc, int fr, int fq) const {
        const int row0 = u.pm * BM + wr * 64 + fr, pn = u.pn;
        float rsv[8];
#pragma unroll
        for (int i = 0; i < 8; ++i) rsv[i] = row_rstd16_coop(ss + (size_t)(row0 + (i >> 2) * HALF + (i & 3) * 16) * 16, fq);
        if (pn < 4) {
            const bool isq = pn < 2; const float* gp = (isq ? qg : kg) + 8 * fq; const float gs = isq ? 0.125f * 1.4426950408889634f : 1.0f;
            f32x4 gn[2][2];
#pragma unroll
            for (int bj = 0; bj < 2; ++bj)
#pragma unroll
                for (int n = 0; n < 2; ++n) gn[bj][n] = *(const f32x4*)(gp + 32 * bj + 4 * n) * gs;
            bf16_t* Z = (isq ? ZQ : ZK) + (pn & 1) * 256 + wc * 64 + (size_t)(u.pm * BM + wr * 64) * 512;
#pragma unroll
            for (int ai = 0; ai < 2; ++ai)
#pragma unroll
                for (int m = 0; m < 4; ++m) {
                    const int row = row0 + ai * HALF + m * 16; const float rs = rsv[ai * 4 + m];
                    f32x4 v[2][2]; float s = 0.f;
#pragma unroll
                    for (int bj = 0; bj < 2; ++bj)
#pragma unroll
                        for (int n = 0; n < 2; ++n) { v[bj][n] = acc[ai][bj][m][n] * rs; const f32x4 x = v[bj][n]; s += (x[0] * x[0] + x[1] * x[1]) + (x[2] * x[2] + x[3] * x[3]); }
                    s += __shfl_xor(s, 16); s += __shfl_xor(s, 32);
                    const float rn = 1.0f / sqrtf(s * (1.0f / 64.0f) + RMS_EPS);
                    u32x4 w[2];
#pragma unroll
                    for (int bj = 0; bj < 2; ++bj) {
                        const f32x4 a = v[bj][0] * gn[bj][0] * rn, b = v[bj][1] * gn[bj][1] * rn;
                        w[bj].x = cvt_pk_bf16(a[0], a[1]); w[bj].y = cvt_pk_bf16(a[2], a[3]); w[bj].z = cvt_pk_bf16(b[0], b[1]); w[bj].w = cvt_pk_bf16(b[2], b[3]);
                    }
                    store_rows16(Z + (size_t)(ai * HALF + m * 16) * 512, 512, w[0], w[1], fr, fq);
                }
        } else if (pn < 6) {
            const int rowt = u.pm * BM; const int S = (rowt < 65536) ? 2048 : 4096; const int h = 4 * (pn - 4) + wc;
#pragma unroll
            for (int ai = 0; ai < 2; ++ai)
#pragma unroll
                for (int m = 0; m < 4; ++m) {
                    const int row = row0 + ai * HALF + m * 16; const float rs = rsv[ai * 4 + m];
                    const int t = row & (S - 1); bf16_t* vp = VT + (size_t)(row - t) * 512 + (size_t)(h * 64 + 8 * fq) * S + t;
#pragma unroll
                    for (int bj = 0; bj < 2; ++bj)
#pragma unroll
                        for (int n = 0; n < 2; ++n) {
                            const f32x4 x = acc[ai][bj][m][n] * rs; const unsigned p0 = cvt_pk_bf16(x[0], x[1]), p1 = cvt_pk_bf16(x[2], x[3]);
                            bf16_t* q = vp + (size_t)(32 * bj + 4 * n) * S;
                            q[0] = (bf16_t)(p0 & 0xffffu); q[(size_t)S] = (bf16_t)(p0 >> 16); q[(size_t)2 * S] = (bf16_t)(p1 & 0xffffu); q[(size_t)3 * S] = (bf16_t)(p1 >> 16);
                        }
                }
        } else if (pn < 8) {
            bf16_t* Z = ZC + (pn - 6) * 256 + wc * 64 + (size_t)(u.pm * BM + wr * 64) * 1024;
#pragma unroll
            for (int ai = 0; ai < 2; ++ai)
#pragma unroll
                for (int m = 0; m < 4; ++m) {
                    const float rs = rsv[ai * 4 + m];
                    u32x4 w[2];
#pragma unroll
                    for (int bj = 0; bj < 2; ++bj) {
                        const f32x4 a = acc[ai][bj][m][0] * rs, b = acc[ai][bj][m][1] * rs;
                        w[bj].x = cvt_pk_bf16(a[0], a[1]); w[bj].y = cvt_pk_bf16(a[2], a[3]); w[bj].z = cvt_pk_bf16(b[0], b[1]); w[bj].w = cvt_pk_bf16(b[2], b[3]);
                    }
                    store_rows16(Z + (size_t)(ai * HALF + m * 16) * 1024, 1024, w[0], w[1], fr, fq);
                }
        } else {
            bf16_t* Z = ZC + 512 + (pn - 8) * 128 + wc * 32 + 8 * fq + (size_t)row0 * 1024;
#pragma unroll
            for (int ai = 0; ai < 2; ++ai)
#pragma unroll
                for (int m = 0; m < 4; ++m) {
                    const float rs = rsv[ai * 4 + m], rs2 = rs * rs;
                    const f32x4 a = acc[ai][0][m][0] * acc[ai][1][m][0] * rs2, b = acc[ai][0][m][1] * acc[ai][1][m][1] * rs2;
                    u32x4 w; w.x = cvt_pk_bf16(a[0], a[1]); w.y = cvt_pk_bf16(a[2], a[3]); w.z = cvt_pk_bf16(b[0], b[1]); w.w = cvt_pk_bf16(b[2], b[3]);
                    *(u32x4*)(Z + (size_t)(ai * HALF + m * 16) * 1024) = w;
                }
        }
    }
};

template <class Epi, class Sched, bool ALIGN_EPI = false, bool SP2 = false>
__device__ __forceinline__ void gemm_phase(PG8_LAS unsigned char* lds, const Gemm g, const Sched& S, const Epi& E) {
    const int wid = g.wid, lane = (int)__builtin_amdgcn_mbcnt_hi(~0u, __builtin_amdgcn_mbcnt_lo(~0u, 0u)), tid = wid * 64 + lane, wr = wid >> 2, wc = wid & 3, fr = lane & 15, fq = lane >> 4;
    const int K = g.K, nt = K / BK;
    unsigned voffA[2], voffB[2];
#pragma unroll
    for (int i = 0; i < 2; ++i) { int R, C; stage_rc(tid * 16 + i * 8192, R, C); const int Rb = Epi::PERM ? ((R & ~31) + perm32(R & 31)) : R;
        voffA[i] = (unsigned)(R * K + C) * 2u; voffB[i] = (unsigned)(Rb * K + C) * 2u; }
    const size_t kstep = (size_t)(BK * 2);
    const size_t hstep = (size_t)HALF * K * 2;
    const size_t tstep = 2 * hstep;
    const unsigned ldsw = (unsigned)wid * 1024u;
    const int aoff = lds_byte(wr * 64 + fr, fq * 8), boff = lds_byte(wc * 32 + fr, fq * 8);
#define PG8_SA(b, h) (((b) * 2 + (h)) * HTB)
#define PG8_SB(b, h) ((4 + (b) * 2 + (h)) * HTB)
#define PG8_STAGE(bufoff, gbase, voff) do { _Pragma("unroll") for (int _i = 0; _i < 2; ++_i) \
        __builtin_amdgcn_global_load_lds((const unsigned*)((const char*)(gbase) + (voff)[_i]), (PG8_LAS unsigned*)(lds + (bufoff) + ldsw + _i * 8192), 16, 0, 0); } while (0)
#define PG8_LDA(dst, b, h) do { _Pragma("unroll") for (int m = 0; m < 4; ++m) _Pragma("unroll") for (int k = 0; k < 2; ++k) dst[m][k] = *(const PG8_LAS bf16x8*)(lds + PG8_SA(b, h) + aoff + m * 2048 + k * 1024); } while (0)
#define PG8_LDB(dst, b, h) do { _Pragma("unroll") for (int n = 0; n < 2; ++n) _Pragma("unroll") for (int k = 0; k < 2; ++k) dst[n][k] = *(const PG8_LAS bf16x8*)(lds + PG8_SB(b, h) + boff + n * 2048 + k * 1024); } while (0)
#define PG8_MMA(ai, bj, At, Bt) do { __builtin_amdgcn_s_setprio(1); _Pragma("unroll") for (int m = 0; m < 4; ++m) _Pragma("unroll") for (int n = 0; n < 2; ++n) _Pragma("unroll") for (int k = 0; k < 2; ++k) \
        acc[ai][bj][m][n] = __builtin_amdgcn_mfma_f32_16x16x32_bf16(Bt[n][k], At[m][k], acc[ai][bj][m][n], 0, 0, 0); __builtin_amdgcn_s_setprio(0); } while (0)
#define PG8_WAIT_V(n) asm volatile("s_waitcnt vmcnt(" #n ")" ::: "memory")
#define PG8_WAIT_L(n) asm volatile("s_waitcnt lgkmcnt(" #n ")" ::: "memory")
#define PG8_BAR __builtin_amdgcn_s_barrier()
#define PG8_SCHED __builtin_amdgcn_sched_barrier(0)
    Unit cur, nxt; int ui = 0;
    if (!S.next(0, cur)) return;
    f32x4 acc[2][2][4][2];
#pragma unroll
    for (int a = 0; a < 2; ++a)
#pragma unroll
        for (int b = 0; b < 2; ++b)
#pragma unroll
            for (int m = 0; m < 4; ++m)
#pragma unroll
                for (int n = 0; n < 2; ++n) acc[a][b][m][n] = (f32x4){0.f, 0.f, 0.f, 0.f};
    bf16x8 At[4][2], B0[2][2], B1[2][2];
    const char* cA = (const char*)g.A + (size_t)cur.pm * tstep; const char* cB = (const char*)g.Bt + (size_t)cur.pn * tstep;
    S.a_ready(cur);
    if constexpr (SP2) {
        PG8_STAGE(PG8_SB(0, 0), cB, voffB); PG8_STAGE(PG8_SB(0, 1), cB + hstep, voffB); PG8_STAGE(PG8_SA(0, 0), cA, voffA); PG8_STAGE(PG8_SA(0, 1), cA + hstep, voffA);
        if (wr == 1) PG8_BAR;
        PG8_WAIT_V(2); PG8_BAR;
        PG8_STAGE(PG8_SB(1, 0), cB + kstep, voffB); PG8_STAGE(PG8_SA(1, 0), cA + kstep, voffA); PG8_STAGE(PG8_SB(1, 1), cB + hstep + kstep, voffB);
        PG8_WAIT_V(6); PG8_BAR;
    } else {
        PG8_STAGE(PG8_SB(0, 0), cB, voffB); PG8_STAGE(PG8_SA(0, 0), cA, voffA); PG8_STAGE(PG8_SB(0, 1), cB + hstep, voffB); PG8_STAGE(PG8_SA(0, 1), cA + hstep, voffA);
        if (wr == 1) PG8_BAR;
        PG8_WAIT_V(4); PG8_BAR;
        PG8_STAGE(PG8_SB(1, 0), cB + kstep, voffB); PG8_STAGE(PG8_SA(1, 0), cA + kstep, voffA); PG8_STAGE(PG8_SB(1, 1), cB + hstep + kstep, voffB);
        PG8_WAIT_V(6); PG8_BAR;
    }
    for (;;) {
        const bool has_next = S.next(ui + 1, nxt);
        const char* nA = has_next ? (const char*)g.A + (size_t)nxt.pm * tstep : cA; const char* nB = has_next ? (const char*)g.Bt + (size_t)nxt.pn * tstep : cB;
        for (int t = 0; t < nt; t += 2) {
            const bool last = (t == nt - 2);
            const char* a1 = cA + (size_t)(t + 1) * kstep;
            const char* a2 = last ? nA : cA + (size_t)(t + 2) * kstep; const char* b2 = last ? nB : cB + (size_t)(t + 2) * kstep;
            const char* a3 = a2 + kstep; const char* b3 = b2 + kstep;
            if (last && has_next) S.a_ready(nxt);
            if constexpr (SP2) {
            PG8_LDB(B0, 0, 0); PG8_LDB(B1, 0, 1); PG8_SCHED; PG8_LDA(At, 0, 0); PG8_STAGE(PG8_SA(1, 1), a1 + hstep, voffA);
            PG8_WAIT_V(8); PG8_WAIT_L(0); PG8_BAR; PG8_MMA(0, 0, At, B0); PG8_MMA(0, 1, At, B1); PG8_BAR; PG8_SCHED;
            PG8_LDA(At, 0, 1); PG8_STAGE(PG8_SB(0, 0), b2, voffB); PG8_STAGE(PG8_SB(0, 1), b2 + hstep, voffB); PG8_STAGE(PG8_SA(0, 0), a2, voffA);
            PG8_WAIT_V(8); PG8_WAIT_L(0); PG8_BAR; PG8_MMA(1, 0, At, B0); PG8_MMA(1, 1, At, B1); PG8_BAR; PG8_SCHED;
            PG8_LDB(B0, 1, 0); PG8_LDB(B1, 1, 1); PG8_SCHED; PG8_LDA(At, 1, 0); PG8_STAGE(PG8_SA(0, 1), a2 + hstep, voffA);
            PG8_WAIT_V(8); PG8_WAIT_L(0); PG8_BAR; PG8_MMA(0, 0, At, B0); PG8_MMA(0, 1, At, B1); PG8_BAR; PG8_SCHED;
            PG8_LDA(At, 1, 1); PG8_STAGE(PG8_SB(1, 0), b3, voffB); PG8_STAGE(PG8_SB(1, 1), b3 + hstep, voffB); PG8_STAGE(PG8_SA(1, 0), a3, voffA);
            PG8_WAIT_V(8); PG8_WAIT_L(0); PG8_BAR; PG8_MMA(1, 0, At, B0); PG8_MMA(1, 1, At, B1); PG8_BAR; PG8_SCHED;
            } else {
            PG8_LDB(B0, 0, 0); PG8_SCHED; PG8_LDA(At, 0, 0); PG8_STAGE(PG8_SA(1, 1), a1 + hstep, voffA);
            PG8_WAIT_L(8); PG8_BAR; PG8_WAIT_L(0); PG8_MMA(0, 0, At, B0); PG8_BAR; PG8_SCHED;
            PG8_LDB(B1, 0, 1); PG8_STAGE(PG8_SB(0, 0), b2, voffB);
            PG8_BAR; PG8_WAIT_L(0); PG8_MMA(0, 1, At, B1); PG8_BAR;
            PG8_LDA(At, 0, 1); PG8_STAGE(PG8_SA(0, 0), a2, voffA);
            PG8_BAR; PG8_WAIT_L(0); PG8_MMA(1, 0, At, B0); PG8_BAR; PG8_SCHED;
            PG8_STAGE(PG8_SB(0, 1), b2 + hstep, voffB);
            PG8_WAIT_V(6); PG8_BAR; PG8_MMA(1, 1, At, B1); PG8_BAR;
            PG8_LDB(B0, 1, 0); PG8_SCHED; PG8_LDA(At, 1, 0); PG8_STAGE(PG8_SA(0, 1), a2 + hstep, voffA);
            PG8_WAIT_L(8); PG8_BAR; PG8_WAIT_L(0); PG8_MMA(0, 0, At, B0); PG8_BAR; PG8_SCHED;
            PG8_LDB(B1, 1, 1); PG8_STAGE(PG8_SB(1, 0), b3, voffB);
            PG8_BAR; PG8_WAIT_L(0); PG8_MMA(0, 1, At, B1); PG8_BAR;
            PG8_LDA(At, 1, 1); PG8_STAGE(PG8_SA(1, 0), a3, voffA);
            PG8_BAR; PG8_WAIT_L(0); PG8_MMA(1, 0, At, B0); PG8_BAR; PG8_SCHED;
            PG8_STAGE(PG8_SB(1, 1), b3 + hstep, voffB);
            PG8_WAIT_V(6); PG8_BAR; PG8_MMA(1, 1, At, B1); PG8_BAR;
            }
        }
        if constexpr (ALIGN_EPI) { if (wr == 0) PG8_BAR; }
        if constexpr (!Epi::AFTER_DRAIN) { E(acc, cur, wr, wc, fr, fq); S.done(cur); }
        if (!has_next) break;
#pragma unroll
        for (int a = 0; a < 2; ++a)
#pragma unroll
            for (int b = 0; b < 2; ++b)
#pragma unroll
                for (int m = 0; m < 4; ++m)
#pragma unroll
                    for (int n = 0; n < 2; ++n) acc[a][b][m][n] = (f32x4){0.f, 0.f, 0.f, 0.f};
        cur = nxt; cA = nA; cB = nB; ++ui;
        if constexpr (ALIGN_EPI) { if (wr == 1) PG8_BAR; }
    }
    PG8_WAIT_V(0);
    if constexpr (!ALIGN_EPI) { if (wr == 0) PG8_BAR; }
    PG8_BAR;
    if constexpr (Epi::AFTER_DRAIN) { E.fused(acc, cur, wr, wc, fr, fq, lds, wid, lane); S.done(cur); }
#undef PG8_SA
#undef PG8_SB
#undef PG8_STAGE
#undef PG8_LDA
#undef PG8_LDB
#undef PG8_MMA
#undef PG8_WAIT_V
#undef PG8_WAIT_L
#undef PG8_BAR
#undef PG8_SCHED
}
}
#define GAS __attribute__((address_space(1)))
#define LAS __attribute__((address_space(3)))
typedef unsigned short bf16;
typedef unsigned v4u __attribute__((ext_vector_type(4)));
typedef unsigned v2u __attribute__((ext_vector_type(2)));
typedef float f32x4 __attribute__((ext_vector_type(4)));
typedef short bf16x8 __attribute__((ext_vector_type(8)));
typedef short s16x4 __attribute__((ext_vector_type(4)));
#define LDS_WAIT() asm volatile("s_waitcnt lgkmcnt(0)" ::: "memory")

constexpr int NWAVES = 8;
constexpr int M_TOK = 81920, MP = 65536, D = 1024, FF = 2816, NGU = 2 * FF, DIN = 3072;
constexpr float EPSF = 1e-6f;
constexpr size_t MiB = 1u << 20;
constexpr size_t WS_CTL = 0, CTL_ZERO_BYTES = 65536;
constexpr size_t WS_W1GU = 1 * MiB, WS_W1D = 12 * MiB, WS_WIN = 18 * MiB, WS_WOUT = 24 * MiB, WS_W2GU = 26 * MiB, WS_W2D = 37 * MiB;
constexpr size_t WS_SS1 = 44 * MiB, WS_SS2 = 50 * MiB, WS_RS0 = 56 * MiB;
constexpr size_t WS_XB = 64 * MiB;
constexpr size_t WS_ACT = 224 * MiB;
constexpr size_t WS_ZQ = WS_ACT, WS_ZK = WS_ACT + 80 * MiB, WS_VT = WS_ACT + 160 * MiB, WS_ZC = WS_ACT + 240 * MiB;
constexpr size_t WS_AC = 704 * MiB;
constexpr size_t WS_END = 864 * MiB;
constexpr int RING_BYTES = 131072, LDS_BYTES = 147456;

__device__ __forceinline__ unsigned f2bf(float f) { unsigned u = __builtin_bit_cast(unsigned, f); return (u + 0x7fffu + ((u >> 16) & 1u)) >> 16; }
__device__ __forceinline__ unsigned pk2(float lo, float hi) { return f2bf(lo) | (f2bf(hi) << 16); }
__device__ __forceinline__ float bflo(unsigned w) { return __builtin_bit_cast(float, w << 16); }
__device__ __forceinline__ float bfhi(unsigned w) { return __builtin_bit_cast(float, w & 0xffff0000u); }
__device__ __forceinline__ float wave_sum(float v) {
#pragma unroll
    for (int o = 1; o < 64; o <<= 1) v += __shfl_xor(v, o);
    return v;
}

__device__ __forceinline__ void p0_transpose_item(const float* W, int K, int N, bf16* WT, const float* gain, int kind, LAS float* scr, int item, int lane) {
    const int nblk = N / 32, kb = item / nblk, nb = item % nblk, k0 = 64 * kb, n0 = 32 * nb;
    int rowbase = n0;
    if (kind == 1) rowbase = (n0 >> 7) * 256 + (n0 & 127);
    else if (kind == 2) rowbase = (n0 >> 7) * 256 + 128 + (n0 & 127);
    else if (kind == 3 || (kind == 4 && n0 < 2048)) rowbase = (n0 & ~255) + 128 * ((n0 >> 5) & 1) + 32 * ((n0 >> 6) & 3);
    else if (kind == 4) { const int isx = n0 >= 2560, ch0 = (n0 - 2048) & 511; rowbase = 256 * (8 + (ch0 >> 7)) + 128 * isx + 32 * ((ch0 >> 5) & 3); }
#pragma unroll 8
    for (int i = 0; i < 32; ++i) { const int kk = 2 * i + (lane >> 5); const float g = gain ? gain[k0 + kk] : 1.0f; scr[kk * 33 + (lane & 31)] = W[(size_t)(k0 + kk) * N + n0 + (lane & 31)] * g; }
    LDS_WAIT(); asm volatile("" ::: "memory");
    const int c = lane & 7;
#pragma unroll
    for (int j = 0; j < 4; ++j) { const int n = (lane >> 3) + 8 * j; const LAS float* s = scr + (8 * c) * 33 + n;
        v4u o; o.x = pk2(s[0 * 33], s[1 * 33]); o.y = pk2(s[2 * 33], s[3 * 33]); o.z = pk2(s[4 * 33], s[5 * 33]); o.w = pk2(s[6 * 33], s[7 * 33]);
        *(v4u*)(WT + (size_t)(rowbase + n) * K + k0 + 8 * c) = o; }
    LDS_WAIT(); asm volatile("" ::: "memory");
}

struct Args {
    const float* in[20]; float* out; unsigned char* ws; int ph_lo, ph_hi;
};
enum { I_XP = 0, I_XS, I_F1N, I_F1G, I_F1U, I_F1D, I_MIXN, I_WIN, I_QN, I_KN, I_RPB, I_CW, I_AON, I_CON, I_WOUT, I_F2N, I_F2G, I_F2U, I_F2D, I_FINN };

__device__ __forceinline__ void p0_prologue(const Args& A, LAS unsigned char* lds, int gw, int NGW, int wave, int lane) {
    unsigned char* ws = A.ws;
    LAS float* scr = (LAS float*)(lds + wave * 16384);
    constexpr int I_G = (D / 64) * (FF / 32), I_DN = (FF / 64) * (D / 32), I_IN = (D / 64) * (DIN / 32), I_OUT = (D / 64) * (D / 32);
    constexpr int NITEMS = 2 * (2 * I_G + I_DN) + I_IN + I_OUT;
    for (int it = gw; it < NITEMS; it += NGW) {
        int r = it;
        if (r < I_G) { p0_transpose_item(A.in[I_F1G], D, FF, (bf16*)(ws + WS_W1GU), nullptr, 1, scr, r, lane); continue; } r -= I_G;
        if (r < I_G) { p0_transpose_item(A.in[I_F1U], D, FF, (bf16*)(ws + WS_W1GU), nullptr, 2, scr, r, lane); continue; } r -= I_G;
        if (r < I_DN) { p0_transpose_item(A.in[I_F1D], FF, D, (bf16*)(ws + WS_W1D), nullptr, 3, scr, r, lane); continue; } r -= I_DN;
        if (r < I_G) { p0_transpose_item(A.in[I_F2G], D, FF, (bf16*)(ws + WS_W2GU), A.in[I_F2N], 1, scr, r, lane); continue; } r -= I_G;
        if (r < I_G) { p0_transpose_item(A.in[I_F2U], D, FF, (bf16*)(ws + WS_W2GU), A.in[I_F2N], 2, scr, r, lane); continue; } r -= I_G;
        if (r < I_DN) { p0_transpose_item(A.in[I_F2D], FF, D, (bf16*)(ws + WS_W2D), nullptr, 3, scr, r, lane); continue; } r -= I_DN;
        if (r < I_IN) { p0_transpose_item(A.in[I_WIN], D, DIN, (bf16*)(ws + WS_WIN), A.in[I_MIXN], 4, scr, r, lane); continue; } r -= I_IN;
        p0_transpose_item(A.in[I_WOUT], D, D, (bf16*)(ws + WS_WOUT), nullptr, 3, scr, r, lane);
    }
    const f32x4* gp = (const f32x4*)A.in[I_F1N] + lane;
    f32x4 gv[4];
#pragma unroll
    for (int j = 0; j < 4; ++j) gv[j] = gp[64 * j];
    bf16* XN = (bf16*)(ws + WS_XB);
    for (int it_ = 0; it_ < 20; ++it_) {
        const int m = (5 * (gw >> 8) + 4 - (it_ >> 2)) * 2048 + (gw & 255) * 8 + 2 * (it_ & 3), m2 = m + 1;
        const float* xrow = (m < MP) ? A.in[I_XP] + (size_t)m * D : A.in[I_XS] + (size_t)(m - MP) * D;
        const float* xrow2 = (m2 < MP) ? A.in[I_XP] + (size_t)m2 * D : A.in[I_XS] + (size_t)(m2 - MP) * D;
        const f32x4* xr = (const f32x4*)xrow + lane; const f32x4* xr2 = (const f32x4*)xrow2 + lane; f32x4 v[4], v2[4]; float s = 0.f, s2 = 0.f;
#pragma unroll
        for (int j = 0; j < 4; ++j) { v[j] = xr[64 * j]; v2[j] = xr2[64 * j]; }
#pragma unroll
        for (int j = 0; j < 4; ++j) { s += (v[j].x * v[j].x + v[j].y * v[j].y) + (v[j].z * v[j].z + v[j].w * v[j].w); s2 += (v2[j].x * v2[j].x + v2[j].y * v2[j].y) + (v2[j].z * v2[j].z + v2[j].w * v2[j].w); }
        const float rstd = 1.0f / sqrtf(wave_sum(s) * (1.0f / D) + EPSF), rstd2 = 1.0f / sqrtf(wave_sum(s2) * (1.0f / D) + EPSF);
        unsigned long long* o8 = (unsigned long long*)(XN + (size_t)m * D) + lane; unsigned long long* o82 = (unsigned long long*)(XN + (size_t)m2 * D) + lane;
        if (lane == 0) { float* rs0 = (float*)(ws + WS_RS0); rs0[m] = rstd; rs0[m2] = rstd2; }
#pragma unroll
        for (int j = 0; j < 4; ++j) { const f32x4 y = v[j] * rstd * gv[j]; o8[64 * j] = (unsigned long long)pk2(y.x, y.y) | ((unsigned long long)pk2(y.z, y.w) << 32);
            const f32x4 y2 = v2[j] * rstd2 * gv[j]; o82[64 * j] = (unsigned long long)pk2(y2.x, y2.y) | ((unsigned long long)pk2(y2.z, y2.w) << 32); }
    }
}

__device__ __forceinline__ void final_norm_phase(const Args& A, int gw, int NGW, int lane) {
    const float* gp = A.in[I_FINN] + 8 * lane;
    const f32x4 g0 = *(const f32x4*)(gp), g1 = *(const f32x4*)(gp + 4), g2 = *(const f32x4*)(gp + 512), g3 = *(const f32x4*)(gp + 516);
    const bf16* XB = (const bf16*)(A.ws + WS_XB);
    for (int it_ = 0; it_ < 10; ++it_) {
        const int m = (5 * (gw >> 8) + 4 - (it_ >> 1)) * 2048 + (gw & 255) * 8 + 4 * (it_ & 1);
        v4u a[4], b[4];
#pragma unroll
        for (int i = 0; i < 4; ++i) { const bf16* xr = XB + (size_t)(m + i) * D + 8 * lane; a[i] = *(const v4u*)(xr); b[i] = *(const v4u*)(xr + 512); }
#pragma unroll
        for (int i = 0; i < 4; ++i) {
            const f32x4 v0 = (f32x4){bflo(a[i].x), bfhi(a[i].x), bflo(a[i].y), bfhi(a[i].y)}, v1 = (f32x4){bflo(a[i].z), bfhi(a[i].z), bflo(a[i].w), bfhi(a[i].w)};
            const f32x4 v2 = (f32x4){bflo(b[i].x), bfhi(b[i].x), bflo(b[i].y), bfhi(b[i].y)}, v3 = (f32x4){bflo(b[i].z), bfhi(b[i].z), bflo(b[i].w), bfhi(b[i].w)};
            const float s = (v0.x * v0.x + v0.y * v0.y) + (v0.z * v0.z + v0.w * v0.w) + (v1.x * v1.x + v1.y * v1.y) + (v1.z * v1.z + v1.w * v1.w)
                          + (v2.x * v2.x + v2.y * v2.y) + (v2.z * v2.z + v2.w * v2.w) + (v3.x * v3.x + v3.y * v3.y) + (v3.z * v3.z + v3.w * v3.w);
            const float rstd = 1.0f / sqrtf(wave_sum(s) * (1.0f / D) + EPSF);
            float* o = A.out + (size_t)(m + i) * D + 8 * lane;
            *(f32x4*)(o) = v0 * rstd * g0; *(f32x4*)(o + 4) = v1 * rstd * g1; *(f32x4*)(o + 512) = v2 * rstd * g2; *(f32x4*)(o + 516) = v3 * rstd * g3;
        }
    }
}

constexpr int RPB_OFF = 256, RPB_N = 8 * 15 * 31;
__device__ __forceinline__ void attn_finish(f32x4 (&o)[4], float sum, const float* aogp  , bf16* op) {
    const float il = 1.0f / sum; float q2 = 0.f;
#pragma unroll
    for (int mt = 0; mt < 4; ++mt) { o[mt] = o[mt] * il; q2 += (o[mt][0] * o[mt][0] + o[mt][1] * o[mt][1]) + (o[mt][2] * o[mt][2] + o[mt][3] * o[mt][3]); }
    q2 += __shfl_xor(q2, 16); q2 += __shfl_xor(q2, 32);
    const float rn = 1.0f / sqrtf(q2 * (1.0f / 64.0f) + EPSF);
#pragma unroll
    for (int mt = 0; mt < 4; ++mt) { const f32x4 y = o[mt] * rn * *(const f32x4*)(aogp + 16 * mt); v2u w; w.x = pg8::cvt_pk_bf16(y[0], y[1]); w.y = pg8::cvt_pk_bf16(y[2], y[3]); *(v2u*)(op + 16 * mt) = w; }
}
template <int STEP>
__device__ __forceinline__ void attn_quad(const bf16* ZQ, const bf16* ZK, const bf16* VT, bf16* AC, const LAS float* rpbL, const float* aogp,
                                          int seqbase, int S, int rA, int rs0, int h, int qc, int l, int g) {
    constexpr int NU = 8 + 3 * STEP;
    const int w0 = (qc == 0) ? 0 : (qc == 1) ? 8 : (qc == 2) ? 24 : 32;
    const int c = 16 * qc + l; int cs = c - 8; cs = cs < 0 ? 0 : cs; cs = cs > 48 ? 48 : cs;
    const size_t qtok0 = (size_t)seqbase + rA * 64 + c;
    bf16x8 qf[4][2];
#pragma unroll
    for (int i = 0; i < 4; ++i)
#pragma unroll
        for (int ks = 0; ks < 2; ++ks) qf[i][ks] = *(const bf16x8*)(ZQ + (qtok0 + 64 * i) * 512 + h * 64 + ks * 32 + 8 * g);
    const bf16* kp = ZK + ((size_t)seqbase + rs0 * 64 + w0 + 8 * (l >> 2) + (l & 3)) * 512 + h * 64 + 8 * g;
    const bf16* vp = VT + (size_t)seqbase * 512 + (size_t)(h * 64 + l) * S + rs0 * 64 + w0 + 8 * g;
    const int kc0 = w0 + 8 * g;
    bool valid[2][4];
#pragma unroll
    for (int hf = 0; hf < 2; ++hf)
#pragma unroll
        for (int j = 0; j < 4; ++j) valid[hf][j] = (unsigned)(kc0 + 4 * hf + j - cs) < 16u;
    const LAS float* bp0 = rpbL + h * 465 + (rs0 - rA + 7) * 31 + (kc0 - c + 15);
    f32x4 o[4][4]; float sum[4];
#pragma unroll
    for (int i = 0; i < 4; ++i) { sum[i] = 0.f;
#pragma unroll
        for (int mt = 0; mt < 4; ++mt) o[i][mt] = (f32x4){0.f, 0.f, 0.f, 0.f}; }
    bf16x8 kn[2][2]; v4u vn[4];
#pragma unroll
    for (int hf = 0; hf < 2; ++hf) { const bf16* kt = kp + (size_t)(hf * 4) * 512; kn[hf][0] = *(const bf16x8*)(kt); kn[hf][1] = *(const bf16x8*)(kt + 32); }
#pragma unroll
    for (int mt = 0; mt < 4; ++mt) vn[mt] = *(const v4u*)(vp + (size_t)(16 * mt) * S);
#pragma unroll 1
    for (int u = 0; u < NU; ++u) {
        bf16x8 kf[2][2]; v4u vf[4];
#pragma unroll
        for (int hf = 0; hf < 2; ++hf) { kf[hf][0] = kn[hf][0]; kf[hf][1] = kn[hf][1]; }
#pragma unroll
        for (int mt = 0; mt < 4; ++mt) vf[mt] = vn[mt];
        if (u + 1 < NU) {
#pragma unroll
            for (int hf = 0; hf < 2; ++hf) { const bf16* kt = kp + (size_t)((u + 1) * 64 + hf * 4) * 512; kn[hf][0] = *(const bf16x8*)(kt); kn[hf][1] = *(const bf16x8*)(kt + 32); }
#pragma unroll
            for (int mt = 0; mt < 4; ++mt) vn[mt] = *(const v4u*)(vp + (size_t)(16 * mt) * S + (u + 1) * 64);
        }
#pragma unroll
        for (int i = 0; i < 4; ++i) {
            if ((unsigned)(u - i * STEP) < 8u) {
                f32x4 s0 = {0.f, 0.f, 0.f, 0.f}, s1 = {0.f, 0.f, 0.f, 0.f};
                s0 = __builtin_amdgcn_mfma_f32_16x16x32_bf16(kf[0][0], qf[i][0], s0, 0, 0, 0); s0 = __builtin_amdgcn_mfma_f32_16x16x32_bf16(kf[0][1], qf[i][1], s0, 0, 0, 0);
                s1 = __builtin_amdgcn_mfma_f32_16x16x32_bf16(kf[1][0], qf[i][0], s1, 0, 0, 0); s1 = __builtin_amdgcn_mfma_f32_16x16x32_bf16(kf[1][1], qf[i][1], s1, 0, 0, 0);
                const LAS float* bp = bp0 + (u - i) * 31;
                float p0[4], p1[4];
#pragma unroll
                for (int j = 0; j < 4; ++j) { p0[j] = valid[0][j] ? __builtin_amdgcn_exp2f(s0[j] + bp[j]) : 0.f; p1[j] = valid[1][j] ? __builtin_amdgcn_exp2f(s1[j] + bp[4 + j]) : 0.f; }
                sum[i] += ((p0[0] + p0[1]) + (p0[2] + p0[3])) + ((p1[0] + p1[1]) + (p1[2] + p1[3]));
                v4u pw; pw.x = pg8::cvt_pk_bf16(p0[0], p0[1]); pw.y = pg8::cvt_pk_bf16(p0[2], p0[3]); pw.z = pg8::cvt_pk_bf16(p1[0], p1[1]); pw.w = pg8::cvt_pk_bf16(p1[2], p1[3]);
                const bf16x8 pf = __builtin_bit_cast(bf16x8, pw);
#pragma unroll
                for (int mt = 0; mt < 4; ++mt) o[i][mt] = __builtin_amdgcn_mfma_f32_16x16x32_bf16(__builtin_bit_cast(bf16x8, vf[mt]), pf, o[i][mt], 0, 0, 0);
            }
        }
    }
#pragma unroll
    for (int i = 0; i < 4; ++i) {
        float sm = sum[i]; sm += __shfl_xor(sm, 16); sm += __shfl_xor(sm, 32);
        attn_finish(o[i], sm, aogp, AC + (qtok0 + 64 * i) * 1024 + h * 64 + 4 * g);
    }
}

__device__ __forceinline__ void attn_conv_phase(const Args& A, LAS unsigned char* lds, int wave, int lane) {
    unsigned char* ws = A.ws;
    const bf16* ZQ = (const bf16*)(ws + WS_ZQ); const bf16* ZK = (const bf16*)(ws + WS_ZK); const bf16* VT = (const bf16*)(ws + WS_VT); const bf16* ZC = (const bf16*)(ws + WS_ZC);
    bf16* AC = (bf16*)(ws + WS_AC);
    LAS float* rpbL = (LAS float*)(lds + RPB_OFF);
    float cb;
    { const float mq = fabsf(A.in[I_QN][lane]), mk = fabsf(A.in[I_KN][lane]); float mqw = mq, mkw = mk, mb = 0.f;
      for (int i = lane; i < RPB_N; i += 64) mb = fmaxf(mb, fabsf(A.in[I_RPB][i]));
#pragma unroll
      for (int o_ = 1; o_ < 64; o_ <<= 1) { mqw = fmaxf(mqw, __shfl_xor(mqw, o_)); mkw = fmaxf(mkw, __shfl_xor(mkw, o_)); mb = fmaxf(mb, __shfl_xor(mb, o_)); }
      cb = 11.5416f * 1.01f * mqw * mkw + 1.4426950408889634f * mb; }
    for (int i = wave * 64 + lane; i < RPB_N; i += NWAVES * 64) rpbL[i] = A.in[I_RPB][i] * 1.4426950408889634f - cb;
    __syncthreads();
    const int l = lane & 15, g = lane >> 4;
#if PROBE_DUP == 44
#pragma unroll 1
    for (int rep_ = 0; rep_ < 2; ++rep_)
#endif
    const int G_ = (int)gridDim.x, vcu_ = (G_ % 8 == 0) ? ((int)blockIdx.x % 8) * (G_ / 8) + (int)blockIdx.x / 8 : (int)blockIdx.x;
    for (int ui_ = 0; ui_ < 5; ++ui_) {
        const int unit = (G_ == 256) ? 32 * (5 * (vcu_ >> 5) + (4 - ui_)) + (vcu_ & 31) : vcu_ + ui_ * G_;
        if (unit >= 1280) break;
        const int quad = unit >> 2, hq = unit & 3;
        int seqbase, rA, S, rows;
        if (quad < 256) { seqbase = (quad >> 3) * 2048; rA = 4 * (quad & 7); S = 2048; rows = 32; }
        else { const int q2 = quad - 256; seqbase = MP + (q2 >> 4) * 4096; rA = 4 * (q2 & 15); S = 4096; rows = 64; }
        int rs0 = rA - 4; rs0 = rs0 < 0 ? 0 : rs0; rs0 = rs0 > rows - 8 ? rows - 8 : rs0;
        int rs1 = rA - 3; rs1 = rs1 < 0 ? 0 : rs1; rs1 = rs1 > rows - 8 ? rows - 8 : rs1;
        const int h = 2 * hq + (wave & 1), qc = wave >> 1;
        const float* aogp = A.in[I_AON] + h * 64 + 4 * g;
        if (rs1 != rs0) attn_quad<1>(ZQ, ZK, VT, AC, rpbL, aogp, seqbase, S, rA, rs0, h, qc, l, g);
        else attn_quad<0>(ZQ, ZK, VT, AC, rpbL, aogp, seqbase, S, rA, rs0, h, qc, l, g);
        const int r = rA + hq;
        {
            const int ch = 8 * lane; const float* cw = A.in[I_CW];
            f32x4 w0a = *(const f32x4*)(cw + ch), w0b = *(const f32x4*)(cw + ch + 4), w1a = *(const f32x4*)(cw + 512 + ch), w1b = *(const f32x4*)(cw + 512 + ch + 4);
            f32x4 w2a = *(const f32x4*)(cw + 1024 + ch), w2b = *(const f32x4*)(cw + 1024 + ch + 4);
            f32x4 cga = *(const f32x4*)(A.in[I_CON] + ch), cgb = *(const f32x4*)(A.in[I_CON] + ch + 4);
            const int t0 = r * 64 + 8 * wave;
            f32x4 upa, upb, uca, ucb, una, unb;
#define LOAD_U(tt, ua, ub) do { const int t_ = (tt); if (t_ >= 0 && t_ < S) { const v4u x_ = *(const v4u*)(ZC + ((size_t)seqbase + t_) * 1024 + 512 + ch); \
                ua = (f32x4){bflo(x_.x), bfhi(x_.x), bflo(x_.y), bfhi(x_.y)}; ub = (f32x4){bflo(x_.z), bfhi(x_.z), bflo(x_.w), bfhi(x_.w)}; } \
                else { ua = (f32x4){0.f, 0.f, 0.f, 0.f}; ub = ua; } } while (0)
            LOAD_U(t0 - 1, upa, upb); LOAD_U(t0, uca, ucb);
#pragma unroll 2
            for (int i = 0; i < 8; ++i) {
                const int t = t0 + i;
                LOAD_U(t + 1, una, unb);
                const v4u b_ = *(const v4u*)(ZC + ((size_t)seqbase + t) * 1024 + ch);
                const f32x4 gba = (f32x4){bflo(b_.x), bfhi(b_.x), bflo(b_.y), bfhi(b_.y)}, gbb = (f32x4){bflo(b_.z), bfhi(b_.z), bflo(b_.w), bfhi(b_.w)};
                const f32x4 ya = gba * (upa * w0a + uca * w1a + una * w2a), yb = gbb * (upb * w0b + ucb * w1b + unb * w2b);
                float q2 = (ya[0] * ya[0] + ya[1] * ya[1]) + (ya[2] * ya[2] + ya[3] * ya[3]) + (yb[0] * yb[0] + yb[1] * yb[1]) + (yb[2] * yb[2] + yb[3] * yb[3]);
                q2 += __shfl_xor(q2, 1); q2 += __shfl_xor(q2, 2); q2 += __shfl_xor(q2, 4);
                const float rn = 1.0f / sqrtf(q2 * (1.0f / 64.0f) + EPSF);
                const f32x4 oa = ya * rn * cga, ob = yb * rn * cgb;
                v4u w; w.x = pg8::cvt_pk_bf16(oa[0], oa[1]); w.y = pg8::cvt_pk_bf16(oa[2], oa[3]); w.z = pg8::cvt_pk_bf16(ob[0], ob[1]); w.w = pg8::cvt_pk_bf16(ob[2], ob[3]);
                *(v4u*)(AC + ((size_t)seqbase + t) * 1024 + 512 + ch) = w;
                upa = uca; upb = ucb; uca = una; ucb = unb;
            }
#undef LOAD_U
        }
    }
    __syncthreads();
}

typedef GAS unsigned gu32;
#define XB_TMO      128
#define XB_XCNT(j)  (256  + 64 * (j))
#define XB_XSUB(j)  (1280 + 64 * (j))
#define XB_XGEN(j)  (2304 + 64 * (j))
#define XB_TOP      3328
#define XB_TOPGEN   3392
#define XCD_BAR_WORDS 3456
#define XB_SPIN_CAP (1u << 18)

__device__ __forceinline__ unsigned xb_ld(unsigned* p)              { return __hip_atomic_load(p, __ATOMIC_RELAXED, __HIP_MEMORY_SCOPE_AGENT); }
__device__ __forceinline__ unsigned xb_add(unsigned* p, unsigned v) { return __hip_atomic_fetch_add(p, v, __ATOMIC_RELAXED, __HIP_MEMORY_SCOPE_AGENT); }
__device__ __forceinline__ unsigned xb_xcc_id() { return (unsigned)__builtin_amdgcn_s_getreg((3 << 11) | 20) & 0xFu; }
#define XB_SPIN(cond, bar) do { unsigned _sp = 0; while (cond) { __builtin_amdgcn_s_sleep(1); \
    if ((++_sp & 255u) == 0u) { if (xb_ld(&(bar)[XB_TMO])) break; if (_sp > XB_SPIN_CAP) { atomicAdd(&(bar)[XB_TMO], 1u); break; } } } } while (0)

struct XcdBarrier {
    unsigned* bar; unsigned x;
    volatile LAS unsigned* st;
};

__device__ __forceinline__ XcdBarrier xcd_barrier_post(unsigned* bar, volatile LAS unsigned* st, bool t0) {
    XcdBarrier b; b.bar = bar; b.x = xb_xcc_id(); b.st = st;
    if (t0) (void)xb_add(&bar[XB_XCNT(b.x)], 1u);
    return b;
}
__device__ __forceinline__ void xcd_barrier_complete(unsigned* bar, unsigned x, unsigned& nloc, unsigned& nx) {
    const unsigned G = gridDim.x * gridDim.y * gridDim.z;
    unsigned sum, cnt, mine, sp = 0u;
    for (;;) {
        sum = 0u; cnt = 0u; mine = 0u;
#pragma unroll
        for (unsigned j = 0; j < 16; ++j) { const unsigned c = xb_ld(&bar[XB_XCNT(j)]); sum += c; cnt += (c > 0u) ? 1u : 0u; mine = (j == x) ? c : mine; }
        if (sum == G) break;
        __builtin_amdgcn_s_sleep(1);
        if ((++sp & 255u) == 0u) { if (xb_ld(&bar[XB_TMO])) break; if (sp > XB_SPIN_CAP) { atomicAdd(&bar[XB_TMO], 1u); break; } }
    }
    nloc = mine > 0u ? mine : 1u; nx = cnt > 0u ? cnt : 1u;
}

__device__ __forceinline__ void xcd_barrier(const XcdBarrier& b, bool t0) {
    asm volatile("s_waitcnt vmcnt(0)" ::: "memory");
    __syncthreads();
    if (t0) {
        unsigned* bar = b.bar;
        __builtin_amdgcn_s_waitcnt(0);
        unsigned nloc = b.st[0], nx = b.st[1];
        if (nloc == 0u) { xcd_barrier_complete(bar, b.x, nloc, nx); b.st[0] = nloc; b.st[1] = nx; }
        const unsigned old = xb_add(&bar[XB_XSUB(b.x)], 1u);
        const unsigned gen = old / nloc;
        if (old + 1u == (gen + 1u) * nloc) {
            __builtin_amdgcn_fence(__ATOMIC_RELEASE, "agent");
            asm volatile("s_waitcnt vmcnt(0)" ::: "memory");
            const unsigned og = xb_add(&bar[XB_TOP], 1u);
            const unsigned tg = og / nx;
            if (og + 1u == (tg + 1u) * nx) xb_add(&bar[XB_TOPGEN], 1u);
            else XB_SPIN(xb_ld(&bar[XB_TOPGEN]) == tg, bar);
            __builtin_amdgcn_fence(__ATOMIC_ACQUIRE, "agent");
            xb_add(&bar[XB_XGEN(b.x)], 1u);
            asm volatile("s_waitcnt vmcnt(0)" ::: "memory");
        } else {
            XB_SPIN(xb_ld(&bar[XB_XGEN(b.x)]) == gen, bar);
            __builtin_amdgcn_fence(__ATOMIC_ACQUIRE, "agent");
            asm volatile("s_waitcnt vmcnt(0)" ::: "memory");
        }
    }
    __syncthreads();
}

#ifndef PROBE_DUP
#define PROBE_DUP -1
#endif
__global__ void __launch_bounds__(NWAVES * 64, 2) enc_fwd(Args args) {
    extern __shared__ __attribute__((aligned(16))) unsigned char lds_raw[];
    LAS unsigned char* lds = (LAS unsigned char*)lds_raw;
    cg::grid_group grid = cg::this_grid();
    const int G = gridDim.x; const int bx = blockIdx.x;
    const int vcu = (G % 8 == 0) ? (bx % 8) * (G / 8) + bx / 8 : bx;
    const int NGW = G * NWAVES;
    const int wave = __builtin_amdgcn_readfirstlane((int)threadIdx.x >> 6);
#define FRESH_IDS() int lane_ = (int)__builtin_amdgcn_mbcnt_hi(~0u, __builtin_amdgcn_mbcnt_lo(~0u, 0u)); asm volatile("" : "+v"(lane_)); const int lane = lane_, gw = vcu * NWAVES + wave; (void)gw; (void)lane
    unsigned char* ws = args.ws;
    const int lo = args.ph_lo, hi = args.ph_hi;
#define IN(k) (lo <= (k) && (k) < hi)
    volatile LAS unsigned* MISC = (volatile LAS unsigned*)(lds + RING_BYTES + 1024);
    const bool t0 = (wave == 0) && ((int)__builtin_amdgcn_mbcnt_hi(~0u, __builtin_amdgcn_mbcnt_lo(~0u, 0u)) == 0);
    if (t0) { MISC[0] = 0u; MISC[1] = 0u; }
    __syncthreads();
    XcdBarrier xbar = xcd_barrier_post((unsigned*)(ws + WS_CTL) + 1024, MISC, t0 && (hi - lo) > 1);
#define SEAM(k) do { if (IN(k) && IN((k) + 1)) { if ((k) == 0) grid.sync(); else xcd_barrier(xbar, (wave == 0) && ((int)__builtin_amdgcn_mbcnt_hi(~0u, __builtin_amdgcn_mbcnt_lo(~0u, 0u)) == 0)); } } while (0)
    bf16* XB = (bf16*)(ws + WS_XB); bf16* ACT = (bf16*)(ws + WS_ACT); bf16* ACB = (bf16*)(ws + WS_AC);
    float* SS1 = (float*)(ws + WS_SS1); float* SS2 = (float*)(ws + WS_SS2);

    if (IN(0)) { FRESH_IDS(); p0_prologue(args, lds, gw, NGW, wave, lane); __syncthreads(); }
#if PROBE_DUP == 0
    if (IN(0)) { FRESH_IDS(); p0_prologue(args, lds, gw, NGW, wave, lane); __syncthreads(); }
#endif
    SEAM(0);
    if (IN(1)) { pg8::Gemm g{XB, (const bf16*)(ws + WS_W1GU), M_TOK, NGU, D, wave}; pg8::StaticOrder S; S.init(M_TOK, NGU, G, bx);
        pg8::EpiSwiGLU<false> E{ACT, FF, nullptr};
        pg8::gemm_phase<pg8::EpiSwiGLU<false>, pg8::StaticOrder, true, true>(lds, g, S, E); }
#if PROBE_DUP == 1
    if (IN(1)) { pg8::Gemm g{XB, (const bf16*)(ws + WS_W1GU), M_TOK, NGU, D, wave}; pg8::StaticOrder S; S.init(M_TOK, NGU, G, bx);
        pg8::EpiSwiGLU<false> E{ACT, FF, nullptr};
        pg8::gemm_phase<pg8::EpiSwiGLU<false>, pg8::StaticOrder, true, true>(lds, g, S, E); }
#endif
    SEAM(1);
    if (IN(2)) { pg8::Gemm g{ACT, (const bf16*)(ws + WS_W1D), M_TOK, D, FF, wave}; pg8::RevOrder S; S.init(M_TOK, D, G, bx);
        pg8::EpiResid<2, true> E{args.in[I_F1N], (const float*)(ws + WS_RS0), XB, SS1, 0.5f};
        pg8::gemm_phase<pg8::EpiResid<2, true>, pg8::RevOrder, true, true>(lds, g, S, E); }
#if PROBE_DUP == 2
    if (IN(2)) { pg8::Gemm g{ACT, (const bf16*)(ws + WS_W1D), M_TOK, D, FF, wave}; pg8::RevOrder S; S.init(M_TOK, D, G, bx);
        pg8::EpiResid<2, true> E{args.in[I_F1N], (const float*)(ws + WS_RS0), XB, SS1, 0.5f};
        pg8::gemm_phase<pg8::EpiResid<2, true>, pg8::RevOrder, true, true>(lds, g, S, E); }
#endif
    SEAM(2);
    if (IN(3)) { pg8::Gemm g{XB, (const bf16*)(ws + WS_WIN), M_TOK, DIN, D, wave}; pg8::StaticOrder S; S.init(M_TOK, DIN, G, bx);
        pg8::EpiWin E{SS1, (bf16*)(ws + WS_ZQ), (bf16*)(ws + WS_ZK), (bf16*)(ws + WS_VT), (bf16*)(ws + WS_ZC), args.in[I_QN], args.in[I_KN]};
        pg8::gemm_phase<pg8::EpiWin, pg8::StaticOrder, true, true>(lds, g, S, E); }
#if PROBE_DUP == 3
    if (IN(3)) { pg8::Gemm g{XB, (const bf16*)(ws + WS_WIN), M_TOK, DIN, D, wave}; pg8::StaticOrder S; S.init(M_TOK, DIN, G, bx);
        pg8::EpiWin E{SS1, (bf16*)(ws + WS_ZQ), (bf16*)(ws + WS_ZK), (bf16*)(ws + WS_VT), (bf16*)(ws + WS_ZC), args.in[I_QN], args.in[I_KN]};
        pg8::gemm_phase<pg8::EpiWin, pg8::StaticOrder, true, true>(lds, g, S, E); }
#endif
    SEAM(3);
    if (IN(4)) { FRESH_IDS(); attn_conv_phase(args, lds, wave, lane); }
#if PROBE_DUP == 4
    if (IN(4)) { FRESH_IDS(); attn_conv_phase(args, lds, wave, lane); }
#endif
    SEAM(4);
    if (IN(5)) { pg8::Gemm g{ACB, (const bf16*)(ws + WS_WOUT), M_TOK, D, D, wave}; pg8::StaticOrder S; S.init(M_TOK, D, G, bx);
        pg8::EpiResid<1, true> E{nullptr, nullptr, XB, SS2, 1.0f};
        pg8::gemm_phase<pg8::EpiResid<1, true>, pg8::StaticOrder, true, true>(lds, g, S, E); } SEAM(5);
    if (IN(6)) { pg8::Gemm g{XB, (const bf16*)(ws + WS_W2GU), M_TOK, NGU, D, wave}; pg8::RevOrder S; S.init(M_TOK, NGU, G, bx);
        pg8::EpiSwiGLU<true> E{ACT, FF, SS2};
        pg8::gemm_phase<pg8::EpiSwiGLU<true>, pg8::RevOrder, true, true>(lds, g, S, E); }
#if PROBE_DUP == 6
    if (IN(6)) { pg8::Gemm g{XB, (const bf16*)(ws + WS_W2GU), M_TOK, NGU, D, wave}; pg8::RevOrder S; S.init(M_TOK, NGU, G, bx);
        pg8::EpiSwiGLU<true> E{ACT, FF, SS2};
        pg8::gemm_phase<pg8::EpiSwiGLU<true>, pg8::RevOrder, true, true>(lds, g, S, E); }
#endif
    SEAM(6);
    if (IN(7)) { pg8::Gemm g{ACT, (const bf16*)(ws + WS_W2D), M_TOK, D, FF, wave}; pg8::StaticOrder S; S.init(M_TOK, D, G, bx);
        pg8::EpiResid<1, false> E{nullptr, nullptr, XB, nullptr, 0.5f};
        pg8::gemm_phase<pg8::EpiResid<1, false>, pg8::StaticOrder, true, true>(lds, g, S, E); } SEAM(7);
    if (IN(8)) { FRESH_IDS(); final_norm_phase(args, gw, NGW, lane); }
#undef IN
#undef SEAM
}

#ifndef MK_N_LAUNCHES
#define MK_N_LAUNCHES 1
#endif
extern "C" void kernel_launch(void* const* d_in, const int* in_sizes, int n_in, void* d_out, int out_size, void* d_ws, size_t ws_size, hipStream_t stream) {
    static int grid = 0;
    if (grid == 0) {
        if (n_in != 20 || in_sizes[0] != MP * D || out_size != M_TOK * D || ws_size < WS_END) { fprintf(stderr, "kernel_launch: unexpected shapes (n_in %d, in0 %d, out %d, ws %zu)\n", n_in, n_in > 0 ? in_sizes[0] : -1, out_size, ws_size); grid = -1; return; }
        int dev = 0, cus = 0, per_cu = 0;
        if (hipGetDevice(&dev) != hipSuccess || hipDeviceGetAttribute(&cus, hipDeviceAttributeMultiprocessorCount, dev) != hipSuccess) { grid = -1; return; }
        if (hipFuncSetAttribute((const void*)enc_fwd, hipFuncAttributeMaxDynamicSharedMemorySize, LDS_BYTES) != hipSuccess) { fprintf(stderr, "kernel_launch: hipFuncSetAttribute failed\n"); grid = -1; return; }
        if (hipOccupancyMaxActiveBlocksPerMultiprocessor(&per_cu, (const void*)enc_fwd, NWAVES * 64, LDS_BYTES) != hipSuccess || per_cu < 1) { fprintf(stderr, "kernel_launch: occupancy query says %d\n", per_cu); per_cu = 1; }
        (void)hipGetLastError();
        if (cus * per_cu < 256) { fprintf(stderr, "kernel_launch: needs 256 co-resident workgroups, device offers %d\n", cus * per_cu); grid = -1; return; }
        grid = 256;
    }
    if (grid < 0) return;
    if (hipMemsetAsync((char*)d_ws + WS_CTL, 0, CTL_ZERO_BYTES, stream) != hipSuccess) { fprintf(stderr, "kernel_launch: memset failed\n"); return; }
    Args a{};
    for (int i = 0; i < 20; ++i) a.in[i] = (const float*)d_in[i];
    a.out = (float*)d_out; a.ws = (unsigned char*)d_ws;
#if MK_N_LAUNCHES == 1
    a.ph_lo = 0; a.ph_hi = 9;
    void* kargs[] = {&a};
    hipError_t e = hipLaunchCooperativeKernel((const void*)enc_fwd, dim3(grid), dim3(NWAVES * 64), kargs, LDS_BYTES, stream);
    if (e != hipSuccess) fprintf(stderr, "kernel_launch: cooperative launch failed: %s (grid %d)\n", hipGetErrorString(e), grid);
#else
    for (int p = 0; p < 9; ++p) {
        a.ph_lo = p; a.ph_hi = p + 1;
        hipLaunchKernelGGL(enc_fwd, dim3(grid), dim3(NWAVES * 64), LDS_BYTES, stream, a);
    }
#endif
}
```

```cpp
#include <hip/hip_runtime.h>
#include <hip/hip_cooperative_groups.h>
#include <cstdio>
#include <cstdint>
#include <cmath>
namespace cg = cooperative_groups;
namespace pg8 {
#define PG8_LAS __attribute__((address_space(3)))
typedef unsigned short bf16_t;
typedef short bf16x8 __attribute__((ext_vector_type(8)));
typedef float f32x4 __attribute__((ext_vector_type(4)));
typedef unsigned u32x4 __attribute__((ext_vector_type(4)));
constexpr int BM = 256, BK = 64, HALF = 128, HTB = HALF * BK * 2  , STAGE_BYTES = 8 * HTB, NXCD = 8, WGM = 8;

__host__ __device__ __forceinline__ int lds_byte(int r, int c) { const int st = (r >> 4) * 2 + (c >> 5), rr = r & 15, cc = c & 31, ob = rr * 64 + cc * 2; return st * 1024 + (ob ^ (((ob >> 9) & 1) << 5)); }
__host__ __device__ __forceinline__ void stage_rc(int b, int& R, int& C) { const int st = b / 1024, sb = b % 1024, swz = sb ^ (((sb >> 9) & 1) << 5); R = (st >> 1) * 16 + swz / 64; C = (st & 1) * 32 + (swz % 64) / 2; }
__host__ __device__ __forceinline__ int perm32(int rho) { const int n = rho >> 4, i = rho & 15; return 8 * (i >> 2) + 4 * n + (i & 3); }

struct Unit { int pm, pn; };
struct Gemm { const bf16_t* A; const bf16_t* Bt; int M, N, K, wid; };

struct StaticOrder {
    int nM, nN, nwg, G, c;
    __host__ __device__ void init(int M, int N, int G_, int c_) { nM = M / BM; nN = N / BM; nwg = nM * nN; G = G_; c = c_; }
    __host__ __device__ bool next(int i, Unit& u) const {
        const long L = (long)i * G + c; if (L >= nwg) return false;
        int wgid = (int)L; { const int q = nwg / NXCD, r = nwg % NXCD, xcd = wgid % NXCD, off = wgid / NXCD; wgid = (xcd < r ? xcd * (q + 1) : r * (q + 1) + (xcd - r) * q) + off; }
        const int nig = WGM * nN, gid = wgid / nig, fm = gid * WGM, gsz = (nM - fm) < WGM ? (nM - fm) : WGM;
        u.pm = fm + ((wgid % nig) % gsz); u.pn = (wgid % nig) / gsz; return true;
    }
    __device__ __forceinline__ void a_ready(const Unit&) const {}
    __device__ __forceinline__ void done(const Unit&) const {}
};
struct RevOrder : StaticOrder {
    __host__ __device__ bool next(int i, Unit& u) const { if (!StaticOrder::next(i, u)) return false; if (nM == 320) u.pm = 40 * (u.pm / 40) + 39 - (u.pm % 40); return true; }
};
__device__ __forceinline__ unsigned cvt_pk_bf16(float lo, float hi) { unsigned r; asm volatile("v_cvt_pk_bf16_f32 %0, %1, %2" : "=v"(r) : "v"(lo), "v"(hi)); return r; }
typedef float f32x2 __attribute__((ext_vector_type(2)));
constexpr float RMS_EPS = 1e-6f;
typedef unsigned u32x2 __attribute__((ext_vector_type(2)));
__device__ __forceinline__ float row_rstd16(const float* ssrow) {
    const f32x4 a = *(const f32x4*)(ssrow), b = *(const f32x4*)(ssrow + 4), c = *(const f32x4*)(ssrow + 8), d = *(const f32x4*)(ssrow + 12);
    const float s = ((a[0] + a[1]) + (a[2] + a[3])) + ((b[0] + b[1]) + (b[2] + b[3])) + ((c[0] + c[1]) + (c[2] + c[3])) + ((d[0] + d[1]) + (d[2] + d[3]));
    return 1.0f / sqrtf(s * (1.0f / 1024.0f) + RMS_EPS);
}
__device__ __forceinline__ float row_rstd16_coop(const float* ssrow, int fq) {
    const f32x4 a = *(const f32x4*)(ssrow + 4 * fq);
    float s = (a[0] + a[1]) + (a[2] + a[3]);
    s += __shfl_xor(s, 16); s += __shfl_xor(s, 32);
    return 1.0f / sqrtf(s * (1.0f / 1024.0f) + RMS_EPS);
}
__device__ __forceinline__ float silu_mul(float g, float u) { return g * u * __builtin_amdgcn_rcpf(1.0f + __builtin_amdgcn_exp2f(-1.4426950408889634f * g)); }

template <bool HAS_RSTD> struct EpiSwiGLU {
    static constexpr bool PERM = true, AFTER_DRAIN = false;
    bf16_t* O; int ldc; const float* ss;
    __device__ __forceinline__ void operator()(const f32x4 (&acc)[2][2][4][2], const Unit& u, int wr, int wc, int fr, int fq) const {
        const int row0 = u.pm * BM + wr * 64 + fr, col0 = u.pn * HALF + wc * 32 + 8 * fq;
        float rsv[8];
#pragma unroll
        for (int i = 0; i < 8; ++i) rsv[i] = HAS_RSTD ? row_rstd16_coop(ss + (size_t)(row0 + (i >> 2) * HALF + (i & 3) * 16) * 16, fq) : 1.0f;
#pragma unroll
        for (int ai = 0; ai < 2; ++ai)
#pragma unroll
            for (int m = 0; m < 4; ++m) {
                const int row = row0 + ai * HALF + m * 16;
                const float rs = rsv[ai * 4 + m];
                const f32x4 g0 = acc[ai][0][m][0] * rs, g1 = acc[ai][0][m][1] * rs, u0 = acc[ai][1][m][0] * rs, u1 = acc[ai][1][m][1] * rs;
                u32x4 w;
                w.x = cvt_pk_bf16(silu_mul(g0[0], u0[0]), silu_mul(g0[1], u0[1])); w.y = cvt_pk_bf16(silu_mul(g0[2], u0[2]), silu_mul(g0[3], u0[3]));
                w.z = cvt_pk_bf16(silu_mul(g1[0], u1[0]), silu_mul(g1[1], u1[1])); w.w = cvt_pk_bf16(silu_mul(g1[2], u1[2]), silu_mul(g1[3], u1[3]));
                *(u32x4*)(O + (size_t)row * ldc + col0) = w;
            }
    }
};

__device__ __forceinline__ u32x4 xchg8(u32x4 v) {
    u32x4 r;
    r.x = (unsigned)__builtin_amdgcn_update_dpp(0, (int)v.x, 0x128, 0xf, 0xf, false); r.y = (unsigned)__builtin_amdgcn_update_dpp(0, (int)v.y, 0x128, 0xf, 0xf, false);
    r.z = (unsigned)__builtin_amdgcn_update_dpp(0, (int)v.z, 0x128, 0xf, 0xf, false); r.w = (unsigned)__builtin_amdgcn_update_dpp(0, (int)v.w, 0x128, 0xf, 0xf, false);
    return r;
}
__device__ __forceinline__ void store_rows16(bf16_t* base, int ld, u32x4 w0, u32x4 w1, int fr, int fq) {
    const bool hi = (fr & 8) != 0;
    const u32x4 rcv = xchg8(hi ? w0 : w1);
    bf16_t* p = base + (size_t)(fr & 7) * ld + (hi ? 32 : 0) + 8 * fq;
    *(u32x4*)p = hi ? rcv : w0; *(u32x4*)(p + (size_t)8 * ld) = hi ? w1 : rcv;
}
__device__ __forceinline__ void load_rows16_issue(const bf16_t* base, int ld, int fr, int fq, u32x4& la, u32x4& lb) {
    const bf16_t* p = base + (size_t)(fr & 7) * ld + ((fr & 8) ? 32 : 0) + 8 * fq;
    la = *(const u32x4*)p; lb = *(const u32x4*)(p + (size_t)8 * ld);
}
__device__ __forceinline__ void load_rows16_finish(u32x4 la, u32x4 lb, int fr, u32x4& r0, u32x4& r1) {
    const bool hi = (fr & 8) != 0;
    const u32x4 rcv = xchg8(hi ? la : lb);
    r0 = hi ? rcv : la; r1 = hi ? lb : rcv;
}

template <int RES_MODE, bool WRITE_SS> struct EpiResid {
    static constexpr bool PERM = true, AFTER_DRAIN = false;
    const float* g; const float* rstd0;
    bf16_t* xb; float* ss; float alpha;
    __device__ __forceinline__ void operator()(const f32x4 (&acc)[2][2][4][2], const Unit& u, int wr, int wc, int fr, int fq) const {
        const int rowg = u.pm * BM + wr * 64, colw = u.pn * BM + wc * 64;
        f32x4 gi[2][2]; float ri[8];
        if (RES_MODE == 2) {
#pragma unroll
            for (int bj = 0; bj < 2; ++bj)
#pragma unroll
                for (int n = 0; n < 2; ++n) { const f32x4 gv = *(const f32x4*)(g + colw + 32 * bj + 8 * fq + 4 * n); gi[bj][n] = (f32x4){1.0f / gv[0], 1.0f / gv[1], 1.0f / gv[2], 1.0f / gv[3]}; }
#pragma unroll
            for (int i = 0; i < 8; ++i) ri[i] = 1.0f / rstd0[rowg + (i >> 2) * HALF + (i & 3) * 16 + fr];
        }
        bf16_t* xw = xb + (size_t)rowg * 1024 + colw;
        u32x4 la[2][4], lb[2][4];
#pragma unroll
        for (int ai = 0; ai < 2; ++ai)
#pragma unroll
            for (int m = 0; m < 4; ++m) load_rows16_issue(xw + (size_t)(ai * HALF + m * 16) * 1024, 1024, fr, fq, la[ai][m], lb[ai][m]);
#pragma unroll
        for (int ai = 0; ai < 2; ++ai)
#pragma unroll
            for (int m = 0; m < 4; ++m) {
                u32x4 q[2]; load_rows16_finish(la[ai][m], lb[ai][m], fr, q[0], q[1]);
                u32x4 w[2]; float s = 0.f;
#pragma unroll
                for (int bj = 0; bj < 2; ++bj) {
                    f32x4 r0 = (f32x4){__builtin_bit_cast(float, q[bj].x << 16), __builtin_bit_cast(float, q[bj].x & 0xffff0000u), __builtin_bit_cast(float, q[bj].y << 16), __builtin_bit_cast(float, q[bj].y & 0xffff0000u)};
                    f32x4 r1 = (f32x4){__builtin_bit_cast(float, q[bj].z << 16), __builtin_bit_cast(float, q[bj].z & 0xffff0000u), __builtin_bit_cast(float, q[bj].w << 16), __builtin_bit_cast(float, q[bj].w & 0xffff0000u)};
                    if (RES_MODE == 2) { r0 = r0 * gi[bj][0] * ri[ai * 4 + m]; r1 = r1 * gi[bj][1] * ri[ai * 4 + m]; }
                    const f32x4 v0 = r0 + acc[ai][bj][m][0] * alpha, v1 = r1 + acc[ai][bj][m][1] * alpha;
                    w[bj].x = cvt_pk_bf16(v0[0], v0[1]); w[bj].y = cvt_pk_bf16(v0[2], v0[3]); w[bj].z = cvt_pk_bf16(v1[0], v1[1]); w[bj].w = cvt_pk_bf16(v1[2], v1[3]);
                    if (WRITE_SS) s += (v0[0] * v0[0] + v0[1] * v0[1]) + (v0[2] * v0[2] + v0[3] * v0[3]) + (v1[0] * v1[0] + v1[1] * v1[1]) + (v1[2] * v1[2] + v1[3] * v1[3]);
                }
                store_rows16(xw + (size_t)(ai * HALF + m * 16) * 1024, 1024, w[0], w[1], fr, fq);
                if (WRITE_SS) { s += __shfl_xor(s, 16); s += __shfl_xor(s, 32); if (fq == 0) ss[(size_t)(rowg + ai * HALF + m * 16 + fr) * 16 + u.pn * 4 + wc] = s; }
            }
    }
};

struct EpiWin {
    static constexpr bool PERM = true, AFTER_DRAIN = false;
    const float* ss; bf16_t *ZQ, *ZK, *VT, *ZC; const float *qg, *kg;
    __device__ __forceinline__ void operator()(const f32x4 (&acc)[2][2][4][2], const Unit& u, int wr, int wc, int fr, int fq) const {
        const int row0 = u.pm * BM + wr * 64 + fr, pn = u.pn;
        float rsv[8];
#pragma unroll
        for (int i = 0; i < 8; ++i) rsv[i] = row_rstd16_coop(ss + (size_t)(row0 + (i >> 2) * HALF + (i & 3) * 16) * 16, fq);
        if (pn < 4) {
            const bool isq = pn < 2; const float* gp = (isq ? qg : kg) + 8 * fq; const float gs = isq ? 0.125f * 1.4426950408889634f : 1.0f;
            f32x4 gn[2][2];
#pragma unroll
            for (int bj = 0; bj < 2; ++bj)
#pragma unroll
                for (int n = 0; n < 2; ++n) gn[bj][n] = *(const f32x4*)(gp + 32 * bj + 4 * n) * gs;
            bf16_t* Z = (isq ? ZQ : ZK) + (pn & 1) * 256 + wc * 64 + (size_t)(u.pm * BM + wr * 64) * 512;
#pragma unroll
            for (int ai = 0; ai < 2; ++ai)
#pragma unroll
                for (int m = 0; m < 4; ++m) {
                    const int row = row0 + ai * HALF + m * 16; const float rs = rsv[ai * 4 + m];
                    f32x4 v[2][2]; float s = 0.f;
#pragma unroll
                    for (int bj = 0; bj < 2; ++bj)
#pragma unroll
                        for (int n = 0; n < 2; ++n) { v[bj][n] = acc[ai][bj][m][n] * rs; const f32x4 x = v[bj][n]; s += (x[0] * x[0] + x[1] * x[1]) + (x[2] * x[2] + x[3] * x[3]); }
                    s += __shfl_xor(s, 16); s += __shfl_xor(s, 32);
                    const float rn = 1.0f / sqrtf(s * (1.0f / 64.0f) + RMS_EPS);
                    u32x4 w[2];
#pragma unroll
                    for (int bj = 0; bj < 2; ++bj) {
                        const f32x4 a = v[bj][0] * gn[bj][0] * rn, b = v[bj][1] * gn[bj][1] * rn;
                        w[bj].x = cvt_pk_bf16(a[0], a[1]); w[bj].y = cvt_pk_bf16(a[2], a[3]); w[bj].z = cvt_pk_bf16(b[0], b[1]); w[bj].w = cvt_pk_bf16(b[2], b[3]);
                    }
                    store_rows16(Z + (size_t)(ai * HALF + m * 16) * 512, 512, w[0], w[1], fr, fq);
                }
        } else if (pn < 6) {
            const int rowt = u.pm * BM; const int S = (rowt < 65536) ? 2048 : 4096; const int h = 4 * (pn - 4) + wc;
#pragma unroll
            for (int ai = 0; ai < 2; ++ai)
#pragma unroll
                for (int m = 0; m < 4; ++m) {
                    const int row = row0 + ai * HALF + m * 16; const float rs = rsv[ai * 4 + m];
                    const int t = row & (S - 1); bf16_t* vp = VT + (size_t)(row - t) * 512 + (size_t)(h * 64 + 8 * fq) * S + t;
#pragma unroll
                    for (int bj = 0; bj < 2; ++bj)
#pragma unroll
                        for (int n = 0; n < 2; ++n) {
                            const f32x4 x = acc[ai][bj][m][n] * rs; const unsigned p0 = cvt_pk_bf16(x[0], x[1]), p1 = cvt_pk_bf16(x[2], x[3]);
                            bf16_t* q = vp + (size_t)(32 * bj + 4 * n) * S;
                            q[0] = (bf16_t)(p0 & 0xffffu); q[(size_t)S] = (bf16_t)(p0 >> 16); q[(size_t)2 * S] = (bf16_t)(p1 & 0xffffu); q[(size_t)3 * S] = (bf16_t)(p1 >> 16);
                        }
                }
        } else if (pn < 8) {
            bf16_t* Z = ZC + (pn - 6) * 256 + wc * 64 + (size_t)(u.pm * BM + wr * 64) * 1024;
#pragma unroll
            for (int ai = 0; ai < 2; ++ai)
#pragma unroll
                for (int m = 0; m < 4; ++m) {
                    const float rs = rsv[ai * 4 + m];
                    u32x4 w[2];
#pragma unroll
                    for (int bj = 0; bj < 2; ++bj) {
                        const f32x4 a = acc[ai][bj][m][0] * rs, b = acc[ai][bj][m][1] * rs;
                        w[bj].x = cvt_pk_bf16(a[0], a[1]); w[bj].y = cvt_pk_bf16(a[2], a[3]); w[bj].z = cvt_pk_bf16(b[0], b[1]); w[bj].w = cvt_pk_bf16(b[2], b[3]);
                    }
                    store_rows16(Z + (size_t)(ai * HALF + m * 16) * 1024, 1024, w[0], w[1], fr, fq);
                }
        } else {
            bf16_t* Z = ZC + 512 + (pn - 8) * 128 + wc * 32 + 8 * fq + (size_t)row0 * 1024;
#pragma unroll
            for (int ai = 0; ai < 2; ++ai)
#pragma unroll
                for (int m = 0; m < 4; ++m) {
                    const float rs = rsv[ai * 4 + m], rs2 = rs * rs;
                    const f32x4 a = acc[ai][0][m][0] * acc[ai][1][m][0] * rs2, b = acc[ai][0][m][1] * acc[ai][1][m][1] * rs2;
                    u32x4 w; w.x = cvt_pk_bf16(a[0], a[1]); w.y = cvt_pk_bf16(a[2], a[3]); w.z = cvt_pk_bf16(b[0], b[1]); w.w = cvt_pk_bf16(b[2], b[3]);
                    *(u32x4*)(Z + (size_t)(ai * HALF + m * 16) * 1024) = w;
                }
        }
    }
};

template <class Epi, class Sched, bool ALIGN_EPI = false, bool SP2 = false>
__device__ __forceinline__ void gemm_phase(PG8_LAS unsigned char* lds, const Gemm g, const Sched& S, const Epi& E) {
    const int wid = g.wid, lane = (int)__builtin_amdgcn_mbcnt_hi(~0u, __builtin_amdgcn_mbcnt_lo(~0u, 0u)), tid = wid * 64 + lane, wr = wid >> 2, wc = wid & 3, fr = lane & 15, fq = lane >> 4;
    const int K = g.K, nt = K / BK;
    unsigned voffA[2], voffB[2];
#pragma unroll
    for (int i = 0; i < 2; ++i) { int R, C; stage_rc(tid * 16 + i * 8192, R, C); const int Rb = Epi::PERM ? ((R & ~31) + perm32(R & 31)) : R;
        voffA[i] = (unsigned)(R * K + C) * 2u; voffB[i] = (unsigned)(Rb * K + C) * 2u; }
    const size_t kstep = (size_t)(BK * 2);
    const size_t hstep = (size_t)HALF * K * 2;
    const size_t tstep = 2 * hstep;
    const unsigned ldsw = (unsigned)wid * 1024u;
    const int aoff = lds_byte(wr * 64 + fr, fq * 8), boff = lds_byte(wc * 32 + fr, fq * 8);
#define PG8_SA(b, h) (((b) * 2 + (h)) * HTB)
#define PG8_SB(b, h) ((4 + (b) * 2 + (h)) * HTB)
#define PG8_STAGE(bufoff, gbase, voff) do { _Pragma("unroll") for (int _i = 0; _i < 2; ++_i) \
        __builtin_amdgcn_global_load_lds((const unsigned*)((const char*)(gbase) + (voff)[_i]), (PG8_LAS unsigned*)(lds + (bufoff) + ldsw + _i * 8192), 16, 0, 0); } while (0)
#define PG8_LDA(dst, b, h) do { _Pragma("unroll") for (int m = 0; m < 4; ++m) _Pragma("unroll") for (int k = 0; k < 2; ++k) dst[m][k] = *(const PG8_LAS bf16x8*)(lds + PG8_SA(b, h) + aoff + m * 2048 + k * 1024); } while (0)
#define PG8_LDB(dst, b, h) do { _Pragma("unroll") for (int n = 0; n < 2; ++n) _Pragma("unroll") for (int k = 0; k < 2; ++k) dst[n][k] = *(const PG8_LAS bf16x8*)(lds + PG8_SB(b, h) + boff + n * 2048 + k * 1024); } while (0)
#define PG8_MMA(ai, bj, At, Bt) do { __builtin_amdgcn_s_setprio(1); _Pragma("unroll") for (int m = 0; m < 4; ++m) _Pragma("unroll") for (int n = 0; n < 2; ++n) _Pragma("unroll") for (int k = 0; k < 2; ++k) \
        acc[ai][bj][m][n] = __builtin_amdgcn_mfma_f32_16x16x32_bf16(Bt[n][k], At[m][k], acc[ai][bj][m][n], 0, 0, 0); __builtin_amdgcn_s_setprio(0); } while (0)
#define PG8_WAIT_V(n) asm volatile("s_waitcnt vmcnt(" #n ")" ::: "memory")
#define PG8_WAIT_L(n) asm volatile("s_waitcnt lgkmcnt(" #n ")" ::: "memory")
#define PG8_BAR __builtin_amdgcn_s_barrier()
#define PG8_SCHED __builtin_amdgcn_sched_barrier(0)
    Unit cur, nxt; int ui = 0;
    if (!S.next(0, cur)) return;
    f32x4 acc[2][2][4][2];
#pragma unroll
    for (int a = 0; a < 2; ++a)
#pragma unroll
        for (int b = 0; b < 2; ++b)
#pragma unroll
            for (int m = 0; m < 4; ++m)
#pragma unroll
                for (int n = 0; n < 2; ++n) acc[a][b][m][n] = (f32x4){0.f, 0.f, 0.f, 0.f};
    bf16x8 At[4][2], B0[2][2], B1[2][2];
    const char* cA = (const char*)g.A + (size_t)cur.pm * tstep; const char* cB = (const char*)g.Bt + (size_t)cur.pn * tstep;
    S.a_ready(cur);
    if constexpr (SP2) {
        PG8_STAGE(PG8_SB(0, 0), cB, voffB); PG8_STAGE(PG8_SB(0, 1), cB + hstep, voffB); PG8_STAGE(PG8_SA(0, 0), cA, voffA); PG8_STAGE(PG8_SA(0, 1), cA + hstep, voffA);
        if (wr == 1) PG8_BAR;
        PG8_WAIT_V(2); PG8_BAR;
        PG8_STAGE(PG8_SB(1, 0), cB + kstep, voffB); PG8_STAGE(PG8_SA(1, 0), cA + kstep, voffA); PG8_STAGE(PG8_SB(1, 1), cB + hstep + kstep, voffB);
        PG8_WAIT_V(6); PG8_BAR;
    } else {
        PG8_STAGE(PG8_SB(0, 0), cB, voffB); PG8_STAGE(PG8_SA(0, 0), cA, voffA); PG8_STAGE(PG8_SB(0, 1), cB + hstep, voffB); PG8_STAGE(PG8_SA(0, 1), cA + hstep, voffA);
        if (wr == 1) PG8_BAR;
        PG8_WAIT_V(4); PG8_BAR;
        PG8_STAGE(PG8_SB(1, 0), cB + kstep, voffB); PG8_STAGE(PG8_SA(1, 0), cA + kstep, voffA); PG8_STAGE(PG8_SB(1, 1), cB + hstep + kstep, voffB);
        PG8_WAIT_V(6); PG8_BAR;
    }
    for (;;) {
        const bool has_next = S.next(ui + 1, nxt);
        const char* nA = has_next ? (const char*)g.A + (size_t)nxt.pm * tstep : cA; const char* nB = has_next ? (const char*)g.Bt + (size_t)nxt.pn * tstep : cB;
        for (int t = 0; t < nt; t += 2) {
            const bool last = (t == nt - 2);
            const char* a1 = cA + (size_t)(t + 1) * kstep;
            const char* a2 = last ? nA : cA + (size_t)(t + 2) * kstep; const char* b2 = last ? nB : cB + (size_t)(t + 2) * kstep;
            const char* a3 = a2 + kstep; const char* b3 = b2 + kstep;
            if (last && has_next) S.a_ready(nxt);
            if constexpr (SP2) {
            PG8_LDB(B0, 0, 0); PG8_LDB(B1, 0, 1); PG8_SCHED; PG8_LDA(At, 0, 0); PG8_STAGE(PG8_SA(1, 1), a1 + hstep, voffA);
            PG8_WAIT_V(8); PG8_WAIT_L(0); PG8_BAR; PG8_MMA(0, 0, At, B0); PG8_MMA(0, 1, At, B1); PG8_BAR; PG8_SCHED;
            PG8_LDA(At, 0, 1); PG8_STAGE(PG8_SB(0, 0), b2, voffB); PG8_STAGE(PG8_SB(0, 1), b2 + hstep, voffB); PG8_STAGE(PG8_SA(0, 0), a2, voffA);
            PG8_WAIT_V(8); PG8_WAIT_L(0); PG8_BAR; PG8_MMA(1, 0, At, B0); PG8_MMA(1, 1, At, B1); PG8_BAR; PG8_SCHED;
            PG8_LDB(B0, 1, 0); PG8_LDB(B1, 1, 1); PG8_SCHED; PG8_LDA(At, 1, 0); PG8_STAGE(PG8_SA(0, 1), a2 + hstep, voffA);
            PG8_WAIT_V(8); PG8_WAIT_L(0); PG8_BAR; PG8_MMA(0, 0, At, B0); PG8_MMA(0, 1, At, B1); PG8_BAR; PG8_SCHED;
            PG8_LDA(At, 1, 1); PG8_STAGE(PG8_SB(1, 0), b3, voffB); PG8_STAGE(PG8_SB(1, 1), b3 + hstep, voffB); PG8_STAGE(PG8_SA(1, 0), a3, voffA);
            PG8_WAIT_V(8); PG8_WAIT_L(0); PG8_BAR; PG8_MMA(1, 0, At, B0); PG8_MMA(1, 1, At, B1); PG8_BAR; PG8_SCHED;
            } else {
            PG8_LDB(B0, 0, 0); PG8_SCHED; PG8_LDA(At, 0, 0); PG8_STAGE(PG8_SA(1, 1), a1 + hstep, voffA);
            PG8_WAIT_L(8); PG8_BAR; PG8_WAIT_L(0); PG8_MMA(0, 0, At, B0); PG8_BAR; PG8_SCHED;
            PG8_LDB(B1, 0, 1); PG8_STAGE(PG8_SB(0, 0), b2, voffB);
            PG8_BAR; PG8_WAIT_L(0); PG8_MMA(0, 1, At, B1); PG8_BAR;
            PG8_LDA(At, 0, 1); PG8_STAGE(PG8_SA(0, 0), a2, voffA);
            PG8_BAR; PG8_WAIT_L(0); PG8_MMA(1, 0, At, B0); PG8_BAR; PG8_SCHED;
            PG8_STAGE(PG8_SB(0, 1), b2 + hstep, voffB);
            PG8_WAIT_V(6); PG8_BAR; PG8_MMA(1, 1, At, B1); PG8_BAR;
            PG8_LDB(B0, 1, 0); PG8_SCHED; PG8_LDA(At, 1, 0); PG8_STAGE(PG8_SA(0, 1), a2 + hstep, voffA);
            PG8_WAIT_L(8); PG8_BAR; PG8_WAIT_L(0); PG8_MMA(0, 0, At, B0); PG8_BAR; PG8_SCHED;
            PG8_LDB(B1, 1, 1); PG8_STAGE(PG8_SB(1, 0), b3, voffB);
            PG8_BAR; PG8_WAIT_L(0); PG8_MMA(0, 1, At, B1); PG8_BAR;
            PG8_LDA(At, 1, 1); PG8_STAGE(PG8_SA(1, 0), a3, voffA);
            PG8_BAR; PG8_WAIT_L(0); PG8_MMA(1, 0, At, B0); PG8_BAR; PG8_SCHED;
            PG8_STAGE(PG8_SB(1, 1), b3 + hstep, voffB);
            PG8_WAIT_V(6); PG8_BAR; PG8_MMA(1, 1, At, B1); PG8_BAR;
            }
        }
        if constexpr (ALIGN_EPI) { if (wr == 0) PG8_BAR; }
        if constexpr (!Epi::AFTER_DRAIN) { E(acc, cur, wr, wc, fr, fq); S.done(cur); }
        if (!has_next) break;
#pragma unroll
        for (int a = 0; a < 2; ++a)
#pragma unroll
            for (int b = 0; b < 2; ++b)
#pragma unroll
                for (int m = 0; m < 4; ++m)
#pragma unroll
                    for (int n = 0; n < 2; ++n) acc[a][b][m][n] = (f32x4){0.f, 0.f, 0.f, 0.f};
        cur = nxt; cA = nA; cB = nB; ++ui;
        if constexpr (ALIGN_EPI) { if (wr == 1) PG8_BAR; }
    }
    PG8_WAIT_V(0);
    if constexpr (!ALIGN_EPI) { if (wr == 0) PG8_BAR; }
    PG8_BAR;
    if constexpr (Epi::AFTER_DRAIN) { E.fused(acc, cur, wr, wc, fr, fq, lds, wid, lane); S.done(cur); }
#undef PG8_SA
#undef PG8_SB
#undef PG8_STAGE
#undef PG8_LDA
#undef PG8_LDB
#undef PG8_MMA
#undef PG8_WAIT_V
#undef PG8_WAIT_L
#undef PG8_BAR
#undef PG8_SCHED
}
}
#define GAS __attribute__((address_space(1)))
#define LAS __attribute__((address_space(3)))
typedef unsigned short bf16;
typedef unsigned v4u __attribute__((ext_vector_type(4)));
typedef unsigned v2u __attribute__((ext_vector_type(2)));
typedef float f32x4 __attribute__((ext_vector_type(4)));
typedef short bf16x8 __attribute__((ext_vector_type(8)));
typedef short s16x4 __attribute__((ext_vector_type(4)));
#define LDS_WAIT() asm volatile("s_waitcnt lgkmcnt(0)" ::: "memory")

constexpr int NWAVES = 8;
constexpr int M_TOK = 81920, MP = 65536, D = 1024, FF = 2816, NGU = 2 * FF, DIN = 3072;
constexpr float EPSF = 1e-6f;
constexpr size_t MiB = 1u << 20;
constexpr size_t WS_CTL = 0, CTL_ZERO_BYTES = 65536;
constexpr size_t WS_W1GU = 1 * MiB, WS_W1D = 12 * MiB, WS_WIN = 18 * MiB, WS_WOUT = 24 * MiB, WS_W2GU = 26 * MiB, WS_W2D = 37 * MiB;
constexpr size_t WS_SS1 = 44 * MiB, WS_SS2 = 50 * MiB, WS_RS0 = 56 * MiB;
constexpr size_t WS_XB = 64 * MiB;
constexpr size_t WS_ACT = 224 * MiB;
constexpr size_t WS_ZQ = WS_ACT, WS_ZK = WS_ACT + 80 * MiB, WS_VT = WS_ACT + 160 * MiB, WS_ZC = WS_ACT + 240 * MiB;
constexpr size_t WS_AC = 704 * MiB;
constexpr size_t WS_END = 864 * MiB;
constexpr int RING_BYTES = 131072, LDS_BYTES = 147456;

__device__ __forceinline__ unsigned f2bf(float f) { unsigned u = __builtin_bit_cast(unsigned, f); return (u + 0x7fffu + ((u >> 16) & 1u)) >> 16; }
__device__ __forceinline__ unsigned pk2(float lo, float hi) { return f2bf(lo) | (f2bf(hi) << 16); }
__device__ __forceinline__ float bflo(unsigned w) { return __builtin_bit_cast(float, w << 16); }
__device__ __forceinline__ float bfhi(unsigned w) { return __builtin_bit_cast(float, w & 0xffff0000u); }
__device__ __forceinline__ float wave_sum(float v) {
#pragma unroll
    for (int o = 1; o < 64; o <<= 1) v += __shfl_xor(v, o);
    return v;
}

__device__ __forceinline__ void p0_transpose_item(const float* W, int K, int N, bf16* WT, const float* gain, int kind, LAS float* scr, int item, int lane) {
    const int nblk = N / 32, kb = item / nblk, nb = item % nblk, k0 = 64 * kb, n0 = 32 * nb;
    int rowbase = n0;
    if (kind == 1) rowbase = (n0 >> 7) * 256 + (n0 & 127);
    else if (kind == 2) rowbase = (n0 >> 7) * 256 + 128 + (n0 & 127);
    else if (kind == 3 || (kind == 4 && n0 < 2048)) rowbase = (n0 & ~255) + 128 * ((n0 >> 5) & 1) + 32 * ((n0 >> 6) & 3);
    else if (kind == 4) { const int isx = n0 >= 2560, ch0 = (n0 - 2048) & 511; rowbase = 256 * (8 + (ch0 >> 7)) + 128 * isx + 32 * ((ch0 >> 5) & 3); }
#pragma unroll 8
    for (int i = 0; i < 32; ++i) { const int kk = 2 * i + (lane >> 5); const float g = gain ? gain[k0 + kk] : 1.0f; scr[kk * 33 + (lane & 31)] = W[(size_t)(k0 + kk) * N + n0 + (lane & 31)] * g; }
    LDS_WAIT(); asm volatile("" ::: "memory");
    const int c = lane & 7;
#pragma unroll
    for (int j = 0; j < 4; ++j) { const int n = (lane >> 3) + 8 * j; const LAS float* s = scr + (8 * c) * 33 + n;
        v4u o; o.x = pk2(s[0 * 33], s[1 * 33]); o.y = pk2(s[2 * 33], s[3 * 33]); o.z = pk2(s[4 * 33], s[5 * 33]); o.w = pk2(s[6 * 33], s[7 * 33]);
        *(v4u*)(WT + (size_t)(rowbase + n) * K + k0 + 8 * c) = o; }
    LDS_WAIT(); asm volatile("" ::: "memory");
}

struct Args {
    const float* in[20]; float* out; unsigned char* ws; int ph_lo, ph_hi;
};
enum { I_XP = 0, I_XS, I_F1N, I_F1G, I_F1U, I_F1D, I_MIXN, I_WIN, I_QN, I_KN, I_RPB, I_CW, I_AON, I_CON, I_WOUT, I_F2N, I_F2G, I_F2U, I_F2D, I_FINN };

__device__ __forceinline__ void p0_prologue(const Args& A, LAS unsigned char* lds, int gw, int NGW, int wave, int lane) {
    unsigned char* ws = A.ws;
    LAS float* scr = (LAS float*)(lds + wave * 16384);
    constexpr int I_G = (D / 64) * (FF / 32), I_DN = (FF / 64) * (D / 32), I_IN = (D / 64) * (DIN / 32), I_OUT = (D / 64) * (D / 32);
    constexpr int NITEMS = 2 * (2 * I_G + I_DN) + I_IN + I_OUT;
    for (int it = gw; it < NITEMS; it += NGW) {
        int r = it;
        if (r < I_G) { p0_transpose_item(A.in[I_F1G], D, FF, (bf16*)(ws + WS_W1GU), nullptr, 1, scr, r, lane); continue; } r -= I_G;
        if (r < I_G) { p0_transpose_item(A.in[I_F1U], D, FF, (bf16*)(ws + WS_W1GU), nullptr, 2, scr, r, lane); continue; } r -= I_G;
        if (r < I_DN) { p0_transpose_item(A.in[I_F1D], FF, D, (bf16*)(ws + WS_W1D), nullptr, 3, scr, r, lane); continue; } r -= I_DN;
        if (r < I_G) { p0_transpose_item(A.in[I_F2G], D, FF, (bf16*)(ws + WS_W2GU), A.in[I_F2N], 1, scr, r, lane); continue; } r -= I_G;
        if (r < I_G) { p0_transpose_item(A.in[I_F2U], D, FF, (bf16*)(ws + WS_W2GU), A.in[I_F2N], 2, scr, r, lane); continue; } r -= I_G;
        if (r < I_DN) { p0_transpose_item(A.in[I_F2D], FF, D, (bf16*)(ws + WS_W2D), nullptr, 3, scr, r, lane); continue; } r -= I_DN;
        if (r < I_IN) { p0_transpose_item(A.in[I_WIN], D, DIN, (bf16*)(ws + WS_WIN), A.in[I_MIXN], 4, scr, r, lane); continue; } r -= I_IN;
        p0_transpose_item(A.in[I_WOUT], D, D, (bf16*)(ws + WS_WOUT), nullptr, 3, scr, r, lane);
    }
    const f32x4* gp = (const f32x4*)A.in[I_F1N] + lane;
    f32x4 gv[4];
#pragma unroll
    for (int j = 0; j < 4; ++j) gv[j] = gp[64 * j];
    bf16* XN = (bf16*)(ws + WS_XB);
    for (int m = gw; m < M_TOK; m += 2 * NGW) {
        const int m2 = m + NGW;
        const float* xrow = (m < MP) ? A.in[I_XP] + (size_t)m * D : A.in[I_XS] + (size_t)(m - MP) * D;
        const float* xrow2 = (m2 < MP) ? A.in[I_XP] + (size_t)m2 * D : A.in[I_XS] + (size_t)(m2 - MP) * D;
        const f32x4* xr = (const f32x4*)xrow + lane; const f32x4* xr2 = (const f32x4*)xrow2 + lane; f32x4 v[4], v2[4]; float s = 0.f, s2 = 0.f;
#pragma unroll
        for (int j = 0; j < 4; ++j) { v[j] = __builtin_nontemporal_load(xr + 64 * j); v2[j] = __builtin_nontemporal_load(xr2 + 64 * j); }
#pragma unroll
        for (int j = 0; j < 4; ++j) { s += (v[j].x * v[j].x + v[j].y * v[j].y) + (v[j].z * v[j].z + v[j].w * v[j].w); s2 += (v2[j].x * v2[j].x + v2[j].y * v2[j].y) + (v2[j].z * v2[j].z + v2[j].w * v2[j].w); }
        const float rstd = 1.0f / sqrtf(wave_sum(s) * (1.0f / D) + EPSF), rstd2 = 1.0f / sqrtf(wave_sum(s2) * (1.0f / D) + EPSF);
        unsigned long long* o8 = (unsigned long long*)(XN + (size_t)m * D) + lane; unsigned long long* o82 = (unsigned long long*)(XN + (size_t)m2 * D) + lane;
        if (lane == 0) { float* rs0 = (float*)(ws + WS_RS0); rs0[m] = rstd; rs0[m2] = rstd2; }
#pragma unroll
        for (int j = 0; j < 4; ++j) { const f32x4 y = v[j] * rstd * gv[j]; o8[64 * j] = (unsigned long long)pk2(y.x, y.y) | ((unsigned long long)pk2(y.z, y.w) << 32);
            const f32x4 y2 = v2[j] * rstd2 * gv[j]; o82[64 * j] = (unsigned long long)pk2(y2.x, y2.y) | ((unsigned long long)pk2(y2.z, y2.w) << 32); }
    }
}

__device__ __forceinline__ void final_norm_phase(const Args& A, int gw, int NGW, int lane) {
    const float* gp = A.in[I_FINN] + 8 * lane;
    const f32x4 g0 = *(const f32x4*)(gp), g1 = *(const f32x4*)(gp + 4), g2 = *(const f32x4*)(gp + 512), g3 = *(const f32x4*)(gp + 516);
    const bf16* XB = (const bf16*)(A.ws + WS_XB);
    for (int m = gw; m < M_TOK; m += 4 * NGW) {
        v4u a[4], b[4];
#pragma unroll
        for (int i = 0; i < 4; ++i) { const bf16* xr = XB + (size_t)(m + i * NGW) * D + 8 * lane; a[i] = *(const v4u*)(xr); b[i] = *(const v4u*)(xr + 512); }
#pragma unroll
        for (int i = 0; i < 4; ++i) {
            const f32x4 v0 = (f32x4){bflo(a[i].x), bfhi(a[i].x), bflo(a[i].y), bfhi(a[i].y)}, v1 = (f32x4){bflo(a[i].z), bfhi(a[i].z), bflo(a[i].w), bfhi(a[i].w)};
            const f32x4 v2 = (f32x4){bflo(b[i].x), bfhi(b[i].x), bflo(b[i].y), bfhi(b[i].y)}, v3 = (f32x4){bflo(b[i].z), bfhi(b[i].z), bflo(b[i].w), bfhi(b[i].w)};
            const float s = (v0.x * v0.x + v0.y * v0.y) + (v0.z * v0.z + v0.w * v0.w) + (v1.x * v1.x + v1.y * v1.y) + (v1.z * v1.z + v1.w * v1.w)
                          + (v2.x * v2.x + v2.y * v2.y) + (v2.z * v2.z + v2.w * v2.w) + (v3.x * v3.x + v3.y * v3.y) + (v3.z * v3.z + v3.w * v3.w);
            const float rstd = 1.0f / sqrtf(wave_sum(s) * (1.0f / D) + EPSF);
            float* o = A.out + (size_t)(m + i * NGW) * D + 8 * lane;
            *(f32x4*)(o) = v0 * rstd * g0; *(f32x4*)(o + 4) = v1 * rstd * g1; *(f32x4*)(o + 512) = v2 * rstd * g2; *(f32x4*)(o + 516) = v3 * rstd * g3;
        }
    }
}

constexpr int RPB_OFF = 256, RPB_N = 8 * 15 * 31;
__device__ __forceinline__ void attn_finish(f32x4 (&o)[4], float sum, const float* aogp  , bf16* op) {
    const float il = 1.0f / sum; float q2 = 0.f;
#pragma unroll
    for (int mt = 0; mt < 4; ++mt) { o[mt] = o[mt] * il; q2 += (o[mt][0] * o[mt][0] + o[mt][1] * o[mt][1]) + (o[mt][2] * o[mt][2] + o[mt][3] * o[mt][3]); }
    q2 += __shfl_xor(q2, 16); q2 += __shfl_xor(q2, 32);
    const float rn = 1.0f / sqrtf(q2 * (1.0f / 64.0f) + EPSF);
#pragma unroll
    for (int mt = 0; mt < 4; ++mt) { const f32x4 y = o[mt] * rn * *(const f32x4*)(aogp + 16 * mt); v2u w; w.x = pg8::cvt_pk_bf16(y[0], y[1]); w.y = pg8::cvt_pk_bf16(y[2], y[3]); *(v2u*)(op + 16 * mt) = w; }
}
template <int STEP>
__device__ __forceinline__ void attn_quad(const bf16* ZQ, const bf16* ZK, const bf16* VT, bf16* AC, const LAS float* rpbL, const float* aogp,
                                          int seqbase, int S, int rA, int rs0, int h, int qc, int l, int g) {
    constexpr int NU = 8 + 3 * STEP;
    const int w0 = (qc == 0) ? 0 : (qc == 1) ? 8 : (qc == 2) ? 24 : 32;
    const int c = 16 * qc + l; int cs = c - 8; cs = cs < 0 ? 0 : cs; cs = cs > 48 ? 48 : cs;
    const size_t qtok0 = (size_t)seqbase + rA * 64 + c;
    bf16x8 qf[4][2];
#pragma unroll
    for (int i = 0; i < 4; ++i)
#pragma unroll
        for (int ks = 0; ks < 2; ++ks) qf[i][ks] = *(const bf16x8*)(ZQ + (qtok0 + 64 * i) * 512 + h * 64 + ks * 32 + 8 * g);
    const bf16* kp = ZK + ((size_t)seqbase + rs0 * 64 + w0 + 8 * (l >> 2) + (l & 3)) * 512 + h * 64 + 8 * g;
    const bf16* vp = VT + (size_t)seqbase * 512 + (size_t)(h * 64 + l) * S + rs0 * 64 + w0 + 8 * g;
    const int kc0 = w0 + 8 * g;
    bool valid[2][4];
#pragma unroll
    for (int hf = 0; hf < 2; ++hf)
#pragma unroll
        for (int j = 0; j < 4; ++j) valid[hf][j] = (unsigned)(kc0 + 4 * hf + j - cs) < 16u;
    const LAS float* bp0 = rpbL + h * 465 + (rs0 - rA + 7) * 31 + (kc0 - c + 15);
    f32x4 o[4][4]; float sum[4];
#pragma unroll
    for (int i = 0; i < 4; ++i) { sum[i] = 0.f;
#pragma unroll
        for (int mt = 0; mt < 4; ++mt) o[i][mt] = (f32x4){0.f, 0.f, 0.f, 0.f}; }
    bf16x8 kn[2][2]; v4u vn[4];
#pragma unroll
    for (int hf = 0; hf < 2; ++hf) { const bf16* kt = kp + (size_t)(hf * 4) * 512; kn[hf][0] = *(const bf16x8*)(kt); kn[hf][1] = *(const bf16x8*)(kt + 32); }
#pragma unroll
    for (int mt = 0; mt < 4; ++mt) vn[mt] = *(const v4u*)(vp + (size_t)(16 * mt) * S);
#pragma unroll 1
    for (int u = 0; u < NU; ++u) {
        bf16x8 kf[2][2]; v4u vf[4];
#pragma unroll
        for (int hf = 0; hf < 2; ++hf) { kf[hf][0] = kn[hf][0]; kf[hf][1] = kn[hf][1]; }
#pragma unroll
        for (int mt = 0; mt < 4; ++mt) vf[mt] = vn[mt];
        if (u + 1 < NU) {
#pragma unroll
            for (int hf = 0; hf < 2; ++hf) { const bf16* kt = kp + (size_t)((u + 1) * 64 + hf * 4) * 512; kn[hf][0] = *(const bf16x8*)(kt); kn[hf][1] = *(const bf16x8*)(kt + 32); }
#pragma unroll
            for (int mt = 0; mt < 4; ++mt) vn[mt] = *(const v4u*)(vp + (size_t)(16 * mt) * S + (u + 1) * 64);
        }
#pragma unroll
        for (int i = 0; i < 4; ++i) {
            if ((unsigned)(u - i * STEP) < 8u) {
                f32x4 s0 = {0.f, 0.f, 0.f, 0.f}, s1 = {0.f, 0.f, 0.f, 0.f};
                s0 = __builtin_amdgcn_mfma_f32_16x16x32_bf16(kf[0][0], qf[i][0], s0, 0, 0, 0); s0 = __builtin_amdgcn_mfma_f32_16x16x32_bf16(kf[0][1], qf[i][1], s0, 0, 0, 0);
                s1 = __builtin_amdgcn_mfma_f32_16x16x32_bf16(kf[1][0], qf[i][0], s1, 0, 0, 0); s1 = __builtin_amdgcn_mfma_f32_16x16x32_bf16(kf[1][1], qf[i][1], s1, 0, 0, 0);
                const LAS float* bp = bp0 + (u - i) * 31;
                float p0[4], p1[4];
#pragma unroll
                for (int j = 0; j < 4; ++j) { p0[j] = valid[0][j] ? __builtin_amdgcn_exp2f(s0[j] + bp[j]) : 0.f; p1[j] = valid[1][j] ? __builtin_amdgcn_exp2f(s1[j] + bp[4 + j]) : 0.f; }
                sum[i] += ((p0[0] + p0[1]) + (p0[2] + p0[3])) + ((p1[0] + p1[1]) + (p1[2] + p1[3]));
                v4u pw; pw.x = pg8::cvt_pk_bf16(p0[0], p0[1]); pw.y = pg8::cvt_pk_bf16(p0[2], p0[3]); pw.z = pg8::cvt_pk_bf16(p1[0], p1[1]); pw.w = pg8::cvt_pk_bf16(p1[2], p1[3]);
                const bf16x8 pf = __builtin_bit_cast(bf16x8, pw);
#pragma unroll
                for (int mt = 0; mt < 4; ++mt) o[i][mt] = __builtin_amdgcn_mfma_f32_16x16x32_bf16(__builtin_bit_cast(bf16x8, vf[mt]), pf, o[i][mt], 0, 0, 0);
            }
        }
    }
#pragma unroll
    for (int i = 0; i < 4; ++i) {
        float sm = sum[i]; sm += __shfl_xor(sm, 16); sm += __shfl_xor(sm, 32);
        attn_finish(o[i], sm, aogp, AC + (qtok0 + 64 * i) * 1024 + h * 64 + 4 * g);
    }
}

__device__ __forceinline__ void attn_conv_phase(const Args& A, LAS unsigned char* lds, int wave, int lane) {
    unsigned char* ws = A.ws;
    const bf16* ZQ = (const bf16*)(ws + WS_ZQ); const bf16* ZK = (const bf16*)(ws + WS_ZK); const bf16* VT = (const bf16*)(ws + WS_VT); const bf16* ZC = (const bf16*)(ws + WS_ZC);
    bf16* AC = (bf16*)(ws + WS_AC);
    LAS float* rpbL = (LAS float*)(lds + RPB_OFF);
    float cb;
    { const float mq = fabsf(A.in[I_QN][lane]), mk = fabsf(A.in[I_KN][lane]); float mqw = mq, mkw = mk, mb = 0.f;
      for (int i = lane; i < RPB_N; i += 64) mb = fmaxf(mb, fabsf(A.in[I_RPB][i]));
#pragma unroll
      for (int o_ = 1; o_ < 64; o_ <<= 1) { mqw = fmaxf(mqw, __shfl_xor(mqw, o_)); mkw = fmaxf(mkw, __shfl_xor(mkw, o_)); mb = fmaxf(mb, __shfl_xor(mb, o_)); }
      cb = 11.5416f * 1.01f * mqw * mkw + 1.4426950408889634f * mb; }
    for (int i = wave * 64 + lane; i < RPB_N; i += NWAVES * 64) rpbL[i] = A.in[I_RPB][i] * 1.4426950408889634f - cb;
    __syncthreads();
    const int l = lane & 15, g = lane >> 4;
#if PROBE_DUP == 44
#pragma unroll 1
    for (int rep_ = 0; rep_ < 2; ++rep_)
#endif
    const int G_ = (int)gridDim.x, vcu_ = (G_ % 8 == 0) ? ((int)blockIdx.x % 8) * (G_ / 8) + (int)blockIdx.x / 8 : (int)blockIdx.x;
    for (int ui_ = 0; ui_ < 5; ++ui_) {
        const int unit = (G_ == 256) ? 32 * (5 * (vcu_ >> 5) + (4 - ui_)) + (vcu_ & 31) : vcu_ + ui_ * G_;
        if (unit >= 1280) break;
        const int quad = unit >> 2, hq = unit & 3;
        int seqbase, rA, S, rows;
        if (quad < 256) { seqbase = (quad >> 3) * 2048; rA = 4 * (quad & 7); S = 2048; rows = 32; }
        else { const int q2 = quad - 256; seqbase = MP + (q2 >> 4) * 4096; rA = 4 * (q2 & 15); S = 4096; rows = 64; }
        int rs0 = rA - 4; rs0 = rs0 < 0 ? 0 : rs0; rs0 = rs0 > rows - 8 ? rows - 8 : rs0;
        int rs1 = rA - 3; rs1 = rs1 < 0 ? 0 : rs1; rs1 = rs1 > rows - 8 ? rows - 8 : rs1;
        const int h = 2 * hq + (wave & 1), qc = wave >> 1;
        const float* aogp = A.in[I_AON] + h * 64 + 4 * g;
        if (rs1 != rs0) attn_quad<1>(ZQ, ZK, VT, AC, rpbL, aogp, seqbase, S, rA, rs0, h, qc, l, g);
        else attn_quad<0>(ZQ, ZK, VT, AC, rpbL, aogp, seqbase, S, rA, rs0, h, qc, l, g);
        const int r = rA + hq;
        {
            const int ch = 8 * lane; const float* cw = A.in[I_CW];
            f32x4 w0a = *(const f32x4*)(cw + ch), w0b = *(const f32x4*)(cw + ch + 4), w1a = *(const f32x4*)(cw + 512 + ch), w1b = *(const f32x4*)(cw + 512 + ch + 4);
            f32x4 w2a = *(const f32x4*)(cw + 1024 + ch), w2b = *(const f32x4*)(cw + 1024 + ch + 4);
            f32x4 cga = *(const f32x4*)(A.in[I_CON] + ch), cgb = *(const f32x4*)(A.in[I_CON] + ch + 4);
            const int t0 = r * 64 + 8 * wave;
            f32x4 upa, upb, uca, ucb, una, unb;
#define LOAD_U(tt, ua, ub) do { const int t_ = (tt); if (t_ >= 0 && t_ < S) { const v4u x_ = *(const v4u*)(ZC + ((size_t)seqbase + t_) * 1024 + 512 + ch); \
                ua = (f32x4){bflo(x_.x), bfhi(x_.x), bflo(x_.y), bfhi(x_.y)}; ub = (f32x4){bflo(x_.z), bfhi(x_.z), bflo(x_.w), bfhi(x_.w)}; } \
                else { ua = (f32x4){0.f, 0.f, 0.f, 0.f}; ub = ua; } } while (0)
            LOAD_U(t0 - 1, upa, upb); LOAD_U(t0, uca, ucb);
#pragma unroll 2
            for (int i = 0; i < 8; ++i) {
                const int t = t0 + i;
                LOAD_U(t + 1, una, unb);
                const v4u b_ = *(const v4u*)(ZC + ((size_t)seqbase + t) * 1024 + ch);
                const f32x4 gba = (f32x4){bflo(b_.x), bfhi(b_.x), bflo(b_.y), bfhi(b_.y)}, gbb = (f32x4){bflo(b_.z), bfhi(b_.z), bflo(b_.w), bfhi(b_.w)};
                const f32x4 ya = gba * (upa * w0a + uca * w1a + una * w2a), yb = gbb * (upb * w0b + ucb * w1b + unb * w2b);
                float q2 = (ya[0] * ya[0] + ya[1] * ya[1]) + (ya[2] * ya[2] + ya[3] * ya[3]) + (yb[0] * yb[0] + yb[1] * yb[1]) + (yb[2] * yb[2] + yb[3] * yb[3]);
                q2 += __shfl_xor(q2, 1); q2 += __shfl_xor(q2, 2); q2 += __shfl_xor(q2, 4);
                const float rn = 1.0f / sqrtf(q2 * (1.0f / 64.0f) + EPSF);
                const f32x4 oa = ya * rn * cga, ob = yb * rn * cgb;
                v4u w; w.x = pg8::cvt_pk_bf16(oa[0], oa[1]); w.y = pg8::cvt_pk_bf16(oa[2], oa[3]); w.z = pg8::cvt_pk_bf16(ob[0], ob[1]); w.w = pg8::cvt_pk_bf16(ob[2], ob[3]);
                *(v4u*)(AC + ((size_t)seqbase + t) * 1024 + 512 + ch) = w;
                upa = uca; upb = ucb; uca = una; ucb = unb;
            }
#undef LOAD_U
        }
    }
    __syncthreads();
}

typedef GAS unsigned gu32;
#define XB_TMO      128
#define XB_XCNT(j)  (256  + 64 * (j))
#define XB_XSUB(j)  (1280 + 64 * (j))
#define XB_XGEN(j)  (2304 + 64 * (j))
#define XB_TOP      3328
#define XB_TOPGEN   3392
#define XCD_BAR_WORDS 3456
#define XB_SPIN_CAP (1u << 18)

__device__ __forceinline__ unsigned xb_ld(unsigned* p)              { return __hip_atomic_load(p, __ATOMIC_RELAXED, __HIP_MEMORY_SCOPE_AGENT); }
__device__ __forceinline__ unsigned xb_add(unsigned* p, unsigned v) { return __hip_atomic_fetch_add(p, v, __ATOMIC_RELAXED, __HIP_MEMORY_SCOPE_AGENT); }
__device__ __forceinline__ unsigned xb_xcc_id() { return (unsigned)__builtin_amdgcn_s_getreg((3 << 11) | 20) & 0xFu; }
#define XB_SPIN(cond, bar) do { unsigned _sp = 0; while (cond) { __builtin_amdgcn_s_sleep(1); \
    if ((++_sp & 255u) == 0u) { if (xb_ld(&(bar)[XB_TMO])) break; if (_sp > XB_SPIN_CAP) { atomicAdd(&(bar)[XB_TMO], 1u); break; } } } } while (0)

struct XcdBarrier {
    unsigned* bar; unsigned x;
    volatile LAS unsigned* st;
};

__device__ __forceinline__ XcdBarrier xcd_barrier_post(unsigned* bar, volatile LAS unsigned* st, bool t0) {
    XcdBarrier b; b.bar = bar; b.x = xb_xcc_id(); b.st = st;
    if (t0) (void)xb_add(&bar[XB_XCNT(b.x)], 1u);
    return b;
}
__device__ __forceinline__ void xcd_barrier_complete(unsigned* bar, unsigned x, unsigned& nloc, unsigned& nx) {
    const unsigned G = gridDim.x * gridDim.y * gridDim.z;
    unsigned sum, cnt, mine, sp = 0u;
    for (;;) {
        sum = 0u; cnt = 0u; mine = 0u;
#pragma unroll
        for (unsigned j = 0; j < 16; ++j) { const unsigned c = xb_ld(&bar[XB_XCNT(j)]); sum += c; cnt += (c > 0u) ? 1u : 0u; mine = (j == x) ? c : mine; }
        if (sum == G) break;
        __builtin_amdgcn_s_sleep(1);
        if ((++sp & 255u) == 0u) { if (xb_ld(&bar[XB_TMO])) break; if (sp > XB_SPIN_CAP) { atomicAdd(&bar[XB_TMO], 1u); break; } }
    }
    nloc = mine > 0u ? mine : 1u; nx = cnt > 0u ? cnt : 1u;
}

__device__ __forceinline__ void xcd_barrier(const XcdBarrier& b, bool t0) {
    asm volatile("s_waitcnt vmcnt(0)" ::: "memory");
    __syncthreads();
    if (t0) {
        unsigned* bar = b.bar;
        __builtin_amdgcn_s_waitcnt(0);
        unsigned nloc = b.st[0], nx = b.st[1];
        if (nloc == 0u) { xcd_barrier_complete(bar, b.x, nloc, nx); b.st[0] = nloc; b.st[1] = nx; }
        const unsigned old = xb_add(&bar[XB_XSUB(b.x)], 1u);
        const unsigned gen = old / nloc;
        if (old + 1u == (gen + 1u) * nloc) {
            __builtin_amdgcn_fence(__ATOMIC_RELEASE, "agent");
            asm volatile("s_waitcnt vmcnt(0)" ::: "memory");
            const unsigned og = xb_add(&bar[XB_TOP], 1u);
            const unsigned tg = og / nx;
            if (og + 1u == (tg + 1u) * nx) xb_add(&bar[XB_TOPGEN], 1u);
            else XB_SPIN(xb_ld(&bar[XB_TOPGEN]) == tg, bar);
            __builtin_amdgcn_fence(__ATOMIC_ACQUIRE, "agent");
            xb_add(&bar[XB_XGEN(b.x)], 1u);
            asm volatile("s_waitcnt vmcnt(0)" ::: "memory");
        } else {
            XB_SPIN(xb_ld(&bar[XB_XGEN(b.x)]) == gen, bar);
            __builtin_amdgcn_fence(__ATOMIC_ACQUIRE, "agent");
            asm volatile("s_waitcnt vmcnt(0)" ::: "memory");
        }
    }
    __syncthreads();
}

#ifndef PROBE_DUP
#define PROBE_DUP -1
#endif
__global__ void __launch_bounds__(NWAVES * 64, 2) enc_fwd(Args args) {
    extern __shared__ __attribute__((aligned(16))) unsigned char lds_raw[];
    LAS unsigned char* lds = (LAS unsigned char*)lds_raw;
    cg::grid_group grid = cg::this_grid();
    const int G = gridDim.x; const int bx = blockIdx.x;
    const int vcu = (G % 8 == 0) ? (bx % 8) * (G / 8) + bx / 8 : bx;
    const int NGW = G * NWAVES;
    const int wave = __builtin_amdgcn_readfirstlane((int)threadIdx.x >> 6);
#define FRESH_IDS() int lane_ = (int)__builtin_amdgcn_mbcnt_hi(~0u, __builtin_amdgcn_mbcnt_lo(~0u, 0u)); asm volatile("" : "+v"(lane_)); const int lane = lane_, gw = vcu * NWAVES + wave; (void)gw; (void)lane
    unsigned char* ws = args.ws;
    const int lo = args.ph_lo, hi = args.ph_hi;
#define IN(k) (lo <= (k) && (k) < hi)
    volatile LAS unsigned* MISC = (volatile LAS unsigned*)(lds + RING_BYTES + 1024);
    const bool t0 = (wave == 0) && ((int)__builtin_amdgcn_mbcnt_hi(~0u, __builtin_amdgcn_mbcnt_lo(~0u, 0u)) == 0);
    if (t0) { MISC[0] = 0u; MISC[1] = 0u; }
    __syncthreads();
    XcdBarrier xbar = xcd_barrier_post((unsigned*)(ws + WS_CTL) + 1024, MISC, t0 && (hi - lo) > 1);
#define SEAM(k) do { if (IN(k) && IN((k) + 1)) { if ((k) == 0) grid.sync(); else xcd_barrier(xbar, (wave == 0) && ((int)__builtin_amdgcn_mbcnt_hi(~0u, __builtin_amdgcn_mbcnt_lo(~0u, 0u)) == 0)); } } while (0)
    bf16* XB = (bf16*)(ws + WS_XB); bf16* ACT = (bf16*)(ws + WS_ACT); bf16* ACB = (bf16*)(ws + WS_AC);
    float* SS1 = (float*)(ws + WS_SS1); float* SS2 = (float*)(ws + WS_SS2);

    if (IN(0)) { FRESH_IDS(); p0_prologue(args, lds, gw, NGW, wave, lane); __syncthreads(); }
#if PROBE_DUP == 0
    if (IN(0)) { FRESH_IDS(); p0_prologue(args, lds, gw, NGW, wave, lane); __syncthreads(); }
#endif
    SEAM(0);
    if (IN(1)) { pg8::Gemm g{XB, (const bf16*)(ws + WS_W1GU), M_TOK, NGU, D, wave}; pg8::StaticOrder S; S.init(M_TOK, NGU, G, bx);
        pg8::EpiSwiGLU<false> E{ACT, FF, nullptr};
        pg8::gemm_phase<pg8::EpiSwiGLU<false>, pg8::StaticOrder, true, true>(lds, g, S, E); }
#if PROBE_DUP == 1
    if (IN(1)) { pg8::Gemm g{XB, (const bf16*)(ws + WS_W1GU), M_TOK, NGU, D, wave}; pg8::StaticOrder S; S.init(M_TOK, NGU, G, bx);
        pg8::EpiSwiGLU<false> E{ACT, FF, nullptr};
        pg8::gemm_phase<pg8::EpiSwiGLU<false>, pg8::StaticOrder, true, true>(lds, g, S, E); }
#endif
    SEAM(1);
    if (IN(2)) { pg8::Gemm g{ACT, (const bf16*)(ws + WS_W1D), M_TOK, D, FF, wave}; pg8::RevOrder S; S.init(M_TOK, D, G, bx);
        pg8::EpiResid<2, true> E{args.in[I_F1N], (const float*)(ws + WS_RS0), XB, SS1, 0.5f};
        pg8::gemm_phase<pg8::EpiResid<2, true>, pg8::RevOrder, true, true>(lds, g, S, E); }
#if PROBE_DUP == 2
    if (IN(2)) { pg8::Gemm g{ACT, (const bf16*)(ws + WS_W1D), M_TOK, D, FF, wave}; pg8::RevOrder S; S.init(M_TOK, D, G, bx);
        pg8::EpiResid<2, true> E{args.in[I_F1N], (const float*)(ws + WS_RS0), XB, SS1, 0.5f};
        pg8::gemm_phase<pg8::EpiResid<2, true>, pg8::RevOrder, true, true>(lds, g, S, E); }
#endif
    SEAM(2);
    if (IN(3)) { pg8::Gemm g{XB, (const bf16*)(ws + WS_WIN), M_TOK, DIN, D, wave}; pg8::StaticOrder S; S.init(M_TOK, DIN, G, bx);
        pg8::EpiWin E{SS1, (bf16*)(ws + WS_ZQ), (bf16*)(ws + WS_ZK), (bf16*)(ws + WS_VT), (bf16*)(ws + WS_ZC), args.in[I_QN], args.in[I_KN]};
        pg8::gemm_phase<pg8::EpiWin, pg8::StaticOrder, true, true>(lds, g, S, E); }
#if PROBE_DUP == 3
    if (IN(3)) { pg8::Gemm g{XB, (const bf16*)(ws + WS_WIN), M_TOK, DIN, D, wave}; pg8::StaticOrder S; S.init(M_TOK, DIN, G, bx);
        pg8::EpiWin E{SS1, (bf16*)(ws + WS_ZQ), (bf16*)(ws + WS_ZK), (bf16*)(ws + WS_VT), (bf16*)(ws + WS_ZC), args.in[I_QN], args.in[I_KN]};
        pg8::gemm_phase<pg8::EpiWin, pg8::StaticOrder, true, true>(lds, g, S, E); }
#endif
    SEAM(3);
    if (IN(4)) { FRESH_IDS(); attn_conv_phase(args, lds, wave, lane); }
#if PROBE_DUP == 4
    if (IN(4)) { FRESH_IDS(); attn_conv_phase(args, lds, wave, lane); }
#endif
    SEAM(4);
    if (IN(5)) { pg8::Gemm g{ACB, (const bf16*)(ws + WS_WOUT), M_TOK, D, D, wave}; pg8::StaticOrder S; S.init(M_TOK, D, G, bx);
        pg8::EpiResid<1, true> E{nullptr, nullptr, XB, SS2, 1.0f};
        pg8::gemm_phase<pg8::EpiResid<1, true>, pg8::StaticOrder, true, true>(lds, g, S, E); } SEAM(5);
    if (IN(6)) { pg8::Gemm g{XB, (const bf16*)(ws + WS_W2GU), M_TOK, NGU, D, wave}; pg8::RevOrder S; S.init(M_TOK, NGU, G, bx);
        pg8::EpiSwiGLU<true> E{ACT, FF, SS2};
        pg8::gemm_phase<pg8::EpiSwiGLU<true>, pg8::RevOrder, true, true>(lds, g, S, E); }
#if PROBE_DUP == 6
    if (IN(6)) { pg8::Gemm g{XB, (const bf16*)(ws + WS_W2GU), M_TOK, NGU, D, wave}; pg8::RevOrder S; S.init(M_TOK, NGU, G, bx);
        pg8::EpiSwiGLU<true> E{ACT, FF, SS2};
        pg8::gemm_phase<pg8::EpiSwiGLU<true>, pg8::RevOrder, true, true>(lds, g, S, E); }
#endif
    SEAM(6);
    if (IN(7)) { pg8::Gemm g{ACT, (const bf16*)(ws + WS_W2D), M_TOK, D, FF, wave}; pg8::StaticOrder S; S.init(M_TOK, D, G, bx);
        pg8::EpiResid<1, false> E{nullptr, nullptr, XB, nullptr, 0.5f};
        pg8::gemm_phase<pg8::EpiResid<1, false>, pg8::StaticOrder, true, true>(lds, g, S, E); } SEAM(7);
    if (IN(8)) { FRESH_IDS(); final_norm_phase(args, gw, NGW, lane); }
#undef IN
#undef SEAM
}

#ifndef MK_N_LAUNCHES
#define MK_N_LAUNCHES 1
#endif
extern "C" void kernel_launch(void* const* d_in, const int* in_sizes, int n_in, void* d_out, int out_size, void* d_ws, size_t ws_size, hipStream_t stream) {
    static int grid = 0;
    if (grid == 0) {
        if (n_in != 20 || in_sizes[0] != MP * D || out_size != M_TOK * D || ws_size < WS_END) { fprintf(stderr, "kernel_launch: unexpected shapes (n_in %d, in0 %d, out %d, ws %zu)\n", n_in, n_in > 0 ? in_sizes[0] : -1, out_size, ws_size); grid = -1; return; }
        int dev = 0, cus = 0, per_cu = 0;
        if (hipGetDevice(&dev) != hipSuccess || hipDeviceGetAttribute(&cus, hipDeviceAttributeMultiprocessorCount, dev) != hipSuccess) { grid = -1; return; }
        if (hipFuncSetAttribute((const void*)enc_fwd, hipFuncAttributeMaxDynamicSharedMemorySize, LDS_BYTES) != hipSuccess) { fprintf(stderr, "kernel_launch: hipFuncSetAttribute failed\n"); grid = -1; return; }
        if (hipOccupancyMaxActiveBlocksPerMultiprocessor(&per_cu, (const void*)enc_fwd, NWAVES * 64, LDS_BYTES) != hipSuccess || per_cu < 1) { fprintf(stderr, "kernel_launch: occupancy query says %d\n", per_cu); per_cu = 1; }
        (void)hipGetLastError();
        if (cus * per_cu < 256) { fprintf(stderr, "kernel_launch: needs 256 co-resident workgroups, device offers %d\n", cus * per_cu); grid = -1; return; }
        grid = 256;
    }
    if (grid < 0) return;
    if (hipMemsetAsync((char*)d_ws + WS_CTL, 0, CTL_ZERO_BYTES, stream) != hipSuccess) { fprintf(stderr, "kernel_launch: memset failed\n"); return; }
    Args a{};
    for (int i = 0; i < 20; ++i) a.in[i] = (const float*)d_in[i];
    a.out = (float*)d_out; a.ws = (unsigned char*)d_ws;
#if MK_N_LAUNCHES == 1
    a.ph_lo = 0; a.ph_hi = 9;
    void* kargs[] = {&a};
    hipError_t e = hipLaunchCooperativeKernel((const void*)enc_fwd, dim3(grid), dim3(NWAVES * 64), kargs, LDS_BYTES, stream);
    if (e != hipSuccess) fprintf(stderr, "kernel_launch: cooperative launch failed: %s (grid %d)\n", hipGetErrorString(e), grid);
#else
    for (int p = 0; p < 9; ++p) {
        a.ph_lo = p; a.ph_hi = p + 1;
        hipLaunchKernelGGL(enc_fwd, dim3(grid), dim3(NWAVES * 64), LDS_BYTES, stream, a);
    }
#endif
}
```

```cpp
#include <hip/hip_runtime.h>
#include <hip/hip_cooperative_groups.h>
#include <cstdio>
#include <cstdint>
#include <cmath>
namespace cg = cooperative_groups;
namespace pg8 {
#define PG8_LAS __attribute__((address_space(3)))
typedef unsigned short bf16_t;
typedef short bf16x8 __attribute__((ext_vector_type(8)));
typedef float f32x4 __attribute__((ext_vector_type(4)));
typedef unsigned u32x4 __attribute__((ext_vector_type(4)));
constexpr int BM = 256, BK = 64, HALF = 128, HTB = HALF * BK * 2  , STAGE_BYTES = 8 * HTB, NXCD = 8, WGM = 8;

__host__ __device__ __forceinline__ int lds_byte(int r, int c) { const int st = (r >> 4) * 2 + (c >> 5), rr = r & 15, cc = c & 31, ob = rr * 64 + cc * 2; return st * 1024 + (ob ^ (((ob >> 9) & 1) << 5)); }
__host__ __device__ __forceinline__ void stage_rc(int b, int& R, int& C) { const int st = b / 1024, sb = b % 1024, swz = sb ^ (((sb >> 9) & 1) << 5); R = (st >> 1) * 16 + swz / 64; C = (st & 1) * 32 + (swz % 64) / 2; }
__host__ __device__ __forceinline__ int perm32(int rho) { const int n = rho >> 4, i = rho & 15; return 8 * (i >> 2) + 4 * n + (i & 3); }

struct Unit { int pm, pn; };
struct Gemm { const bf16_t* A; const bf16_t* Bt; int M, N, K, wid; };

struct StaticOrder {
    int nM, nN, nwg, G, c;
    __host__ __device__ void init(int M, int N, int G_, int c_) { nM = M / BM; nN = N / BM; nwg = nM * nN; G = G_; c = c_; }
    __host__ __device__ bool next(int i, Unit& u) const {
        const long L = (long)i * G + c; if (L >= nwg) return false;
        int wgid = (int)L; { const int q = nwg / NXCD, r = nwg % NXCD, xcd = wgid % NXCD, off = wgid / NXCD; wgid = (xcd < r ? xcd * (q + 1) : r * (q + 1) + (xcd - r) * q) + off; }
        const int nig = WGM * nN, gid = wgid / nig, fm = gid * WGM, gsz = (nM - fm) < WGM ? (nM - fm) : WGM;
        u.pm = fm + ((wgid % nig) % gsz); u.pn = (wgid % nig) / gsz; return true;
    }
    __device__ __forceinline__ void a_ready(const Unit&) const {}
    __device__ __forceinline__ void done(const Unit&) const {}
};
struct RevOrder : StaticOrder {
    __host__ __device__ bool next(int i, Unit& u) const { if (!StaticOrder::next(i, u)) return false; if (nM == 320) u.pm = 40 * (u.pm / 40) + 39 - (u.pm % 40); return true; }
};
__device__ __forceinline__ unsigned cvt_pk_bf16(float lo, float hi) { unsigned r; asm volatile("v_cvt_pk_bf16_f32 %0, %1, %2" : "=v"(r) : "v"(lo), "v"(hi)); return r; }
typedef float f32x2 __attribute__((ext_vector_type(2)));
constexpr float RMS_EPS = 1e-6f;
typedef unsigned u32x2 __attribute__((ext_vector_type(2)));
__device__ __forceinline__ float row_rstd16(const float* ssrow) {
    const f32x4 a = *(const f32x4*)(ssrow), b = *(const f32x4*)(ssrow + 4), c = *(const f32x4*)(ssrow + 8), d = *(const f32x4*)(ssrow + 12);
    const float s = ((a[0] + a[1]) + (a[2] + a[3])) + ((b[0] + b[1]) + (b[2] + b[3])) + ((c[0] + c[1]) + (c[2] + c[3])) + ((d[0] + d[1]) + (d[2] + d[3]));
    return __builtin_amdgcn_rsqf(s * (1.0f / 1024.0f) + RMS_EPS);
}
__device__ __forceinline__ float row_rstd16_coop(const float* ssrow, int fq) {
    const f32x4 a = *(const f32x4*)(ssrow + 4 * fq);
    float s = (a[0] + a[1]) + (a[2] + a[3]);
    s += __shfl_xor(s, 16); s += __shfl_xor(s, 32);
    return __builtin_amdgcn_rsqf(s * (1.0f / 1024.0f) + RMS_EPS);
}
__device__ __forceinline__ float silu_mul(float g, float u) { return g * u * __builtin_amdgcn_rcpf(1.0f + __builtin_amdgcn_exp2f(-1.4426950408889634f * g)); }

template <bool HAS_RSTD> struct EpiSwiGLU {
    static constexpr bool PERM = true, AFTER_DRAIN = false;
    bf16_t* O; int ldc; const float* ss;
    __device__ __forceinline__ void operator()(const f32x4 (&acc)[2][2][4][2], const Unit& u, int wr, int wc, int fr, int fq) const {
        const int row0 = u.pm * BM + wr * 64 + fr, col0 = u.pn * HALF + wc * 32 + 8 * fq;
        float rsv[8];
#pragma unroll
        for (int i = 0; i < 8; ++i) rsv[i] = HAS_RSTD ? row_rstd16_coop(ss + (size_t)(row0 + (i >> 2) * HALF + (i & 3) * 16) * 16, fq) : 1.0f;
#pragma unroll
        for (int ai = 0; ai < 2; ++ai)
#pragma unroll
            for (int m = 0; m < 4; ++m) {
                const int row = row0 + ai * HALF + m * 16;
                const float rs = rsv[ai * 4 + m];
                const f32x4 g0 = acc[ai][0][m][0] * rs, g1 = acc[ai][0][m][1] * rs, u0 = acc[ai][1][m][0] * rs, u1 = acc[ai][1][m][1] * rs;
                u32x4 w;
                w.x = cvt_pk_bf16(silu_mul(g0[0], u0[0]), silu_mul(g0[1], u0[1])); w.y = cvt_pk_bf16(silu_mul(g0[2], u0[2]), silu_mul(g0[3], u0[3]));
                w.z = cvt_pk_bf16(silu_mul(g1[0], u1[0]), silu_mul(g1[1], u1[1])); w.w = cvt_pk_bf16(silu_mul(g1[2], u1[2]), silu_mul(g1[3], u1[3]));
                *(u32x4*)(O + (size_t)row * ldc + col0) = w;
            }
    }
};

__device__ __forceinline__ u32x4 xchg8(u32x4 v) {
    u32x4 r;
    r.x = (unsigned)__builtin_amdgcn_update_dpp(0, (int)v.x, 0x128, 0xf, 0xf, false); r.y = (unsigned)__builtin_amdgcn_update_dpp(0, (int)v.y, 0x128, 0xf, 0xf, false);
    r.z = (unsigned)__builtin_amdgcn_update_dpp(0, (int)v.z, 0x128, 0xf, 0xf, false); r.w = (unsigned)__builtin_amdgcn_update_dpp(0, (int)v.w, 0x128, 0xf, 0xf, false);
    return r;
}
__device__ __forceinline__ void store_rows16(bf16_t* base, int ld, u32x4 w0, u32x4 w1, int fr, int fq) {
    const bool hi = (fr & 8) != 0;
    const u32x4 rcv = xchg8(hi ? w0 : w1);
    bf16_t* p = base + (size_t)(fr & 7) * ld + (hi ? 32 : 0) + 8 * fq;
    *(u32x4*)p = hi ? rcv : w0; *(u32x4*)(p + (size_t)8 * ld) = hi ? w1 : rcv;
}
__device__ __forceinline__ void load_rows16_issue(const bf16_t* base, int ld, int fr, int fq, u32x4& la, u32x4& lb) {
    const bf16_t* p = base + (size_t)(fr & 7) * ld + ((fr & 8) ? 32 : 0) + 8 * fq;
    la = *(const u32x4*)p; lb = *(const u32x4*)(p + (size_t)8 * ld);
}
__device__ __forceinline__ void load_rows16_finish(u32x4 la, u32x4 lb, int fr, u32x4& r0, u32x4& r1) {
    const bool hi = (fr & 8) != 0;
    const u32x4 rcv = xchg8(hi ? la : lb);
    r0 = hi ? rcv : la; r1 = hi ? lb : rcv;
}

template <int RES_MODE, bool WRITE_SS> struct EpiResid {
    static constexpr bool PERM = true, AFTER_DRAIN = false;
    const float* g; const float* rstd0;
    bf16_t* xb; float* ss; float alpha;
    __device__ __forceinline__ void operator()(const f32x4 (&acc)[2][2][4][2], const Unit& u, int wr, int wc, int fr, int fq) const {
        const int rowg = u.pm * BM + wr * 64, colw = u.pn * BM + wc * 64;
        f32x4 gi[2][2]; float ri[8];
        if (RES_MODE == 2) {
#pragma unroll
            for (int bj = 0; bj < 2; ++bj)
#pragma unroll
                for (int n = 0; n < 2; ++n) { const f32x4 gv = *(const f32x4*)(g + colw + 32 * bj + 8 * fq + 4 * n); gi[bj][n] = (f32x4){__builtin_amdgcn_rcpf(gv[0]), __builtin_amdgcn_rcpf(gv[1]), __builtin_amdgcn_rcpf(gv[2]), __builtin_amdgcn_rcpf(gv[3])}; }
#pragma unroll
            for (int i = 0; i < 8; ++i) ri[i] = __builtin_amdgcn_rcpf(rstd0[rowg + (i >> 2) * HALF + (i & 3) * 16 + fr]);
        }
        bf16_t* xw = xb + (size_t)rowg * 1024 + colw;
        u32x4 la[2][4], lb[2][4];
#pragma unroll
        for (int ai = 0; ai < 2; ++ai)
#pragma unroll
            for (int m = 0; m < 4; ++m) load_rows16_issue(xw + (size_t)(ai * HALF + m * 16) * 1024, 1024, fr, fq, la[ai][m], lb[ai][m]);
#pragma unroll
        for (int ai = 0; ai < 2; ++ai)
#pragma unroll
            for (int m = 0; m < 4; ++m) {
                u32x4 q[2]; load_rows16_finish(la[ai][m], lb[ai][m], fr, q[0], q[1]);
                u32x4 w[2]; float s = 0.f;
#pragma unroll
                for (int bj = 0; bj < 2; ++bj) {
                    f32x4 r0 = (f32x4){__builtin_bit_cast(float, q[bj].x << 16), __builtin_bit_cast(float, q[bj].x & 0xffff0000u), __builtin_bit_cast(float, q[bj].y << 16), __builtin_bit_cast(float, q[bj].y & 0xffff0000u)};
                    f32x4 r1 = (f32x4){__builtin_bit_cast(float, q[bj].z << 16), __builtin_bit_cast(float, q[bj].z & 0xffff0000u), __builtin_bit_cast(float, q[bj].w << 16), __builtin_bit_cast(float, q[bj].w & 0xffff0000u)};
                    if (RES_MODE == 2) { r0 = r0 * gi[bj][0] * ri[ai * 4 + m]; r1 = r1 * gi[bj][1] * ri[ai * 4 + m]; }
                    const f32x4 v0 = r0 + acc[ai][bj][m][0] * alpha, v1 = r1 + acc[ai][bj][m][1] * alpha;
                    w[bj].x = cvt_pk_bf16(v0[0], v0[1]); w[bj].y = cvt_pk_bf16(v0[2], v0[3]); w[bj].z = cvt_pk_bf16(v1[0], v1[1]); w[bj].w = cvt_pk_bf16(v1[2], v1[3]);
                    if (WRITE_SS) s += (v0[0] * v0[0] + v0[1] * v0[1]) + (v0[2] * v0[2] + v0[3] * v0[3]) + (v1[0] * v1[0] + v1[1] * v1[1]) + (v1[2] * v1[2] + v1[3] * v1[3]);
                }
                store_rows16(xw + (size_t)(ai * HALF + m * 16) * 1024, 1024, w[0], w[1], fr, fq);
                if (WRITE_SS) { s += __shfl_xor(s, 16); s += __shfl_xor(s, 32); if (fq == 0) ss[(size_t)(rowg + ai * HALF + m * 16 + fr) * 16 + u.pn * 4 + wc] = s; }
            }
    }
};

struct EpiWin {
    static constexpr bool PERM = true, AFTER_DRAIN = false;
    const float* ss; bf16_t *ZQ, *ZK, *VT, *ZC; const float *qg, *kg;
    __device__ __forceinline__ void operator()(const f32x4 (&acc)[2][2][4][2], const Unit& u, int wr, int wc, int fr, int fq) const {
        const int row0 = u.pm * BM + wr * 64 + fr, pn = u.pn;
        float rsv[8];
#pragma unroll
        for (int i = 0; i < 8; ++i) rsv[i] = row_rstd16_coop(ss + (size_t)(row0 + (i >> 2) * HALF + (i & 3) * 16) * 16, fq);
        if (pn < 4) {
            const bool isq = pn < 2; const float* gp = (isq ? qg : kg) + 8 * fq; const float gs = isq ? 0.125f * 1.4426950408889634f : 1.0f;
            f32x4 gn[2][2];
#pragma unroll
            for (int bj = 0; bj < 2; ++bj)
#pragma unroll
                for (int n = 0; n < 2; ++n) gn[bj][n] = *(const f32x4*)(gp + 32 * bj + 4 * n) * gs;
            bf16_t* Z = (isq ? ZQ : ZK) + (pn & 1) * 256 + wc * 64 + (size_t)(u.pm * BM + wr * 64) * 512;
#pragma unroll
            for (int ai = 0; ai < 2; ++ai)
#pragma unroll
                for (int m = 0; m < 4; ++m) {
                    const int row = row0 + ai * HALF + m * 16; const float rs = rsv[ai * 4 + m];
                    f32x4 v[2][2]; float s = 0.f;
#pragma unroll
                    for (int bj = 0; bj < 2; ++bj)
#pragma unroll
                        for (int n = 0; n < 2; ++n) { v[bj][n] = acc[ai][bj][m][n] * rs; const f32x4 x = v[bj][n]; s += (x[0] * x[0] + x[1] * x[1]) + (x[2] * x[2] + x[3] * x[3]); }
                    s += __shfl_xor(s, 16); s += __shfl_xor(s, 32);
                    const float rn = __builtin_amdgcn_rsqf(s * (1.0f / 64.0f) + RMS_EPS);
                    u32x4 w[2];
#pragma unroll
                    for (int bj = 0; bj < 2; ++bj) {
                        const f32x4 a = v[bj][0] * gn[bj][0] * rn, b = v[bj][1] * gn[bj][1] * rn;
                        w[bj].x = cvt_pk_bf16(a[0], a[1]); w[bj].y = cvt_pk_bf16(a[2], a[3]); w[bj].z = cvt_pk_bf16(b[0], b[1]); w[bj].w = cvt_pk_bf16(b[2], b[3]);
                    }
                    store_rows16(Z + (size_t)(ai * HALF + m * 16) * 512, 512, w[0], w[1], fr, fq);
                }
        } else if (pn < 6) {
            const int rowt = u.pm * BM; const int S = (rowt < 65536) ? 2048 : 4096; const int h = 4 * (pn - 4) + wc;
#pragma unroll
            for (int ai = 0; ai < 2; ++ai)
#pragma unroll
                for (int m = 0; m < 4; ++m) {
                    const int row = row0 + ai * HALF + m * 16; const float rs = rsv[ai * 4 + m];
                    const int t = row & (S - 1); bf16_t* vp = VT + (size_t)(row - t) * 512 + (size_t)(h * 64 + 8 * fq) * S + t;
#pragma unroll
                    for (int bj = 0; bj < 2; ++bj)
#pragma unroll
                        for (int n = 0; n < 2; ++n) {
                            const f32x4 x = acc[ai][bj][m][n] * rs; const unsigned p0 = cvt_pk_bf16(x[0], x[1]), p1 = cvt_pk_bf16(x[2], x[3]);
                            bf16_t* q = vp + (size_t)(32 * bj + 4 * n) * S;
                            q[0] = (bf16_t)(p0 & 0xffffu); q[(size_t)S] = (bf16_t)(p0 >> 16); q[(size_t)2 * S] = (bf16_t)(p1 & 0xffffu); q[(size_t)3 * S] = (bf16_t)(p1 >> 16);
                        }
                }
        } else if (pn < 8) {
            bf16_t* Z = ZC + (pn - 6) * 256 + wc * 64 + (size_t)(u.pm * BM + wr * 64) * 1024;
#pragma unroll
            for (int ai = 0; ai < 2; ++ai)
#pragma unroll
                for (int m = 0; m < 4; ++m) {
                    const float rs = rsv[ai * 4 + m];
                    u32x4 w[2];
#pragma unroll
                    for (int bj = 0; bj < 2; ++bj) {
                        const f32x4 a = acc[ai][bj][m][0] * rs, b = acc[ai][bj][m][1] * rs;
                        w[bj].x = cvt_pk_bf16(a[0], a[1]); w[bj].y = cvt_pk_bf16(a[2], a[3]); w[bj].z = cvt_pk_bf16(b[0], b[1]); w[bj].w = cvt_pk_bf16(b[2], b[3]);
                    }
                    store_rows16(Z + (size_t)(ai * HALF + m * 16) * 1024, 1024, w[0], w[1], fr, fq);
                }
        } else {
            bf16_t* Z = ZC + 512 + (pn - 8) * 128 + wc * 32 + 8 * fq + (size_t)row0 * 1024;
#pragma unroll
            for (int ai = 0; ai < 2; ++ai)
#pragma unroll
                for (int m = 0; m < 4; ++m) {
                    const float rs = rsv[ai * 4 + m], rs2 = rs * rs;
                    const f32x4 a = acc[ai][0][m][0] * acc[ai][1][m][0] * rs2, b = acc[ai][0][m][1] * acc[ai][1][m][1] * rs2;
                    u32x4 w; w.x = cvt_pk_bf16(a[0], a[1]); w.y = cvt_pk_bf16(a[2], a[3]); w.z = cvt_pk_bf16(b[0], b[1]); w.w = cvt_pk_bf16(b[2], b[3]);
                    *(u32x4*)(Z + (size_t)(ai * HALF + m * 16) * 1024) = w;
                }
        }
    }
};

template <class Epi, class Sched, bool ALIGN_EPI = false, bool SP2 = false>
__device__ __forceinline__ void gemm_phase(PG8_LAS unsigned char* lds, const Gemm g, const Sched& S, const Epi& E) {
    const int wid = g.wid, lane = (int)__builtin_amdgcn_mbcnt_hi(~0u, __builtin_amdgcn_mbcnt_lo(~0u, 0u)), tid = wid * 64 + lane, wr = wid >> 2, wc = wid & 3, fr = lane & 15, fq = lane >> 4;
    const int K = g.K, nt = K / BK;
    unsigned voffA[2], voffB[2];
#pragma unroll
    for (int i = 0; i < 2; ++i) { int R, C; stage_rc(tid * 16 + i * 8192, R, C); const int Rb = Epi::PERM ? ((R & ~31) + perm32(R & 31)) : R;
        voffA[i] = (unsigned)(R * K + C) * 2u; voffB[i] = (unsigned)(Rb * K + C) * 2u; }
    const size_t kstep = (size_t)(BK * 2);
    const size_t hstep = (size_t)HALF * K * 2;
    const size_t tstep = 2 * hstep;
    const unsigned ldsw = (unsigned)wid * 1024u;
    const int aoff = lds_byte(wr * 64 + fr, fq * 8), boff = lds_byte(wc * 32 + fr, fq * 8);
#define PG8_SA(b, h) (((b) * 2 + (h)) * HTB)
#define PG8_SB(b, h) ((4 + (b) * 2 + (h)) * HTB)
#define PG8_STAGE(bufoff, gbase, voff) do { _Pragma("unroll") for (int _i = 0; _i < 2; ++_i) \
        __builtin_amdgcn_global_load_lds((const unsigned*)((const char*)(gbase) + (voff)[_i]), (PG8_LAS unsigned*)(lds + (bufoff) + ldsw + _i * 8192), 16, 0, 0); } while (0)
#define PG8_LDA(dst, b, h) do { _Pragma("unroll") for (int m = 0; m < 4; ++m) _Pragma("unroll") for (int k = 0; k < 2; ++k) dst[m][k] = *(const PG8_LAS bf16x8*)(lds + PG8_SA(b, h) + aoff + m * 2048 + k * 1024); } while (0)
#define PG8_LDB(dst, b, h) do { _Pragma("unroll") for (int n = 0; n < 2; ++n) _Pragma("unroll") for (int k = 0; k < 2; ++k) dst[n][k] = *(const PG8_LAS bf16x8*)(lds + PG8_SB(b, h) + boff + n * 2048 + k * 1024); } while (0)
#define PG8_MMA(ai, bj, At, Bt) do { __builtin_amdgcn_s_setprio(1); _Pragma("unroll") for (int m = 0; m < 4; ++m) _Pragma("unroll") for (int n = 0; n < 2; ++n) _Pragma("unroll") for (int k = 0; k < 2; ++k) \
        acc[ai][bj][m][n] = __builtin_amdgcn_mfma_f32_16x16x32_bf16(Bt[n][k], At[m][k], acc[ai][bj][m][n], 0, 0, 0); __builtin_amdgcn_s_setprio(0); } while (0)
#define PG8_WAIT_V(n) asm volatile("s_waitcnt vmcnt(" #n ")" ::: "memory")
#define PG8_WAIT_L(n) asm volatile("s_waitcnt lgkmcnt(" #n ")" ::: "memory")
#define PG8_BAR __builtin_amdgcn_s_barrier()
#define PG8_SCHED __builtin_amdgcn_sched_barrier(0)
    Unit cur, nxt; int ui = 0;
    if (!S.next(0, cur)) return;
    f32x4 acc[2][2][4][2];
#pragma unroll
    for (int a = 0; a < 2; ++a)
#pragma unroll
        for (int b = 0; b < 2; ++b)
#pragma unroll
            for (int m = 0; m < 4; ++m)
#pragma unroll
                for (int n = 0; n < 2; ++n) acc[a][b][m][n] = (f32x4){0.f, 0.f, 0.f, 0.f};
    bf16x8 At[4][2], B0[2][2], B1[2][2];
    const char* cA = (const char*)g.A + (size_t)cur.pm * tstep; const char* cB = (const char*)g.Bt + (size_t)cur.pn * tstep;
    S.a_ready(cur);
    if constexpr (SP2) {
        PG8_STAGE(PG8_SB(0, 0), cB, voffB); PG8_STAGE(PG8_SB(0, 1), cB + hstep, voffB); PG8_STAGE(PG8_SA(0, 0), cA, voffA); PG8_STAGE(PG8_SA(0, 1), cA + hstep, voffA);
        if (wr == 1) PG8_BAR;
        PG8_WAIT_V(2); PG8_BAR;
        PG8_STAGE(PG8_SB(1, 0), cB + kstep, voffB); PG8_STAGE(PG8_SA(1, 0), cA + kstep, voffA); PG8_STAGE(PG8_SB(1, 1), cB + hstep + kstep, voffB);
        PG8_WAIT_V(6); PG8_BAR;
    } else {
        PG8_STAGE(PG8_SB(0, 0), cB, voffB); PG8_STAGE(PG8_SA(0, 0), cA, voffA); PG8_STAGE(PG8_SB(0, 1), cB + hstep, voffB); PG8_STAGE(PG8_SA(0, 1), cA + hstep, voffA);
        if (wr == 1) PG8_BAR;
        PG8_WAIT_V(4); PG8_BAR;
        PG8_STAGE(PG8_SB(1, 0), cB + kstep, voffB); PG8_STAGE(PG8_SA(1, 0), cA + kstep, voffA); PG8_STAGE(PG8_SB(1, 1), cB + hstep + kstep, voffB);
        PG8_WAIT_V(6); PG8_BAR;
    }
    for (;;) {
        const bool has_next = S.next(ui + 1, nxt);
        const char* nA = has_next ? (const char*)g.A + (size_t)nxt.pm * tstep : cA; const char* nB = has_next ? (const char*)g.Bt + (size_t)nxt.pn * tstep : cB;
        for (int t = 0; t < nt; t += 2) {
            const bool last = (t == nt - 2);
            const char* a1 = cA + (size_t)(t + 1) * kstep;
            const char* a2 = last ? nA : cA + (size_t)(t + 2) * kstep; const char* b2 = last ? nB : cB + (size_t)(t + 2) * kstep;
            const char* a3 = a2 + kstep; const char* b3 = b2 + kstep;
            if (last && has_next) S.a_ready(nxt);
            if constexpr (SP2) {
            PG8_LDB(B0, 0, 0); PG8_LDB(B1, 0, 1); PG8_SCHED; PG8_LDA(At, 0, 0); PG8_STAGE(PG8_SA(1, 1), a1 + hstep, voffA);
            PG8_WAIT_V(8); PG8_WAIT_L(0); PG8_BAR; PG8_MMA(0, 0, At, B0); PG8_MMA(0, 1, At, B1); PG8_BAR; PG8_SCHED;
            PG8_LDA(At, 0, 1); PG8_STAGE(PG8_SB(0, 0), b2, voffB); PG8_STAGE(PG8_SB(0, 1), b2 + hstep, voffB); PG8_STAGE(PG8_SA(0, 0), a2, voffA);
            PG8_WAIT_V(8); PG8_WAIT_L(0); PG8_BAR; PG8_MMA(1, 0, At, B0); PG8_MMA(1, 1, At, B1); PG8_BAR; PG8_SCHED;
            PG8_LDB(B0, 1, 0); PG8_LDB(B1, 1, 1); PG8_SCHED; PG8_LDA(At, 1, 0); PG8_STAGE(PG8_SA(0, 1), a2 + hstep, voffA);
            PG8_WAIT_V(8); PG8_WAIT_L(0); PG8_BAR; PG8_MMA(0, 0, At, B0); PG8_MMA(0, 1, At, B1); PG8_BAR; PG8_SCHED;
            PG8_LDA(At, 1, 1); PG8_STAGE(PG8_SB(1, 0), b3, voffB); PG8_STAGE(PG8_SB(1, 1), b3 + hstep, voffB); PG8_STAGE(PG8_SA(1, 0), a3, voffA);
            PG8_WAIT_V(8); PG8_WAIT_L(0); PG8_BAR; PG8_MMA(1, 0, At, B0); PG8_MMA(1, 1, At, B1); PG8_BAR; PG8_SCHED;
            } else {
            PG8_LDB(B0, 0, 0); PG8_SCHED; PG8_LDA(At, 0, 0); PG8_STAGE(PG8_SA(1, 1), a1 + hstep, voffA);
            PG8_WAIT_L(8); PG8_BAR; PG8_WAIT_L(0); PG8_MMA(0, 0, At, B0); PG8_BAR; PG8_SCHED;
            PG8_LDB(B1, 0, 1); PG8_STAGE(PG8_SB(0, 0), b2, voffB);
            PG8_BAR; PG8_WAIT_L(0); PG8_MMA(0, 1, At, B1); PG8_BAR;
            PG8_LDA(At, 0, 1); PG8_STAGE(PG8_SA(0, 0), a2, voffA);
            PG8_BAR; PG8_WAIT_L(0); PG8_MMA(1, 0, At, B0); PG8_BAR; PG8_SCHED;
            PG8_STAGE(PG8_SB(0, 1), b2 + hstep, voffB);
            PG8_WAIT_V(6); PG8_BAR; PG8_MMA(1, 1, At, B1); PG8_BAR;
            PG8_LDB(B0, 1, 0); PG8_SCHED; PG8_LDA(At, 1, 0); PG8_STAGE(PG8_SA(0, 1), a2 + hstep, voffA);
            PG8_WAIT_L(8); PG8_BAR; PG8_WAIT_L(0); PG8_MMA(0, 0, At, B0); PG8_BAR; PG8_SCHED;
            PG8_LDB(B1, 1, 1); PG8_STAGE(PG8_SB(1, 0), b3, voffB);
            PG8_BAR; PG8_WAIT_L(0); PG8_MMA(0, 1, At, B1); PG8_BAR;
            PG8_LDA(At, 1, 1); PG8_STAGE(PG8_SA(1, 0), a3, voffA);
            PG8_BAR; PG8_WAIT_L(0); PG8_MMA(1, 0, At, B0); PG8_BAR; PG8_SCHED;
            PG8_STAGE(PG8_SB(1, 1), b3 + hstep, voffB);
            PG8_WAIT_V(6); PG8_BAR; PG8_MMA(1, 1, At, B1); PG8_BAR;
            }
        }
        if constexpr (ALIGN_EPI) { if (wr == 0) PG8_BAR; }
        if constexpr (!Epi::AFTER_DRAIN) { E(acc, cur, wr, wc, fr, fq); S.done(cur); }
        if (!has_next) break;
#pragma unroll
        for (int a = 0; a < 2; ++a)
#pragma unroll
            for (int b = 0; b < 2; ++b)
#pragma unroll
                for (int m = 0; m < 4; ++m)
#pragma unroll
                    for (int n = 0; n < 2; ++n) acc[a][b][m][n] = (f32x4){0.f, 0.f, 0.f, 0.f};
        cur = nxt; cA = nA; cB = nB; ++ui;
        if constexpr (ALIGN_EPI) { if (wr == 1) PG8_BAR; }
    }
    PG8_WAIT_V(0);
    if constexpr (!ALIGN_EPI) { if (wr == 0) PG8_BAR; }
    PG8_BAR;
    if constexpr (Epi::AFTER_DRAIN) { E.fused(acc, cur, wr, wc, fr, fq, lds, wid, lane); S.done(cur); }
#undef PG8_SA
#undef PG8_SB
#undef PG8_STAGE
#undef PG8_LDA
#undef PG8_LDB
#undef PG8_MMA
#undef PG8_WAIT_V
#undef PG8_WAIT_L
#undef PG8_BAR
#undef PG8_SCHED
}
}
#define GAS __attribute__((address_space(1)))
#define LAS __attribute__((address_space(3)))
typedef unsigned short bf16;
typedef unsigned v4u __attribute__((ext_vector_type(4)));
typedef unsigned v2u __attribute__((ext_vector_type(2)));
typedef float f32x4 __attribute__((ext_vector_type(4)));
typedef short bf16x8 __attribute__((ext_vector_type(8)));
typedef short s16x4 __attribute__((ext_vector_type(4)));
#define LDS_WAIT() asm volatile("s_waitcnt lgkmcnt(0)" ::: "memory")

constexpr int NWAVES = 8;
constexpr int M_TOK = 81920, MP = 65536, D = 1024, FF = 2816, NGU = 2 * FF, DIN = 3072;
constexpr float EPSF = 1e-6f;
constexpr size_t MiB = 1u << 20;
constexpr size_t WS_CTL = 0, CTL_ZERO_BYTES = 65536;
constexpr size_t WS_W1GU = 1 * MiB, WS_W1D = 12 * MiB, WS_WIN = 18 * MiB, WS_WOUT = 24 * MiB, WS_W2GU = 26 * MiB, WS_W2D = 37 * MiB;
constexpr size_t WS_SS1 = 44 * MiB, WS_SS2 = 50 * MiB, WS_RS0 = 56 * MiB;
constexpr size_t WS_XB = 64 * MiB;
constexpr size_t WS_ACT = 224 * MiB;
constexpr size_t WS_ZQ = WS_ACT, WS_ZK = WS_ACT + 80 * MiB, WS_VT = WS_ACT + 160 * MiB, WS_ZC = WS_ACT + 240 * MiB;
constexpr size_t WS_AC = 704 * MiB;
constexpr size_t WS_END = 864 * MiB;
constexpr int RING_BYTES = 131072, LDS_BYTES = 147456;

__device__ __forceinline__ unsigned f2bf(float f) { unsigned u = __builtin_bit_cast(unsigned, f); return (u + 0x7fffu + ((u >> 16) & 1u)) >> 16; }
__device__ __forceinline__ unsigned pk2(float lo, float hi) { return f2bf(lo) | (f2bf(hi) << 16); }
__device__ __forceinline__ float bflo(unsigned w) { return __builtin_bit_cast(float, w << 16); }
__device__ __forceinline__ float bfhi(unsigned w) { return __builtin_bit_cast(float, w & 0xffff0000u); }
__device__ __forceinline__ float wave_sum(float v) {
#pragma unroll
    for (int o = 1; o < 64; o <<= 1) v += __shfl_xor(v, o);
    return v;
}

__device__ __forceinline__ void p0_transpose_item(const float* W, int K, int N, bf16* WT, const float* gain, int kind, LAS float* scr, int item, int lane) {
    const int nblk = N / 32, kb = item / nblk, nb = item % nblk, k0 = 64 * kb, n0 = 32 * nb;
    int rowbase = n0;
    if (kind == 1) rowbase = (n0 >> 7) * 256 + (n0 & 127);
    else if (kind == 2) rowbase = (n0 >> 7) * 256 + 128 + (n0 & 127);
    else if (kind == 3 || (kind == 4 && n0 < 2048)) rowbase = (n0 & ~255) + 128 * ((n0 >> 5) & 1) + 32 * ((n0 >> 6) & 3);
    else if (kind == 4) { const int isx = n0 >= 2560, ch0 = (n0 - 2048) & 511; rowbase = 256 * (8 + (ch0 >> 7)) + 128 * isx + 32 * ((ch0 >> 5) & 3); }
#pragma unroll 8
    for (int i = 0; i < 32; ++i) { const int kk = 2 * i + (lane >> 5); const float g = gain ? gain[k0 + kk] : 1.0f; scr[kk * 33 + (lane & 31)] = W[(size_t)(k0 + kk) * N + n0 + (lane & 31)] * g; }
    LDS_WAIT(); asm volatile("" ::: "memory");
    const int c = lane & 7;
#pragma unroll
    for (int j = 0; j < 4; ++j) { const int n = (lane >> 3) + 8 * j; const LAS float* s = scr + (8 * c) * 33 + n;
        v4u o; o.x = pk2(s[0 * 33], s[1 * 33]); o.y = pk2(s[2 * 33], s[3 * 33]); o.z = pk2(s[4 * 33], s[5 * 33]); o.w = pk2(s[6 * 33], s[7 * 33]);
        *(v4u*)(WT + (size_t)(rowbase + n) * K + k0 + 8 * c) = o; }
    LDS_WAIT(); asm volatile("" ::: "memory");
}

struct Args {
    const float* in[20]; float* out; unsigned char* ws; int ph_lo, ph_hi;
};
enum { I_XP = 0, I_XS, I_F1N, I_F1G, I_F1U, I_F1D, I_MIXN, I_WIN, I_QN, I_KN, I_RPB, I_CW, I_AON, I_CON, I_WOUT, I_F2N, I_F2G, I_F2U, I_F2D, I_FINN };

__device__ __forceinline__ void p0_prologue(const Args& A, LAS unsigned char* lds, int gw, int NGW, int wave, int lane) {
    unsigned char* ws = A.ws;
    LAS float* scr = (LAS float*)(lds + wave * 16384);
    constexpr int I_G = (D / 64) * (FF / 32), I_DN = (FF / 64) * (D / 32), I_IN = (D / 64) * (DIN / 32), I_OUT = (D / 64) * (D / 32);
    constexpr int NITEMS = 2 * (2 * I_G + I_DN) + I_IN + I_OUT;
    for (int it = gw; it < NITEMS; it += NGW) {
        int r = it;
        if (r < I_G) { p0_transpose_item(A.in[I_F1G], D, FF, (bf16*)(ws + WS_W1GU), nullptr, 1, scr, r, lane); continue; } r -= I_G;
        if (r < I_G) { p0_transpose_item(A.in[I_F1U], D, FF, (bf16*)(ws + WS_W1GU), nullptr, 2, scr, r, lane); continue; } r -= I_G;
        if (r < I_DN) { p0_transpose_item(A.in[I_F1D], FF, D, (bf16*)(ws + WS_W1D), nullptr, 3, scr, r, lane); continue; } r -= I_DN;
        if (r < I_G) { p0_transpose_item(A.in[I_F2G], D, FF, (bf16*)(ws + WS_W2GU), A.in[I_F2N], 1, scr, r, lane); continue; } r -= I_G;
        if (r < I_G) { p0_transpose_item(A.in[I_F2U], D, FF, (bf16*)(ws + WS_W2GU), A.in[I_F2N], 2, scr, r, lane); continue; } r -= I_G;
        if (r < I_DN) { p0_transpose_item(A.in[I_F2D], FF, D, (bf16*)(ws + WS_W2D), nullptr, 3, scr, r, lane); continue; } r -= I_DN;
        if (r < I_IN) { p0_transpose_item(A.in[I_WIN], D, DIN, (bf16*)(ws + WS_WIN), A.in[I_MIXN], 4, scr, r, lane); continue; } r -= I_IN;
        p0_transpose_item(A.in[I_WOUT], D, D, (bf16*)(ws + WS_WOUT), nullptr, 3, scr, r, lane);
    }
    const f32x4* gp = (const f32x4*)A.in[I_F1N] + lane;
    f32x4 gv[4];
#pragma unroll
    for (int j = 0; j < 4; ++j) gv[j] = gp[64 * j];
    bf16* XN = (bf16*)(ws + WS_XB);
    for (int m = gw; m < M_TOK; m += 2 * NGW) {
        const int m2 = m + NGW;
        const float* xrow = (m < MP) ? A.in[I_XP] + (size_t)m * D : A.in[I_XS] + (size_t)(m - MP) * D;
        const float* xrow2 = (m2 < MP) ? A.in[I_XP] + (size_t)m2 * D : A.in[I_XS] + (size_t)(m2 - MP) * D;
        const f32x4* xr = (const f32x4*)xrow + lane; const f32x4* xr2 = (const f32x4*)xrow2 + lane; f32x4 v[4], v2[4]; float s = 0.f, s2 = 0.f;
#pragma unroll
        for (int j = 0; j < 4; ++j) { v[j] = xr[64 * j]; v2[j] = xr2[64 * j]; }
#pragma unroll
        for (int j = 0; j < 4; ++j) { s += (v[j].x * v[j].x + v[j].y * v[j].y) + (v[j].z * v[j].z + v[j].w * v[j].w); s2 += (v2[j].x * v2[j].x + v2[j].y * v2[j].y) + (v2[j].z * v2[j].z + v2[j].w * v2[j].w); }
        const float rstd = __builtin_amdgcn_rsqf(wave_sum(s) * (1.0f / D) + EPSF), rstd2 = __builtin_amdgcn_rsqf(wave_sum(s2) * (1.0f / D) + EPSF);
        unsigned long long* o8 = (unsigned long long*)(XN + (size_t)m * D) + lane; unsigned long long* o82 = (unsigned long long*)(XN + (size_t)m2 * D) + lane;
        if (lane == 0) { float* rs0 = (float*)(ws + WS_RS0); rs0[m] = rstd; rs0[m2] = rstd2; }
#pragma unroll
        for (int j = 0; j < 4; ++j) { const f32x4 y = v[j] * rstd * gv[j]; o8[64 * j] = (unsigned long long)pk2(y.x, y.y) | ((unsigned long long)pk2(y.z, y.w) << 32);
            const f32x4 y2 = v2[j] * rstd2 * gv[j]; o82[64 * j] = (unsigned long long)pk2(y2.x, y2.y) | ((unsigned long long)pk2(y2.z, y2.w) << 32); }
    }
}

__device__ __forceinline__ void final_norm_phase(const Args& A, int gw, int NGW, int lane) {
    const float* gp = A.in[I_FINN] + 8 * lane;
    const f32x4 g0 = *(const f32x4*)(gp), g1 = *(const f32x4*)(gp + 4), g2 = *(const f32x4*)(gp + 512), g3 = *(const f32x4*)(gp + 516);
    const bf16* XB = (const bf16*)(A.ws + WS_XB);
    for (int m = gw; m < M_TOK; m += 4 * NGW) {
        v4u a[4], b[4];
#pragma unroll
        for (int i = 0; i < 4; ++i) { const bf16* xr = XB + (size_t)(m + i * NGW) * D + 8 * lane; a[i] = *(const v4u*)(xr); b[i] = *(const v4u*)(xr + 512); }
#pragma unroll
        for (int i = 0; i < 4; ++i) {
            const f32x4 v0 = (f32x4){bflo(a[i].x), bfhi(a[i].x), bflo(a[i].y), bfhi(a[i].y)}, v1 = (f32x4){bflo(a[i].z), bfhi(a[i].z), bflo(a[i].w), bfhi(a[i].w)};
            const f32x4 v2 = (f32x4){bflo(b[i].x), bfhi(b[i].x), bflo(b[i].y), bfhi(b[i].y)}, v3 = (f32x4){bflo(b[i].z), bfhi(b[i].z), bflo(b[i].w), bfhi(b[i].w)};
            const float s = (v0.x * v0.x + v0.y * v0.y) + (v0.z * v0.z + v0.w * v0.w) + (v1.x * v1.x + v1.y * v1.y) + (v1.z * v1.z + v1.w * v1.w)
                          + (v2.x * v2.x + v2.y * v2.y) + (v2.z * v2.z + v2.w * v2.w) + (v3.x * v3.x + v3.y * v3.y) + (v3.z * v3.z + v3.w * v3.w);
            const float rstd = __builtin_amdgcn_rsqf(wave_sum(s) * (1.0f / D) + EPSF);
            float* o = A.out + (size_t)(m + i * NGW) * D + 8 * lane;
            *(f32x4*)(o) = v0 * rstd * g0; *(f32x4*)(o + 4) = v1 * rstd * g1; *(f32x4*)(o + 512) = v2 * rstd * g2; *(f32x4*)(o + 516) = v3 * rstd * g3;
        }
    }
}

constexpr int RPB_OFF = 256, RPB_N = 8 * 15 * 31;
__device__ __forceinline__ void attn_finish(f32x4 (&o)[4], float sum, const float* aogp  , bf16* op) {
    const float il = __builtin_amdgcn_rcpf(sum); float q2 = 0.f;
#pragma unroll
    for (int mt = 0; mt < 4; ++mt) { o[mt] = o[mt] * il; q2 += (o[mt][0] * o[mt][0] + o[mt][1] * o[mt][1]) + (o[mt][2] * o[mt][2] + o[mt][3] * o[mt][3]); }
    q2 += __shfl_xor(q2, 16); q2 += __shfl_xor(q2, 32);
    const float rn = __builtin_amdgcn_rsqf(q2 * (1.0f / 64.0f) + EPSF);
#pragma unroll
    for (int mt = 0; mt < 4; ++mt) { const f32x4 y = o[mt] * rn * *(const f32x4*)(aogp + 16 * mt); v2u w; w.x = pg8::cvt_pk_bf16(y[0], y[1]); w.y = pg8::cvt_pk_bf16(y[2], y[3]); *(v2u*)(op + 16 * mt) = w; }
}
template <int STEP>
__device__ __forceinline__ void attn_quad(const bf16* ZQ, const bf16* ZK, const bf16* VT, bf16* AC, const LAS float* rpbL, const float* aogp,
                                          int seqbase, int S, int rA, int rs0, int h, int qc, int l, int g) {
    constexpr int NU = 8 + 3 * STEP;
    const int w0 = (qc == 0) ? 0 : (qc == 1) ? 8 : (qc == 2) ? 24 : 32;
    const int c = 16 * qc + l; int cs = c - 8; cs = cs < 0 ? 0 : cs; cs = cs > 48 ? 48 : cs;
    const size_t qtok0 = (size_t)seqbase + rA * 64 + c;
    bf16x8 qf[4][2];
#pragma unroll
    for (int i = 0; i < 4; ++i)
#pragma unroll
        for (int ks = 0; ks < 2; ++ks) qf[i][ks] = *(const bf16x8*)(ZQ + (qtok0 + 64 * i) * 512 + h * 64 + ks * 32 + 8 * g);
    const bf16* kp = ZK + ((size_t)seqbase + rs0 * 64 + w0 + 8 * (l >> 2) + (l & 3)) * 512 + h * 64 + 8 * g;
    const bf16* vp = VT + (size_t)seqbase * 512 + (size_t)(h * 64 + l) * S + rs0 * 64 + w0 + 8 * g;
    const int kc0 = w0 + 8 * g;
    bool valid[2][4];
#pragma unroll
    for (int hf = 0; hf < 2; ++hf)
#pragma unroll
        for (int j = 0; j < 4; ++j) valid[hf][j] = (unsigned)(kc0 + 4 * hf + j - cs) < 16u;
    const LAS float* bp0 = rpbL + h * 465 + (rs0 - rA + 7) * 31 + (kc0 - c + 15);
    f32x4 o[4][4]; float sum[4];
#pragma unroll
    for (int i = 0; i < 4; ++i) { sum[i] = 0.f;
#pragma unroll
        for (int mt = 0; mt < 4; ++mt) o[i][mt] = (f32x4){0.f, 0.f, 0.f, 0.f}; }
    bf16x8 kn[2][2]; v4u vn[4];
#pragma unroll
    for (int hf = 0; hf < 2; ++hf) { const bf16* kt = kp + (size_t)(hf * 4) * 512; kn[hf][0] = *(const bf16x8*)(kt); kn[hf][1] = *(const bf16x8*)(kt + 32); }
#pragma unroll
    for (int mt = 0; mt < 4; ++mt) vn[mt] = *(const v4u*)(vp + (size_t)(16 * mt) * S);
#pragma unroll 1
    for (int u = 0; u < NU; ++u) {
        bf16x8 kf[2][2]; v4u vf[4];
#pragma unroll
        for (int hf = 0; hf < 2; ++hf) { kf[hf][0] = kn[hf][0]; kf[hf][1] = kn[hf][1]; }
#pragma unroll
        for (int mt = 0; mt < 4; ++mt) vf[mt] = vn[mt];
        if (u + 1 < NU) {
#pragma unroll
            for (int hf = 0; hf < 2; ++hf) { const bf16* kt = kp + (size_t)((u + 1) * 64 + hf * 4) * 512; kn[hf][0] = *(const bf16x8*)(kt); kn[hf][1] = *(const bf16x8*)(kt + 32); }
#pragma unroll
            for (int mt = 0; mt < 4; ++mt) vn[mt] = *(const v4u*)(vp + (size_t)(16 * mt) * S + (u + 1) * 64);
        }
#pragma unroll
        for (int i = 0; i < 4; ++i) {
            if ((unsigned)(u - i * STEP) < 8u) {
                f32x4 s0 = {0.f, 0.f, 0.f, 0.f}, s1 = {0.f, 0.f, 0.f, 0.f};
                s0 = __builtin_amdgcn_mfma_f32_16x16x32_bf16(kf[0][0], qf[i][0], s0, 0, 0, 0); s0 = __builtin_amdgcn_mfma_f32_16x16x32_bf16(kf[0][1], qf[i][1], s0, 0, 0, 0);
                s1 = __builtin_amdgcn_mfma_f32_16x16x32_bf16(kf[1][0], qf[i][0], s1, 0, 0, 0); s1 = __builtin_amdgcn_mfma_f32_16x16x32_bf16(kf[1][1], qf[i][1], s1, 0, 0, 0);
                const LAS float* bp = bp0 + (u - i) * 31;
                float p0[4], p1[4];
#pragma unroll
                for (int j = 0; j < 4; ++j) { p0[j] = valid[0][j] ? __builtin_amdgcn_exp2f(s0[j] + bp[j]) : 0.f; p1[j] = valid[1][j] ? __builtin_amdgcn_exp2f(s1[j] + bp[4 + j]) : 0.f; }
                sum[i] += ((p0[0] + p0[1]) + (p0[2] + p0[3])) + ((p1[0] + p1[1]) + (p1[2] + p1[3]));
                v4u pw; pw.x = pg8::cvt_pk_bf16(p0[0], p0[1]); pw.y = pg8::cvt_pk_bf16(p0[2], p0[3]); pw.z = pg8::cvt_pk_bf16(p1[0], p1[1]); pw.w = pg8::cvt_pk_bf16(p1[2], p1[3]);
                const bf16x8 pf = __builtin_bit_cast(bf16x8, pw);
#pragma unroll
                for (int mt = 0; mt < 4; ++mt) o[i][mt] = __builtin_amdgcn_mfma_f32_16x16x32_bf16(__builtin_bit_cast(bf16x8, vf[mt]), pf, o[i][mt], 0, 0, 0);
            }
        }
    }
#pragma unroll
    for (int i = 0; i < 4; ++i) {
        float sm = sum[i]; sm += __shfl_xor(sm, 16); sm += __shfl_xor(sm, 32);
        attn_finish(o[i], sm, aogp, AC + (qtok0 + 64 * i) * 1024 + h * 64 + 4 * g);
    }
}

__device__ __forceinline__ void attn_conv_phase(const Args& A, LAS unsigned char* lds, int wave, int lane) {
    unsigned char* ws = A.ws;
    const bf16* ZQ = (const bf16*)(ws + WS_ZQ); const bf16* ZK = (const bf16*)(ws + WS_ZK); const bf16* VT = (const bf16*)(ws + WS_VT); const bf16* ZC = (const bf16*)(ws + WS_ZC);
    bf16* AC = (bf16*)(ws + WS_AC);
    LAS float* rpbL = (LAS float*)(lds + RPB_OFF);
    float cb;
    { const float mq = fabsf(A.in[I_QN][lane]), mk = fabsf(A.in[I_KN][lane]); float mqw = mq, mkw = mk, mb = 0.f;
      for (int i = lane; i < RPB_N; i += 64) mb = fmaxf(mb, fabsf(A.in[I_RPB][i]));
#pragma unroll
      for (int o_ = 1; o_ < 64; o_ <<= 1) { mqw = fmaxf(mqw, __shfl_xor(mqw, o_)); mkw = fmaxf(mkw, __shfl_xor(mkw, o_)); mb = fmaxf(mb, __shfl_xor(mb, o_)); }
      cb = 11.5416f * 1.01f * mqw * mkw + 1.4426950408889634f * mb; }
    for (int i = wave * 64 + lane; i < RPB_N; i += NWAVES * 64) rpbL[i] = A.in[I_RPB][i] * 1.4426950408889634f - cb;
    __syncthreads();
    const int l = lane & 15, g = lane >> 4;
#if PROBE_DUP == 44
#pragma unroll 1
    for (int rep_ = 0; rep_ < 2; ++rep_)
#endif
    const int G_ = (int)gridDim.x, vcu_ = (G_ % 8 == 0) ? ((int)blockIdx.x % 8) * (G_ / 8) + (int)blockIdx.x / 8 : (int)blockIdx.x;
    for (int ui_ = 0; ui_ < 5; ++ui_) {
        const int unit = (G_ == 256) ? 32 * (5 * (vcu_ >> 5) + (4 - ui_)) + (vcu_ & 31) : vcu_ + ui_ * G_;
        if (unit >= 1280) break;
        const int quad = unit >> 2, hq = unit & 3;
        int seqbase, rA, S, rows;
        if (quad < 256) { seqbase = (quad >> 3) * 2048; rA = 4 * (quad & 7); S = 2048; rows = 32; }
        else { const int q2 = quad - 256; seqbase = MP + (q2 >> 4) * 4096; rA = 4 * (q2 & 15); S = 4096; rows = 64; }
        int rs0 = rA - 4; rs0 = rs0 < 0 ? 0 : rs0; rs0 = rs0 > rows - 8 ? rows - 8 : rs0;
        int rs1 = rA - 3; rs1 = rs1 < 0 ? 0 : rs1; rs1 = rs1 > rows - 8 ? rows - 8 : rs1;
        const int h = 2 * hq + (wave & 1), qc = wave >> 1;
        const float* aogp = A.in[I_AON] + h * 64 + 4 * g;
        if (rs1 != rs0) attn_quad<1>(ZQ, ZK, VT, AC, rpbL, aogp, seqbase, S, rA, rs0, h, qc, l, g);
        else attn_quad<0>(ZQ, ZK, VT, AC, rpbL, aogp, seqbase, S, rA, rs0, h, qc, l, g);
        const int r = rA + hq;
        {
            const int ch = 8 * lane; const float* cw = A.in[I_CW];
            f32x4 w0a = *(const f32x4*)(cw + ch), w0b = *(const f32x4*)(cw + ch + 4), w1a = *(const f32x4*)(cw + 512 + ch), w1b = *(const f32x4*)(cw + 512 + ch + 4);
            f32x4 w2a = *(const f32x4*)(cw + 1024 + ch), w2b = *(const f32x4*)(cw + 1024 + ch + 4);
            f32x4 cga = *(const f32x4*)(A.in[I_CON] + ch), cgb = *(const f32x4*)(A.in[I_CON] + ch + 4);
            const int t0 = r * 64 + 8 * wave;
            f32x4 upa, upb, uca, ucb, una, unb;
#define LOAD_U(tt, ua, ub) do { const int t_ = (tt); if (t_ >= 0 && t_ < S) { const v4u x_ = *(const v4u*)(ZC + ((size_t)seqbase + t_) * 1024 + 512 + ch); \
                ua = (f32x4){bflo(x_.x), bfhi(x_.x), bflo(x_.y), bfhi(x_.y)}; ub = (f32x4){bflo(x_.z), bfhi(x_.z), bflo(x_.w), bfhi(x_.w)}; } \
                else { ua = (f32x4){0.f, 0.f, 0.f, 0.f}; ub = ua; } } while (0)
            LOAD_U(t0 - 1, upa, upb); LOAD_U(t0, uca, ucb);
#pragma unroll 2
            for (int i = 0; i < 8; ++i) {
                const int t = t0 + i;
                LOAD_U(t + 1, una, unb);
                const v4u b_ = *(const v4u*)(ZC + ((size_t)seqbase + t) * 1024 + ch);
                const f32x4 gba = (f32x4){bflo(b_.x), bfhi(b_.x), bflo(b_.y), bfhi(b_.y)}, gbb = (f32x4){bflo(b_.z), bfhi(b_.z), bflo(b_.w), bfhi(b_.w)};
                const f32x4 ya = gba * (upa * w0a + uca * w1a + una * w2a), yb = gbb * (upb * w0b + ucb * w1b + unb * w2b);
                float q2 = (ya[0] * ya[0] + ya[1] * ya[1]) + (ya[2] * ya[2] + ya[3] * ya[3]) + (yb[0] * yb[0] + yb[1] * yb[1]) + (yb[2] * yb[2] + yb[3] * yb[3]);
                q2 += __shfl_xor(q2, 1); q2 += __shfl_xor(q2, 2); q2 += __shfl_xor(q2, 4);
                const float rn = __builtin_amdgcn_rsqf(q2 * (1.0f / 64.0f) + EPSF);
                const f32x4 oa = ya * rn * cga, ob = yb * rn * cgb;
                v4u w; w.x = pg8::cvt_pk_bf16(oa[0], oa[1]); w.y = pg8::cvt_pk_bf16(oa[2], oa[3]); w.z = pg8::cvt_pk_bf16(ob[0], ob[1]); w.w = pg8::cvt_pk_bf16(ob[2], ob[3]);
                *(v4u*)(AC + ((size_t)seqbase + t) * 1024 + 512 + ch) = w;
                upa = uca; upb = ucb; uca = una; ucb = unb;
            }
#undef LOAD_U
        }
    }
    __syncthreads();
}

typedef GAS unsigned gu32;
#define XB_TMO      128
#define XB_XCNT(j)  (256  + 64 * (j))
#define XB_XSUB(j)  (1280 + 64 * (j))
#define XB_XGEN(j)  (2304 + 64 * (j))
#define XB_TOP      3328
#define XB_TOPGEN   3392
#define XCD_BAR_WORDS 3456
#define XB_SPIN_CAP (1u << 18)

__device__ __forceinline__ unsigned xb_ld(unsigned* p)              { return __hip_atomic_load(p, __ATOMIC_RELAXED, __HIP_MEMORY_SCOPE_AGENT); }
__device__ __forceinline__ unsigned xb_add(unsigned* p, unsigned v) { return __hip_atomic_fetch_add(p, v, __ATOMIC_RELAXED, __HIP_MEMORY_SCOPE_AGENT); }
__device__ __forceinline__ unsigned xb_xcc_id() { return (unsigned)__builtin_amdgcn_s_getreg((3 << 11) | 20) & 0xFu; }
#define XB_SPIN(cond, bar) do { unsigned _sp = 0; while (cond) { __builtin_amdgcn_s_sleep(1); \
    if ((++_sp & 255u) == 0u) { if (xb_ld(&(bar)[XB_TMO])) break; if (_sp > XB_SPIN_CAP) { atomicAdd(&(bar)[XB_TMO], 1u); break; } } } } while (0)

struct XcdBarrier {
    unsigned* bar; unsigned x;
    volatile LAS unsigned* st;
};

__device__ __forceinline__ XcdBarrier xcd_barrier_post(unsigned* bar, volatile LAS unsigned* st, bool t0) {
    XcdBarrier b; b.bar = bar; b.x = xb_xcc_id(); b.st = st;
    if (t0) (void)xb_add(&bar[XB_XCNT(b.x)], 1u);
    return b;
}
__device__ __forceinline__ void xcd_barrier_complete(unsigned* bar, unsigned x, unsigned& nloc, unsigned& nx) {
    const unsigned G = gridDim.x * gridDim.y * gridDim.z;
    unsigned sum, cnt, mine, sp = 0u;
    for (;;) {
        sum = 0u; cnt = 0u; mine = 0u;
#pragma unroll
        for (unsigned j = 0; j < 16; ++j) { const unsigned c = xb_ld(&bar[XB_XCNT(j)]); sum += c; cnt += (c > 0u) ? 1u : 0u; mine = (j == x) ? c : mine; }
        if (sum == G) break;
        __builtin_amdgcn_s_sleep(1);
        if ((++sp & 255u) == 0u) { if (xb_ld(&bar[XB_TMO])) break; if (sp > XB_SPIN_CAP) { atomicAdd(&bar[XB_TMO], 1u); break; } }
    }
    nloc = mine > 0u ? mine : 1u; nx = cnt > 0u ? cnt : 1u;
}

__device__ __forceinline__ void xcd_barrier(const XcdBarrier& b, bool t0) {
    asm volatile("s_waitcnt vmcnt(0)" ::: "memory");
    __syncthreads();
    if (t0) {
        unsigned* bar = b.bar;
        __builtin_amdgcn_s_waitcnt(0);
        unsigned nloc = b.st[0], nx = b.st[1];
        if (nloc == 0u) { xcd_barrier_complete(bar, b.x, nloc, nx); b.st[0] = nloc; b.st[1] = nx; }
        const unsigned old = xb_add(&bar[XB_XSUB(b.x)], 1u);
        const unsigned gen = old / nloc;
        if (old + 1u == (gen + 1u) * nloc) {
            __builtin_amdgcn_fence(__ATOMIC_RELEASE, "agent");
            asm volatile("s_waitcnt vmcnt(0)" ::: "memory");
            const unsigned og = xb_add(&bar[XB_TOP], 1u);
            const unsigned tg = og / nx;
            if (og + 1u == (tg + 1u) * nx) xb_add(&bar[XB_TOPGEN], 1u);
            else XB_SPIN(xb_ld(&bar[XB_TOPGEN]) == tg, bar);
            __builtin_amdgcn_fence(__ATOMIC_ACQUIRE, "agent");
            xb_add(&bar[XB_XGEN(b.x)], 1u);
            asm volatile("s_waitcnt vmcnt(0)" ::: "memory");
        } else {
            XB_SPIN(xb_ld(&bar[XB_XGEN(b.x)]) == gen, bar);
            __builtin_amdgcn_fence(__ATOMIC_ACQUIRE, "agent");
            asm volatile("s_waitcnt vmcnt(0)" ::: "memory");
        }
    }
    __syncthreads();
}

#ifndef PROBE_DUP
#define PROBE_DUP -1
#endif
__global__ void __launch_bounds__(NWAVES * 64, 2) enc_fwd(Args args) {
    extern __shared__ __attribute__((aligned(16))) unsigned char lds_raw[];
    LAS unsigned char* lds = (LAS unsigned char*)lds_raw;
    cg::grid_group grid = cg::this_grid();
    const int G = gridDim.x; const int bx = blockIdx.x;
    const int vcu = (G % 8 == 0) ? (bx % 8) * (G / 8) + bx / 8 : bx;
    const int NGW = G * NWAVES;
    const int wave = __builtin_amdgcn_readfirstlane((int)threadIdx.x >> 6);
#define FRESH_IDS() int lane_ = (int)__builtin_amdgcn_mbcnt_hi(~0u, __builtin_amdgcn_mbcnt_lo(~0u, 0u)); asm volatile("" : "+v"(lane_)); const int lane = lane_, gw = vcu * NWAVES + wave; (void)gw; (void)lane
    unsigned char* ws = args.ws;
    const int lo = args.ph_lo, hi = args.ph_hi;
#define IN(k) (lo <= (k) && (k) < hi)
    volatile LAS unsigned* MISC = (volatile LAS unsigned*)(lds + RING_BYTES + 1024);
    const bool t0 = (wave == 0) && ((int)__builtin_amdgcn_mbcnt_hi(~0u, __builtin_amdgcn_mbcnt_lo(~0u, 0u)) == 0);
    if (t0) { MISC[0] = 0u; MISC[1] = 0u; }
    __syncthreads();
    XcdBarrier xbar = xcd_barrier_post((unsigned*)(ws + WS_CTL) + 1024, MISC, t0 && (hi - lo) > 1);
#define SEAM(k) do { if (IN(k) && IN((k) + 1)) { if ((k) == 0) grid.sync(); else xcd_barrier(xbar, (wave == 0) && ((int)__builtin_amdgcn_mbcnt_hi(~0u, __builtin_amdgcn_mbcnt_lo(~0u, 0u)) == 0)); } } while (0)
    bf16* XB = (bf16*)(ws + WS_XB); bf16* ACT = (bf16*)(ws + WS_ACT); bf16* ACB = (bf16*)(ws + WS_AC);
    float* SS1 = (float*)(ws + WS_SS1); float* SS2 = (float*)(ws + WS_SS2);

    if (IN(0)) { FRESH_IDS(); p0_prologue(args, lds, gw, NGW, wave, lane); __syncthreads(); }
#if PROBE_DUP == 0
    if (IN(0)) { FRESH_IDS(); p0_prologue(args, lds, gw, NGW, wave, lane); __syncthreads(); }
#endif
    SEAM(0);
    if (IN(1)) { pg8::Gemm g{XB, (const bf16*)(ws + WS_W1GU), M_TOK, NGU, D, wave}; pg8::StaticOrder S; S.init(M_TOK, NGU, G, bx);
        pg8::EpiSwiGLU<false> E{ACT, FF, nullptr};
        pg8::gemm_phase<pg8::EpiSwiGLU<false>, pg8::StaticOrder, true, true>(lds, g, S, E); }
#if PROBE_DUP == 1
    if (IN(1)) { pg8::Gemm g{XB, (const bf16*)(ws + WS_W1GU), M_TOK, NGU, D, wave}; pg8::StaticOrder S; S.init(M_TOK, NGU, G, bx);
        pg8::EpiSwiGLU<false> E{ACT, FF, nullptr};
        pg8::gemm_phase<pg8::EpiSwiGLU<false>, pg8::StaticOrder, true, true>(lds, g, S, E); }
#endif
    SEAM(1);
    if (IN(2)) { pg8::Gemm g{ACT, (const bf16*)(ws + WS_W1D), M_TOK, D, FF, wave}; pg8::RevOrder S; S.init(M_TOK, D, G, bx);
        pg8::EpiResid<2, true> E{args.in[I_F1N], (const float*)(ws + WS_RS0), XB, SS1, 0.5f};
        pg8::gemm_phase<pg8::EpiResid<2, true>, pg8::RevOrder, true, true>(lds, g, S, E); }
#if PROBE_DUP == 2
    if (IN(2)) { pg8::Gemm g{ACT, (const bf16*)(ws + WS_W1D), M_TOK, D, FF, wave}; pg8::RevOrder S; S.init(M_TOK, D, G, bx);
        pg8::EpiResid<2, true> E{args.in[I_F1N], (const float*)(ws + WS_RS0), XB, SS1, 0.5f};
        pg8::gemm_phase<pg8::EpiResid<2, true>, pg8::RevOrder, true, true>(lds, g, S, E); }
#endif
    SEAM(2);
    if (IN(3)) { pg8::Gemm g{XB, (const bf16*)(ws + WS_WIN), M_TOK, DIN, D, wave}; pg8::StaticOrder S; S.init(M_TOK, DIN, G, bx);
        pg8::EpiWin E{SS1, (bf16*)(ws + WS_ZQ), (bf16*)(ws + WS_ZK), (bf16*)(ws + WS_VT), (bf16*)(ws + WS_ZC), args.in[I_QN], args.in[I_KN]};
        pg8::gemm_phase<pg8::EpiWin, pg8::StaticOrder, true, true>(lds, g, S, E); }
#if PROBE_DUP == 3
    if (IN(3)) { pg8::Gemm g{XB, (const bf16*)(ws + WS_WIN), M_TOK, DIN, D, wave}; pg8::StaticOrder S; S.init(M_TOK, DIN, G, bx);
        pg8::EpiWin E{SS1, (bf16*)(ws + WS_ZQ), (bf16*)(ws + WS_ZK), (bf16*)(ws + WS_VT), (bf16*)(ws + WS_ZC), args.in[I_QN], args.in[I_KN]};
        pg8::gemm_phase<pg8::EpiWin, pg8::StaticOrder, true, true>(lds, g, S, E); }
#endif
    SEAM(3);
    if (IN(4)) { FRESH_IDS(); attn_conv_phase(args, lds, wave, lane); }
#if PROBE_DUP == 4
    if (IN(4)) { FRESH_IDS(); attn_conv_phase(args, lds, wave, lane); }
#endif
    SEAM(4);
    if (IN(5)) { pg8::Gemm g{ACB, (const bf16*)(ws + WS_WOUT), M_TOK, D, D, wave}; pg8::StaticOrder S; S.init(M_TOK, D, G, bx);
        pg8::EpiResid<1, true> E{nullptr, nullptr, XB, SS2, 1.0f};
        pg8::gemm_phase<pg8::EpiResid<1, true>, pg8::StaticOrder, true, true>(lds, g, S, E); } SEAM(5);
    if (IN(6)) { pg8::Gemm g{XB, (const bf16*)(ws + WS_W2GU), M_TOK, NGU, D, wave}; pg8::RevOrder S; S.init(M_TOK, NGU, G, bx);
        pg8::EpiSwiGLU<true> E{ACT, FF, SS2};
        pg8::gemm_phase<pg8::EpiSwiGLU<true>, pg8::RevOrder, true, true>(lds, g, S, E); }
#if PROBE_DUP == 6
    if (IN(6)) { pg8::Gemm g{XB, (const bf16*)(ws + WS_W2GU), M_TOK, NGU, D, wave}; pg8::RevOrder S; S.init(M_TOK, NGU, G, bx);
        pg8::EpiSwiGLU<true> E{ACT, FF, SS2};
        pg8::gemm_phase<pg8::EpiSwiGLU<true>, pg8::RevOrder, true, true>(lds, g, S, E); }
#endif
    SEAM(6);
    if (IN(7)) { pg8::Gemm g{ACT, (const bf16*)(ws + WS_W2D), M_TOK, D, FF, wave}; pg8::StaticOrder S; S.init(M_TOK, D, G, bx);
        pg8::EpiResid<1, false> E{nullptr, nullptr, XB, nullptr, 0.5f};
        pg8::gemm_phase<pg8::EpiResid<1, false>, pg8::StaticOrder, true, true>(lds, g, S, E); } SEAM(7);
    if (IN(8)) { FRESH_IDS(); final_norm_phase(args, gw, NGW, lane); }
#undef IN
#undef SEAM
}

#ifndef MK_N_LAUNCHES
#define MK_N_LAUNCHES 1
#endif
extern "C" void kernel_launch(void* const* d_in, const int* in_sizes, int n_in, void* d_out, int out_size, void* d_ws, size_t ws_size, hipStream_t stream) {
    static int grid = 0;
    if (grid == 0) {
        if (n_in != 20 || in_sizes[0] != MP * D || out_size != M_TOK * D || ws_size < WS_END) { fprintf(stderr, "kernel_launch: unexpected shapes (n_in %d, in0 %d, out %d, ws %zu)\n", n_in, n_in > 0 ? in_sizes[0] : -1, out_size, ws_size); grid = -1; return; }
        int dev = 0, cus = 0, per_cu = 0;
        if (hipGetDevice(&dev) != hipSuccess || hipDeviceGetAttribute(&cus, hipDeviceAttributeMultiprocessorCount, dev) != hipSuccess) { grid = -1; return; }
        if (hipFuncSetAttribute((const void*)enc_fwd, hipFuncAttributeMaxDynamicSharedMemorySize, LDS_BYTES) != hipSuccess) { fprintf(stderr, "kernel_launch: hipFuncSetAttribute failed\n"); grid = -1; return; }
        if (hipOccupancyMaxActiveBlocksPerMultiprocessor(&per_cu, (const void*)enc_fwd, NWAVES * 64, LDS_BYTES) != hipSuccess || per_cu < 1) { fprintf(stderr, "kernel_launch: occupancy query says %d\n", per_cu); per_cu = 1; }
        (void)hipGetLastError();
        if (cus * per_cu < 256) { fprintf(stderr, "kernel_launch: needs 256 co-resident workgroups, device offers %d\n", cus * per_cu); grid = -1; return; }
        grid = 256;
    }
    if (grid < 0) return;
    if (hipMemsetAsync((char*)d_ws + WS_CTL, 0, CTL_ZERO_BYTES, stream) != hipSuccess) { fprintf(stderr, "kernel_launch: memset failed\n"); return; }
    Args a{};
    for (int i = 0; i < 20; ++i) a.in[i] = (const float*)d_in[i];
    a.out = (float*)d_out; a.ws = (unsigned char*)d_ws;
#if MK_N_LAUNCHES == 1
    a.ph_lo = 0; a.ph_hi = 9;
    void* kargs[] = {&a};
    hipError_t e = hipLaunchCooperativeKernel((const void*)enc_fwd, dim3(grid), dim3(NWAVES * 64), kargs, LDS_BYTES, stream);
    if (e != hipSuccess) fprintf(stderr, "kernel_launch: cooperative launch failed: %s (grid %d)\n", hipGetErrorString(e), grid);
#else
    for (int p = 0; p < 9; ++p) {
        a.ph_lo = p; a.ph_hi = p + 1;
        hipLaunchKernelGGL(enc_fwd, dim3(grid), dim3(NWAVES * 64), LDS_BYTES, stream, a);
    }
#endif
}
```

```cpp
#include <hip/hip_runtime.h>
#include <hip/hip_cooperative_groups.h>
#include <cstdio>
#include <cstdint>
#include <cmath>
namespace cg = cooperative_groups;
namespace pg8 {
#define PG8_LAS __attribute__((address_space(3)))
typedef unsigned short bf16_t;
typedef short bf16x8 __attribute__((ext_vector_type(8)));
typedef float f32x4 __attribute__((ext_vector_type(4)));
typedef unsigned u32x4 __attribute__((ext_vector_type(4)));
constexpr int BM = 256, BK = 64, HALF = 128, HTB = HALF * BK * 2  , STAGE_BYTES = 8 * HTB, NXCD = 8, WGM = 8;

__host__ __device__ __forceinline__ int lds_byte(int r, int c) { const int st = (r >> 4) * 2 + (c >> 5), rr = r & 15, cc = c & 31, ob = rr * 64 + cc * 2; return st * 1024 + (ob ^ (((ob >> 9) & 1) << 5)); }
__host__ __device__ __forceinline__ void stage_rc(int b, int& R, int& C) { const int st = b / 1024, sb = b % 1024, swz = sb ^ (((sb >> 9) & 1) << 5); R = (st >> 1) * 16 + swz / 64; C = (st & 1) * 32 + (swz % 64) / 2; }
__host__ __device__ __forceinline__ int perm32(int rho) { const int n = rho >> 4, i = rho & 15; return 8 * (i >> 2) + 4 * n + (i & 3); }

struct Unit { int pm, pn; };
struct Gemm { const bf16_t* A; const bf16_t* Bt; int M, N, K, wid; };

struct StaticOrder {
    int nM, nN, nwg, G, c;
    __host__ __device__ void init(int M, int N, int G_, int c_) { nM = M / BM; nN = N / BM; nwg = nM * nN; G = G_; c = c_; }
    __host__ __device__ bool next(int i, Unit& u) const {
        const long L = (long)i * G + c; if (L >= nwg) return false;
        int wgid = (int)L; { const int q = nwg / NXCD, r = nwg % NXCD, xcd = wgid % NXCD, off = wgid / NXCD; wgid = (xcd < r ? xcd * (q + 1) : r * (q + 1) + (xcd - r) * q) + off; }
        const int nig = WGM * nN, gid = wgid / nig, fm = gid * WGM, gsz = (nM - fm) < WGM ? (nM - fm) : WGM;
        u.pm = fm + ((wgid % nig) % gsz); u.pn = (wgid % nig) / gsz; return true;
    }
    __device__ __forceinline__ void a_ready(const Unit&) const {}
    __device__ __forceinline__ void done(const Unit&) const {}
};
struct RevOrder : StaticOrder {
    __host__ __device__ bool next(int i, Unit& u) const { if (!StaticOrder::next(i, u)) return false; if (nM == 320) u.pm = 40 * (u.pm / 40) + 39 - (u.pm % 40); return true; }
};
__device__ __forceinline__ unsigned cvt_pk_bf16(float lo, float hi) { unsigned r; asm volatile("v_cvt_pk_bf16_f32 %0, %1, %2" : "=v"(r) : "v"(lo), "v"(hi)); return r; }
typedef float f32x2 __attribute__((ext_vector_type(2)));
constexpr float RMS_EPS = 1e-6f;
typedef unsigned u32x2 __attribute__((ext_vector_type(2)));
__device__ __forceinline__ float row_rstd16(const float* ssrow) {
    const f32x4 a = *(const f32x4*)(ssrow), b = *(const f32x4*)(ssrow + 4), c = *(const f32x4*)(ssrow + 8), d = *(const f32x4*)(ssrow + 12);
    const float s = ((a[0] + a[1]) + (a[2] + a[3])) + ((b[0] + b[1]) + (b[2] + b[3])) + ((c[0] + c[1]) + (c[2] + c[3])) + ((d[0] + d[1]) + (d[2] + d[3]));
    return __builtin_amdgcn_rsqf(s * (1.0f / 1024.0f) + RMS_EPS);
}
__device__ __forceinline__ float row_rstd16_coop(const float* ssrow, int fq) {
    const f32x4 a = *(const f32x4*)(ssrow + 4 * fq);
    float s = (a[0] + a[1]) + (a[2] + a[3]);
    s += __shfl_xor(s, 16); s += __shfl_xor(s, 32);
    return __builtin_amdgcn_rsqf(s * (1.0f / 1024.0f) + RMS_EPS);
}
__device__ __forceinline__ float silu_mul(float g, float u) { return g * u * __builtin_amdgcn_rcpf(1.0f + __builtin_amdgcn_exp2f(-1.4426950408889634f * g)); }

template <bool HAS_RSTD> struct EpiSwiGLU {
    static constexpr bool PERM = true, AFTER_DRAIN = false;
    bf16_t* O; int ldc; const float* ss;
    __device__ __forceinline__ void operator()(const f32x4 (&acc)[2][2][4][2], const Unit& u, int wr, int wc, int fr, int fq) const {
        const int row0 = u.pm * BM + wr * 64 + fr, col0 = u.pn * HALF + wc * 32 + 8 * fq;
        float rsv[8];
#pragma unroll
        for (int i = 0; i < 8; ++i) rsv[i] = HAS_RSTD ? row_rstd16_coop(ss + (size_t)(row0 + (i >> 2) * HALF + (i & 3) * 16) * 16, fq) : 1.0f;
#pragma unroll
        for (int ai = 0; ai < 2; ++ai)
#pragma unroll
            for (int m = 0; m < 4; ++m) {
                const int row = row0 + ai * HALF + m * 16;
                const float rs = rsv[ai * 4 + m];
                const f32x4 g0 = acc[ai][0][m][0] * rs, g1 = acc[ai][0][m][1] * rs, u0 = acc[ai][1][m][0] * rs, u1 = acc[ai][1][m][1] * rs;
                u32x4 w;
                w.x = cvt_pk_bf16(silu_mul(g0[0], u0[0]), silu_mul(g0[1], u0[1])); w.y = cvt_pk_bf16(silu_mul(g0[2], u0[2]), silu_mul(g0[3], u0[3]));
                w.z = cvt_pk_bf16(silu_mul(g1[0], u1[0]), silu_mul(g1[1], u1[1])); w.w = cvt_pk_bf16(silu_mul(g1[2], u1[2]), silu_mul(g1[3], u1[3]));
                *(u32x4*)(O + (size_t)row * ldc + col0) = w;
            }
    }
};

__device__ __forceinline__ u32x4 xchg8(u32x4 v) {
    u32x4 r;
    r.x = (unsigned)__builtin_amdgcn_update_dpp(0, (int)v.x, 0x128, 0xf, 0xf, false); r.y = (unsigned)__builtin_amdgcn_update_dpp(0, (int)v.y, 0x128, 0xf, 0xf, false);
    r.z = (unsigned)__builtin_amdgcn_update_dpp(0, (int)v.z, 0x128, 0xf, 0xf, false); r.w = (unsigned)__builtin_amdgcn_update_dpp(0, (int)v.w, 0x128, 0xf, 0xf, false);
    return r;
}
__device__ __forceinline__ void store_rows16(bf16_t* base, int ld, u32x4 w0, u32x4 w1, int fr, int fq) {
    const bool hi = (fr & 8) != 0;
    const u32x4 rcv = xchg8(hi ? w0 : w1);
    bf16_t* p = base + (size_t)(fr & 7) * ld + (hi ? 32 : 0) + 8 * fq;
    *(u32x4*)p = hi ? rcv : w0; *(u32x4*)(p + (size_t)8 * ld) = hi ? w1 : rcv;
}
__device__ __forceinline__ void load_rows16_issue(const bf16_t* base, int ld, int fr, int fq, u32x4& la, u32x4& lb) {
    const bf16_t* p = base + (size_t)(fr & 7) * ld + ((fr & 8) ? 32 : 0) + 8 * fq;
    la = *(const u32x4*)p; lb = *(const u32x4*)(p + (size_t)8 * ld);
}
__device__ __forceinline__ void load_rows16_finish(u32x4 la, u32x4 lb, int fr, u32x4& r0, u32x4& r1) {
    const bool hi = (fr & 8) != 0;
    const u32x4 rcv = xchg8(hi ? la : lb);
    r0 = hi ? rcv : la; r1 = hi ? lb : rcv;
}

template <int RES_MODE, bool WRITE_SS> struct EpiResid {
    static constexpr bool PERM = true, AFTER_DRAIN = false;
    const float* g; const float* rstd0;
    bf16_t* xb; float* ss; float alpha;
    __device__ __forceinline__ void operator()(const f32x4 (&acc)[2][2][4][2], const Unit& u, int wr, int wc, int fr, int fq) const {
        const int rowg = u.pm * BM + wr * 64, colw = u.pn * BM + wc * 64;
        f32x4 gi[2][2]; float ri[8];
        if (RES_MODE == 2) {
#pragma unroll
            for (int bj = 0; bj < 2; ++bj)
#pragma unroll
                for (int n = 0; n < 2; ++n) { const f32x4 gv = *(const f32x4*)(g + colw + 32 * bj + 8 * fq + 4 * n); gi[bj][n] = (f32x4){__builtin_amdgcn_rcpf(gv[0]), __builtin_amdgcn_rcpf(gv[1]), __builtin_amdgcn_rcpf(gv[2]), __builtin_amdgcn_rcpf(gv[3])}; }
#pragma unroll
            for (int i = 0; i < 8; ++i) ri[i] = __builtin_amdgcn_rcpf(rstd0[rowg + (i >> 2) * HALF + (i & 3) * 16 + fr]);
        }
        bf16_t* xw = xb + (size_t)rowg * 1024 + colw;
        u32x4 la[2][4], lb[2][4];
#pragma unroll
        for (int ai = 0; ai < 2; ++ai)
#pragma unroll
            for (int m = 0; m < 4; ++m) load_rows16_issue(xw + (size_t)(ai * HALF + m * 16) * 1024, 1024, fr, fq, la[ai][m], lb[ai][m]);
#pragma unroll
        for (int ai = 0; ai < 2; ++ai)
#pragma unroll
            for (int m = 0; m < 4; ++m) {
                u32x4 q[2]; load_rows16_finish(la[ai][m], lb[ai][m], fr, q[0], q[1]);
                u32x4 w[2]; float s = 0.f;
#pragma unroll
                for (int bj = 0; bj < 2; ++bj) {
                    f32x4 r0 = (f32x4){__builtin_bit_cast(float, q[bj].x << 16), __builtin_bit_cast(float, q[bj].x & 0xffff0000u), __builtin_bit_cast(float, q[bj].y << 16), __builtin_bit_cast(float, q[bj].y & 0xffff0000u)};
                    f32x4 r1 = (f32x4){__builtin_bit_cast(float, q[bj].z << 16), __builtin_bit_cast(float, q[bj].z & 0xffff0000u), __builtin_bit_cast(float, q[bj].w << 16), __builtin_bit_cast(float, q[bj].w & 0xffff0000u)};
                    if (RES_MODE == 2) { r0 = r0 * gi[bj][0] * ri[ai * 4 + m]; r1 = r1 * gi[bj][1] * ri[ai * 4 + m]; }
                    const f32x4 v0 = r0 + acc[ai][bj][m][0] * alpha, v1 = r1 + acc[ai][bj][m][1] * alpha;
                    w[bj].x = cvt_pk_bf16(v0[0], v0[1]); w[bj].y = cvt_pk_bf16(v0[2], v0[3]); w[bj].z = cvt_pk_bf16(v1[0], v1[1]); w[bj].w = cvt_pk_bf16(v1[2], v1[3]);
                    if (WRITE_SS) s += (v0[0] * v0[0] + v0[1] * v0[1]) + (v0[2] * v0[2] + v0[3] * v0[3]) + (v1[0] * v1[0] + v1[1] * v1[1]) + (v1[2] * v1[2] + v1[3] * v1[3]);
                }
                store_rows16(xw + (size_t)(ai * HALF + m * 16) * 1024, 1024, w[0], w[1], fr, fq);
                if (WRITE_SS) { s += __shfl_xor(s, 16); s += __shfl_xor(s, 32); if (fq == 0) ss[(size_t)(rowg + ai * HALF + m * 16 + fr) * 16 + u.pn * 4 + wc] = s; }
            }
    }
};

struct EpiWin {
    static constexpr bool PERM = true, AFTER_DRAIN = false;
    const float* ss; bf16_t *ZQ, *ZK, *VT, *ZC; const float *qg, *kg;
    __device__ __forceinline__ void operator()(const f32x4 (&acc)[2][2][4][2], const Unit& u, int wr, int wc, int fr, int fq) const {
        const int row0 = u.pm * BM + wr * 64 + fr, pn = u.pn;
        float rsv[8];
#pragma unroll
        for (int i = 0; i < 8; ++i) rsv[i] = row_rstd16_coop(ss + (size_t)(row0 + (i >> 2) * HALF + (i & 3) * 16) * 16, fq);
        if (pn < 4) {
            const bool isq = pn < 2; const float* gp = (isq ? qg : kg) + 8 * fq; const float gs = isq ? 0.125f * 1.4426950408889634f : 1.0f;
            f32x4 gn[2][2];
#pragma unroll
            for (int bj = 0; bj < 2; ++bj)
#pragma unroll
                for (int n = 0; n < 2; ++n) gn[bj][n] = *(const f32x4*)(gp + 32 * bj + 4 * n) * gs;
            bf16_t* Z = (isq ? ZQ : ZK) + (pn & 1) * 256 + wc * 64 + (size_t)(u.pm * BM + wr * 64) * 512;
#pragma unroll
            for (int ai = 0; ai < 2; ++ai)
#pragma unroll
                for (int m = 0; m < 4; ++m) {
                    const int row = row0 + ai * HALF + m * 16; const float rs = rsv[ai * 4 + m];
                    f32x4 v[2][2]; float s = 0.f;
#pragma unroll
                    for (int bj = 0; bj < 2; ++bj)
#pragma unroll
                        for (int n = 0; n < 2; ++n) { v[bj][n] = acc[ai][bj][m][n] * rs; const f32x4 x = v[bj][n]; s += (x[0] * x[0] + x[1] * x[1]) + (x[2] * x[2] + x[3] * x[3]); }
                    s += __shfl_xor(s, 16); s += __shfl_xor(s, 32);
                    const float rn = __builtin_amdgcn_rsqf(s * (1.0f / 64.0f) + RMS_EPS);
                    u32x4 w[2];
#pragma unroll
                    for (int bj = 0; bj < 2; ++bj) {
                        const f32x4 a = v[bj][0] * gn[bj][0] * rn, b = v[bj][1] * gn[bj][1] * rn;
                        w[bj].x = cvt_pk_bf16(a[0], a[1]); w[bj].y = cvt_pk_bf16(a[2], a[3]); w[bj].z = cvt_pk_bf16(b[0], b[1]); w[bj].w = cvt_pk_bf16(b[2], b[3]);
                    }
                    store_rows16(Z + (size_t)(ai * HALF + m * 16) * 512, 512, w[0], w[1], fr, fq);
                }
        } else if (pn < 6) {
            const int rowt = u.pm * BM; const int S = (rowt < 65536) ? 2048 : 4096; const int h = 4 * (pn - 4) + wc;
#pragma unroll
            for (int ai = 0; ai < 2; ++ai)
#pragma unroll
                for (int m = 0; m < 4; ++m) {
                    const int row = row0 + ai * HALF + m * 16; const float rs = rsv[ai * 4 + m];
                    const int t = row & (S - 1); bf16_t* vp = VT + (size_t)(row - t) * 512 + (size_t)(h * 64 + 8 * fq) * S + t;
#pragma unroll
                    for (int bj = 0; bj < 2; ++bj)
#pragma unroll
                        for (int n = 0; n < 2; ++n) {
                            const f32x4 x = acc[ai][bj][m][n] * rs; const unsigned p0 = cvt_pk_bf16(x[0], x[1]), p1 = cvt_pk_bf16(x[2], x[3]);
                            bf16_t* q = vp + (size_t)(32 * bj + 4 * n) * S;
                            q[0] = (bf16_t)(p0 & 0xffffu); q[(size_t)S] = (bf16_t)(p0 >> 16); q[(size_t)2 * S] = (bf16_t)(p1 & 0xffffu); q[(size_t)3 * S] = (bf16_t)(p1 >> 16);
                        }
                }
        } else if (pn < 8) {
            bf16_t* Z = ZC + (pn - 6) * 256 + wc * 64 + (size_t)(u.pm * BM + wr * 64) * 1024;
#pragma unroll
            for (int ai = 0; ai < 2; ++ai)
#pragma unroll
                for (int m = 0; m < 4; ++m) {
                    const float rs = rsv[ai * 4 + m];
                    u32x4 w[2];
#pragma unroll
                    for (int bj = 0; bj < 2; ++bj) {
                        const f32x4 a = acc[ai][bj][m][0] * rs, b = acc[ai][bj][m][1] * rs;
                        w[bj].x = cvt_pk_bf16(a[0], a[1]); w[bj].y = cvt_pk_bf16(a[2], a[3]); w[bj].z = cvt_pk_bf16(b[0], b[1]); w[bj].w = cvt_pk_bf16(b[2], b[3]);
                    }
                    store_rows16(Z + (size_t)(ai * HALF + m * 16) * 1024, 1024, w[0], w[1], fr, fq);
                }
        } else {
            bf16_t* Z = ZC + 512 + (pn - 8) * 128 + wc * 32 + 8 * fq + (size_t)row0 * 1024;
#pragma unroll
            for (int ai = 0; ai < 2; ++ai)
#pragma unroll
                for (int m = 0; m < 4; ++m) {
                    const float rs = rsv[ai * 4 + m], rs2 = rs * rs;
                    const f32x4 a = acc[ai][0][m][0] * acc[ai][1][m][0] * rs2, b = acc[ai][0][m][1] * acc[ai][1][m][1] * rs2;
                    u32x4 w; w.x = cvt_pk_bf16(a[0], a[1]); w.y = cvt_pk_bf16(a[2], a[3]); w.z = cvt_pk_bf16(b[0], b[1]); w.w = cvt_pk_bf16(b[2], b[3]);
                    *(u32x4*)(Z + (size_t)(ai * HALF + m * 16) * 1024) = w;
                }
        }
    }
};

template <class Epi, class Sched, bool ALIGN_EPI = false, bool SP2 = false>
__device__ __forceinline__ void gemm_phase(PG8_LAS unsigned char* lds, const Gemm g, const Sched& S, const Epi& E) {
    const int wid = g.wid, lane = (int)__builtin_amdgcn_mbcnt_hi(~0u, __builtin_amdgcn_mbcnt_lo(~0u, 0u)), tid = wid * 64 + lane, wr = wid >> 2, wc = wid & 3, fr = lane & 15, fq = lane >> 4;
    const int K = g.K, nt = K / BK;
    unsigned voffA[2], voffB[2];
#pragma unroll
    for (int i = 0; i < 2; ++i) { int R, C; stage_rc(tid * 16 + i * 8192, R, C); const int Rb = Epi::PERM ? ((R & ~31) + perm32(R & 31)) : R;
        voffA[i] = (unsigned)(R * K + C) * 2u; voffB[i] = (unsigned)(Rb * K + C) * 2u; }
    const size_t kstep = (size_t)(BK * 2);
    const size_t hstep = (size_t)HALF * K * 2;
    const size_t tstep = 2 * hstep;
    const unsigned ldsw = (unsigned)wid * 1024u;
    const int aoff = lds_byte(wr * 64 + fr, fq * 8), boff = lds_byte(wc * 32 + fr, fq * 8);
#define PG8_SA(b, h) (((b) * 2 + (h)) * HTB)
#define PG8_SB(b, h) ((4 + (b) * 2 + (h)) * HTB)
#define PG8_STAGE(bufoff, gbase, voff) do { _Pragma("unroll") for (int _i = 0; _i < 2; ++_i) \
        __builtin_amdgcn_global_load_lds((const unsigned*)((const char*)(gbase) + (voff)[_i]), (PG8_LAS unsigned*)(lds + (bufoff) + ldsw + _i * 8192), 16, 0, 0); } while (0)
#define PG8_LDA(dst, b, h) do { _Pragma("unroll") for (int m = 0; m < 4; ++m) _Pragma("unroll") for (int k = 0; k < 2; ++k) dst[m][k] = *(const PG8_LAS bf16x8*)(lds + PG8_SA(b, h) + aoff + m * 2048 + k * 1024); } while (0)
#define PG8_LDB(dst, b, h) do { _Pragma("unroll") for (int n = 0; n < 2; ++n) _Pragma("unroll") for (int k = 0; k < 2; ++k) dst[n][k] = *(const PG8_LAS bf16x8*)(lds + PG8_SB(b, h) + boff + n * 2048 + k * 1024); } while (0)
#define PG8_MMA(ai, bj, At, Bt) do { __builtin_amdgcn_s_setprio(1); _Pragma("unroll") for (int m = 0; m < 4; ++m) _Pragma("unroll") for (int n = 0; n < 2; ++n) _Pragma("unroll") for (int k = 0; k < 2; ++k) \
        acc[ai][bj][m][n] = __builtin_amdgcn_mfma_f32_16x16x32_bf16(Bt[n][k], At[m][k], acc[ai][bj][m][n], 0, 0, 0); __builtin_amdgcn_s_setprio(0); } while (0)
#define PG8_WAIT_V(n) asm volatile("s_waitcnt vmcnt(" #n ")" ::: "memory")
#define PG8_WAIT_L(n) asm volatile("s_waitcnt lgkmcnt(" #n ")" ::: "memory")
#define PG8_BAR __builtin_amdgcn_s_barrier()
#define PG8_SCHED __builtin_amdgcn_sched_barrier(0)
    Unit cur, nxt; int ui = 0;
    if (!S.next(0, cur)) return;
    f32x4 acc[2][2][4][2];
#pragma unroll
    for (int a = 0; a < 2; ++a)
#pragma unroll
        for (int b = 0; b < 2; ++b)
#pragma unroll
            for (int m = 0; m < 4; ++m)
#pragma unroll
                for (int n = 0; n < 2; ++n) acc[a][b][m][n] = (f32x4){0.f, 0.f, 0.f, 0.f};
    bf16x8 At[4][2], B0[2][2], B1[2][2];
    const char* cA = (const char*)g.A + (size_t)cur.pm * tstep; const char* cB = (const char*)g.Bt + (size_t)cur.pn * tstep;
    S.a_ready(cur);
    if constexpr (SP2) {
        PG8_STAGE(PG8_SB(0, 0), cB, voffB); PG8_STAGE(PG8_SB(0, 1), cB + hstep, voffB); PG8_STAGE(PG8_SA(0, 0), cA, voffA); PG8_STAGE(PG8_SA(0, 1), cA + hstep, voffA);
        if (wr == 1) PG8_BAR;
        PG8_WAIT_V(2); PG8_BAR;
        PG8_STAGE(PG8_SB(1, 0), cB + kstep, voffB); PG8_STAGE(PG8_SA(1, 0), cA + kstep, voffA); PG8_STAGE(PG8_SB(1, 1), cB + hstep + kstep, voffB);
        PG8_WAIT_V(6); PG8_BAR;
    } else {
        PG8_STAGE(PG8_SB(0, 0), cB, voffB); PG8_STAGE(PG8_SA(0, 0), cA, voffA); PG8_STAGE(PG8_SB(0, 1), cB + hstep, voffB); PG8_STAGE(PG8_SA(0, 1), cA + hstep, voffA);
        if (wr == 1) PG8_BAR;
        PG8_WAIT_V(4); PG8_BAR;
        PG8_STAGE(PG8_SB(1, 0), cB + kstep, voffB); PG8_STAGE(PG8_SA(1, 0), cA + kstep, voffA); PG8_STAGE(PG8_SB(1, 1), cB + hstep + kstep, voffB);
        PG8_WAIT_V(6); PG8_BAR;
    }
    for (;;) {
        const bool has_next = S.next(ui + 1, nxt);
        const char* nA = has_next ? (const char*)g.A + (size_t)nxt.pm * tstep : cA; const char* nB = has_next ? (const char*)g.Bt + (size_t)nxt.pn * tstep : cB;
        for (int t = 0; t < nt; t += 2) {
            const bool last = (t == nt - 2);
            const char* a1 = cA + (size_t)(t + 1) * kstep;
            const char* a2 = last ? nA : cA + (size_t)(t + 2) * kstep; const char* b2 = last ? nB : cB + (size_t)(t + 2) * kstep;
            const char* a3 = a2 + kstep; const char* b3 = b2 + kstep;
            if (last && has_next) S.a_ready(nxt);
            if constexpr (SP2) {
            PG8_LDB(B0, 0, 0); PG8_LDB(B1, 0, 1); PG8_SCHED; PG8_LDA(At, 0, 0); PG8_STAGE(PG8_SA(1, 1), a1 + hstep, voffA);
            PG8_WAIT_V(8); PG8_WAIT_L(0); PG8_BAR; PG8_MMA(0, 0, At, B0); PG8_MMA(0, 1, At, B1); PG8_BAR; PG8_SCHED;
            PG8_LDA(At, 0, 1); PG8_STAGE(PG8_SB(0, 0), b2, voffB); PG8_STAGE(PG8_SB(0, 1), b2 + hstep, voffB); PG8_STAGE(PG8_SA(0, 0), a2, voffA);
            PG8_WAIT_V(8); PG8_WAIT_L(0); PG8_BAR; PG8_MMA(1, 0, At, B0); PG8_MMA(1, 1, At, B1); PG8_BAR; PG8_SCHED;
            PG8_LDB(B0, 1, 0); PG8_LDB(B1, 1, 1); PG8_SCHED; PG8_LDA(At, 1, 0); PG8_STAGE(PG8_SA(0, 1), a2 + hstep, voffA);
            PG8_WAIT_V(8); PG8_WAIT_L(0); PG8_BAR; PG8_MMA(0, 0, At, B0); PG8_MMA(0, 1, At, B1); PG8_BAR; PG8_SCHED;
            PG8_LDA(At, 1, 1); PG8_STAGE(PG8_SB(1, 0), b3, voffB); PG8_STAGE(PG8_SB(1, 1), b3 + hstep, voffB); PG8_STAGE(PG8_SA(1, 0), a3, voffA);
            PG8_WAIT_V(8); PG8_WAIT_L(0); PG8_BAR; PG8_MMA(1, 0, At, B0); PG8_MMA(1, 1, At, B1); PG8_BAR; PG8_SCHED;
            } else {
            PG8_LDB(B0, 0, 0); PG8_SCHED; PG8_LDA(At, 0, 0); PG8_STAGE(PG8_SA(1, 1), a1 + hstep, voffA);
            PG8_WAIT_L(8); PG8_BAR; PG8_WAIT_L(0); PG8_MMA(0, 0, At, B0); PG8_BAR; PG8_SCHED;
            PG8_LDB(B1, 0, 1); PG8_STAGE(PG8_SB(0, 0), b2, voffB);
            PG8_BAR; PG8_WAIT_L(0); PG8_MMA(0, 1, At, B1); PG8_BAR;
            PG8_LDA(At, 0, 1); PG8_STAGE(PG8_SA(0, 0), a2, voffA);
            PG8_BAR; PG8_WAIT_L(0); PG8_MMA(1, 0, At, B0); PG8_BAR; PG8_SCHED;
            PG8_STAGE(PG8_SB(0, 1), b2 + hstep, voffB);
            PG8_WAIT_V(6); PG8_BAR; PG8_MMA(1, 1, At, B1); PG8_BAR;
            PG8_LDB(B0, 1, 0); PG8_SCHED; PG8_LDA(At, 1, 0); PG8_STAGE(PG8_SA(0, 1), a2 + hstep, voffA);
            PG8_WAIT_L(8); PG8_BAR; PG8_WAIT_L(0); PG8_MMA(0, 0, At, B0); PG8_BAR; PG8_SCHED;
            PG8_LDB(B1, 1, 1); PG8_STAGE(PG8_SB(1, 0), b3, voffB);
            PG8_BAR; PG8_WAIT_L(0); PG8_MMA(0, 1, At, B1); PG8_BAR;
            PG8_LDA(At, 1, 1); PG8_STAGE(PG8_SA(1, 0), a3, voffA);
            PG8_BAR; PG8_WAIT_L(0); PG8_MMA(1, 0, At, B0); PG8_BAR; PG8_SCHED;
            PG8_STAGE(PG8_SB(1, 1), b3 + hstep, voffB);
            PG8_WAIT_V(6); PG8_BAR; PG8_MMA(1, 1, At, B1); PG8_BAR;
            }
        }
        if constexpr (ALIGN_EPI) { if (wr == 0) PG8_BAR; }
        if constexpr (!Epi::AFTER_DRAIN) { E(acc, cur, wr, wc, fr, fq); S.done(cur); }
        if (!has_next) break;
#pragma unroll
        for (int a = 0; a < 2; ++a)
#pragma unroll
            for (int b = 0; b < 2; ++b)
#pragma unroll
                for (int m = 0; m < 4; ++m)
#pragma unroll
                    for (int n = 0; n < 2; ++n) acc[a][b][m][n] = (f32x4){0.f, 0.f, 0.f, 0.f};
        cur = nxt; cA = nA; cB = nB; ++ui;
        if constexpr (ALIGN_EPI) { if (wr == 1) PG8_BAR; }
    }
    PG8_WAIT_V(0);
    if constexpr (!ALIGN_EPI) { if (wr == 0) PG8_BAR; }
    PG8_BAR;
    if constexpr (Epi::AFTER_DRAIN) { E.fused(acc, cur, wr, wc, fr, fq, lds, wid, lane); S.done(cur); }
#undef PG8_SA
#undef PG8_SB
#undef PG8_STAGE
#undef PG8_LDA
#undef PG8_LDB
#undef PG8_MMA
#undef PG8_WAIT_V
#undef PG8_WAIT_L
#undef PG8_BAR
#undef PG8_SCHED
}
}
#define GAS __attribute__((address_space(1)))
#define LAS __attribute__((address_space(3)))
typedef unsigned short bf16;
typedef unsigned v4u __attribute__((ext_vector_type(4)));
typedef unsigned v2u __attribute__((ext_vector_type(2)));
typedef float f32x4 __attribute__((ext_vector_type(4)));
typedef short bf16x8 __attribute__((ext_vector_type(8)));
typedef short s16x4 __attribute__((ext_vector_type(4)));
#define LDS_WAIT() asm volatile("s_waitcnt lgkmcnt(0)" ::: "memory")

constexpr int NWAVES = 8;
constexpr int M_TOK = 81920, MP = 65536, D = 1024, FF = 2816, NGU = 2 * FF, DIN = 3072;
constexpr float EPSF = 1e-6f;
constexpr size_t MiB = 1u << 20;
constexpr size_t WS_CTL = 0, CTL_ZERO_BYTES = 65536;
constexpr size_t WS_W1GU = 1 * MiB, WS_W1D = 12 * MiB, WS_WIN = 18 * MiB, WS_WOUT = 24 * MiB, WS_W2GU = 26 * MiB, WS_W2D = 37 * MiB;
constexpr size_t WS_SS1 = 44 * MiB, WS_SS2 = 50 * MiB, WS_RS0 = 56 * MiB;
constexpr size_t WS_XB = 64 * MiB;
constexpr size_t WS_ACT = 224 * MiB;
constexpr size_t WS_ZQ = WS_ACT, WS_ZK = WS_ACT + 80 * MiB, WS_VT = WS_ACT + 160 * MiB, WS_ZC = WS_ACT + 240 * MiB;
constexpr size_t WS_AC = 704 * MiB;
constexpr size_t WS_END = 864 * MiB;
constexpr int RING_BYTES = 131072, LDS_BYTES = 147456;

__device__ __forceinline__ unsigned f2bf(float f) { unsigned u = __builtin_bit_cast(unsigned, f); return (u + 0x7fffu + ((u >> 16) & 1u)) >> 16; }
__device__ __forceinline__ unsigned pk2(float lo, float hi) { return pg8::cvt_pk_bf16(lo, hi); }
__device__ __forceinline__ float bflo(unsigned w) { return __builtin_bit_cast(float, w << 16); }
__device__ __forceinline__ float bfhi(unsigned w) { return __builtin_bit_cast(float, w & 0xffff0000u); }
__device__ __forceinline__ float wave_sum(float v) {
#pragma unroll
    for (int o = 1; o < 64; o <<= 1) v += __shfl_xor(v, o);
    return v;
}

__device__ __forceinline__ void p0_transpose_item(const float* W, int K, int N, bf16* WT, const float* gain, int kind, LAS float* scr, int item, int lane) {
    const int nblk = N / 32, kb = item / nblk, nb = item % nblk, k0 = 64 * kb, n0 = 32 * nb;
    int rowbase = n0;
    if (kind == 1) rowbase = (n0 >> 7) * 256 + (n0 & 127);
    else if (kind == 2) rowbase = (n0 >> 7) * 256 + 128 + (n0 & 127);
    else if (kind == 3 || (kind == 4 && n0 < 2048)) rowbase = (n0 & ~255) + 128 * ((n0 >> 5) & 1) + 32 * ((n0 >> 6) & 3);
    else if (kind == 4) { const int isx = n0 >= 2560, ch0 = (n0 - 2048) & 511; rowbase = 256 * (8 + (ch0 >> 7)) + 128 * isx + 32 * ((ch0 >> 5) & 3); }
#pragma unroll 8
    for (int i = 0; i < 32; ++i) { const int kk = 2 * i + (lane >> 5); const float g = gain ? gain[k0 + kk] : 1.0f; scr[kk * 33 + (lane & 31)] = W[(size_t)(k0 + kk) * N + n0 + (lane & 31)] * g; }
    LDS_WAIT(); asm volatile("" ::: "memory");
    const int c = lane & 7;
#pragma unroll
    for (int j = 0; j < 4; ++j) { const int n = (lane >> 3) + 8 * j; const LAS float* s = scr + (8 * c) * 33 + n;
        v4u o; o.x = pk2(s[0 * 33], s[1 * 33]); o.y = pk2(s[2 * 33], s[3 * 33]); o.z = pk2(s[4 * 33], s[5 * 33]); o.w = pk2(s[6 * 33], s[7 * 33]);
        *(v4u*)(WT + (size_t)(rowbase + n) * K + k0 + 8 * c) = o; }
    LDS_WAIT(); asm volatile("" ::: "memory");
}

struct Args {
    const float* in[20]; float* out; unsigned char* ws; int ph_lo, ph_hi;
};
enum { I_XP = 0, I_XS, I_F1N, I_F1G, I_F1U, I_F1D, I_MIXN, I_WIN, I_QN, I_KN, I_RPB, I_CW, I_AON, I_CON, I_WOUT, I_F2N, I_F2G, I_F2U, I_F2D, I_FINN };

__device__ __forceinline__ void p0_prologue(const Args& A, LAS unsigned char* lds, int gw, int NGW, int wave, int lane) {
    unsigned char* ws = A.ws;
    LAS float* scr = (LAS float*)(lds + wave * 16384);
    constexpr int I_G = (D / 64) * (FF / 32), I_DN = (FF / 64) * (D / 32), I_IN = (D / 64) * (DIN / 32), I_OUT = (D / 64) * (D / 32);
    constexpr int NITEMS = 2 * (2 * I_G + I_DN) + I_IN + I_OUT;
    for (int it = gw; it < NITEMS; it += NGW) {
        int r = it;
        if (r < I_G) { p0_transpose_item(A.in[I_F1G], D, FF, (bf16*)(ws + WS_W1GU), nullptr, 1, scr, r, lane); continue; } r -= I_G;
        if (r < I_G) { p0_transpose_item(A.in[I_F1U], D, FF, (bf16*)(ws + WS_W1GU), nullptr, 2, scr, r, lane); continue; } r -= I_G;
        if (r < I_DN) { p0_transpose_item(A.in[I_F1D], FF, D, (bf16*)(ws + WS_W1D), nullptr, 3, scr, r, lane); continue; } r -= I_DN;
        if (r < I_G) { p0_transpose_item(A.in[I_F2G], D, FF, (bf16*)(ws + WS_W2GU), A.in[I_F2N], 1, scr, r, lane); continue; } r -= I_G;
        if (r < I_G) { p0_transpose_item(A.in[I_F2U], D, FF, (bf16*)(ws + WS_W2GU), A.in[I_F2N], 2, scr, r, lane); continue; } r -= I_G;
        if (r < I_DN) { p0_transpose_item(A.in[I_F2D], FF, D, (bf16*)(ws + WS_W2D), nullptr, 3, scr, r, lane); continue; } r -= I_DN;
        if (r < I_IN) { p0_transpose_item(A.in[I_WIN], D, DIN, (bf16*)(ws + WS_WIN), A.in[I_MIXN], 4, scr, r, lane); continue; } r -= I_IN;
        p0_transpose_item(A.in[I_WOUT], D, D, (bf16*)(ws + WS_WOUT), nullptr, 3, scr, r, lane);
    }
    const f32x4* gp = (const f32x4*)A.in[I_F1N] + lane;
    f32x4 gv[4];
#pragma unroll
    for (int j = 0; j < 4; ++j) gv[j] = gp[64 * j];
    bf16* XN = (bf16*)(ws + WS_XB);
    for (int m = gw; m < M_TOK; m += 2 * NGW) {
        const int m2 = m + NGW;
        const float* xrow = (m < MP) ? A.in[I_XP] + (size_t)m * D : A.in[I_XS] + (size_t)(m - MP) * D;
        const float* xrow2 = (m2 < MP) ? A.in[I_XP] + (size_t)m2 * D : A.in[I_XS] + (size_t)(m2 - MP) * D;
        const f32x4* xr = (const f32x4*)xrow + lane; const f32x4* xr2 = (const f32x4*)xrow2 + lane; f32x4 v[4], v2[4]; float s = 0.f, s2 = 0.f;
#pragma unroll
        for (int j = 0; j < 4; ++j) { v[j] = xr[64 * j]; v2[j] = xr2[64 * j]; }
#pragma unroll
        for (int j = 0; j < 4; ++j) { s += (v[j].x * v[j].x + v[j].y * v[j].y) + (v[j].z * v[j].z + v[j].w * v[j].w); s2 += (v2[j].x * v2[j].x + v2[j].y * v2[j].y) + (v2[j].z * v2[j].z + v2[j].w * v2[j].w); }
        const float rstd = __builtin_amdgcn_rsqf(wave_sum(s) * (1.0f / D) + EPSF), rstd2 = __builtin_amdgcn_rsqf(wave_sum(s2) * (1.0f / D) + EPSF);
        unsigned long long* o8 = (unsigned long long*)(XN + (size_t)m * D) + lane; unsigned long long* o82 = (unsigned long long*)(XN + (size_t)m2 * D) + lane;
        if (lane == 0) { float* rs0 = (float*)(ws + WS_RS0); rs0[m] = rstd; rs0[m2] = rstd2; }
#pragma unroll
        for (int j = 0; j < 4; ++j) { const f32x4 y = v[j] * rstd * gv[j]; o8[64 * j] = (unsigned long long)pk2(y.x, y.y) | ((unsigned long long)pk2(y.z, y.w) << 32);
            const f32x4 y2 = v2[j] * rstd2 * gv[j]; o82[64 * j] = (unsigned long long)pk2(y2.x, y2.y) | ((unsigned long long)pk2(y2.z, y2.w) << 32); }
    }
}

__device__ __forceinline__ void final_norm_phase(const Args& A, int gw, int NGW, int lane) {
    const float* gp = A.in[I_FINN] + 8 * lane;
    const f32x4 g0 = *(const f32x4*)(gp), g1 = *(const f32x4*)(gp + 4), g2 = *(const f32x4*)(gp + 512), g3 = *(const f32x4*)(gp + 516);
    const bf16* XB = (const bf16*)(A.ws + WS_XB);
    for (int m = gw; m < M_TOK; m += 4 * NGW) {
        v4u a[4], b[4];
#pragma unroll
        for (int i = 0; i < 4; ++i) { const bf16* xr = XB + (size_t)(m + i * NGW) * D + 8 * lane; a[i] = *(const v4u*)(xr); b[i] = *(const v4u*)(xr + 512); }
#pragma unroll
        for (int i = 0; i < 4; ++i) {
            const f32x4 v0 = (f32x4){bflo(a[i].x), bfhi(a[i].x), bflo(a[i].y), bfhi(a[i].y)}, v1 = (f32x4){bflo(a[i].z), bfhi(a[i].z), bflo(a[i].w), bfhi(a[i].w)};
            const f32x4 v2 = (f32x4){bflo(b[i].x), bfhi(b[i].x), bflo(b[i].y), bfhi(b[i].y)}, v3 = (f32x4){bflo(b[i].z), bfhi(b[i].z), bflo(b[i].w), bfhi(b[i].w)};
            const float s = (v0.x * v0.x + v0.y * v0.y) + (v0.z * v0.z + v0.w * v0.w) + (v1.x * v1.x + v1.y * v1.y) + (v1.z * v1.z + v1.w * v1.w)
                          + (v2.x * v2.x + v2.y * v2.y) + (v2.z * v2.z + v2.w * v2.w) + (v3.x * v3.x + v3.y * v3.y) + (v3.z * v3.z + v3.w * v3.w);
            const float rstd = __builtin_amdgcn_rsqf(wave_sum(s) * (1.0f / D) + EPSF);
            float* o = A.out + (size_t)(m + i * NGW) * D + 8 * lane;
            *(f32x4*)(o) = v0 * rstd * g0; *(f32x4*)(o + 4) = v1 * rstd * g1; *(f32x4*)(o + 512) = v2 * rstd * g2; *(f32x4*)(o + 516) = v3 * rstd * g3;
        }
    }
}

constexpr int RPB_OFF = 256, RPB_N = 8 * 15 * 31;
__device__ __forceinline__ void attn_finish(f32x4 (&o)[4], float sum, const float* aogp  , bf16* op) {
    const float il = __builtin_amdgcn_rcpf(sum); float q2 = 0.f;
#pragma unroll
    for (int mt = 0; mt < 4; ++mt) { o[mt] = o[mt] * il; q2 += (o[mt][0] * o[mt][0] + o[mt][1] * o[mt][1]) + (o[mt][2] * o[mt][2] + o[mt][3] * o[mt][3]); }
    q2 += __shfl_xor(q2, 16); q2 += __shfl_xor(q2, 32);
    const float rn = __builtin_amdgcn_rsqf(q2 * (1.0f / 64.0f) + EPSF);
#pragma unroll
    for (int mt = 0; mt < 4; ++mt) { const f32x4 y = o[mt] * rn * *(const f32x4*)(aogp + 16 * mt); v2u w; w.x = pg8::cvt_pk_bf16(y[0], y[1]); w.y = pg8::cvt_pk_bf16(y[2], y[3]); *(v2u*)(op + 16 * mt) = w; }
}
template <int STEP>
__device__ __forceinline__ void attn_quad(const bf16* ZQ, const bf16* ZK, const bf16* VT, bf16* AC, const LAS float* rpbL, const float* aogp,
                                          int seqbase, int S, int rA, int rs0, int h, int qc, int l, int g) {
    constexpr int NU = 8 + 3 * STEP;
    const int w0 = (qc == 0) ? 0 : (qc == 1) ? 8 : (qc == 2) ? 24 : 32;
    const int c = 16 * qc + l; int cs = c - 8; cs = cs < 0 ? 0 : cs; cs = cs > 48 ? 48 : cs;
    const size_t qtok0 = (size_t)seqbase + rA * 64 + c;
    bf16x8 qf[4][2];
#pragma unroll
    for (int i = 0; i < 4; ++i)
#pragma unroll
        for (int ks = 0; ks < 2; ++ks) qf[i][ks] = *(const bf16x8*)(ZQ + (qtok0 + 64 * i) * 512 + h * 64 + ks * 32 + 8 * g);
    const bf16* kp = ZK + ((size_t)seqbase + rs0 * 64 + w0 + 8 * (l >> 2) + (l & 3)) * 512 + h * 64 + 8 * g;
    const bf16* vp = VT + (size_t)seqbase * 512 + (size_t)(h * 64 + l) * S + rs0 * 64 + w0 + 8 * g;
    const int kc0 = w0 + 8 * g;
    bool valid[2][4];
#pragma unroll
    for (int hf = 0; hf < 2; ++hf)
#pragma unroll
        for (int j = 0; j < 4; ++j) valid[hf][j] = (unsigned)(kc0 + 4 * hf + j - cs) < 16u;
    const LAS float* bp0 = rpbL + h * 465 + (rs0 - rA + 7) * 31 + (kc0 - c + 15);
    f32x4 o[4][4]; float sum[4];
#pragma unroll
    for (int i = 0; i < 4; ++i) { sum[i] = 0.f;
#pragma unroll
        for (int mt = 0; mt < 4; ++mt) o[i][mt] = (f32x4){0.f, 0.f, 0.f, 0.f}; }
    bf16x8 kn[2][2]; v4u vn[4];
#pragma unroll
    for (int hf = 0; hf < 2; ++hf) { const bf16* kt = kp + (size_t)(hf * 4) * 512; kn[hf][0] = *(const bf16x8*)(kt); kn[hf][1] = *(const bf16x8*)(kt + 32); }
#pragma unroll
    for (int mt = 0; mt < 4; ++mt) vn[mt] = *(const v4u*)(vp + (size_t)(16 * mt) * S);
#pragma unroll 1
    for (int u = 0; u < NU; ++u) {
        bf16x8 kf[2][2]; v4u vf[4];
#pragma unroll
        for (int hf = 0; hf < 2; ++hf) { kf[hf][0] = kn[hf][0]; kf[hf][1] = kn[hf][1]; }
#pragma unroll
        for (int mt = 0; mt < 4; ++mt) vf[mt] = vn[mt];
        if (u + 1 < NU) {
#pragma unroll
            for (int hf = 0; hf < 2; ++hf) { const bf16* kt = kp + (size_t)((u + 1) * 64 + hf * 4) * 512; kn[hf][0] = *(const bf16x8*)(kt); kn[hf][1] = *(const bf16x8*)(kt + 32); }
#pragma unroll
            for (int mt = 0; mt < 4; ++mt) vn[mt] = *(const v4u*)(vp + (size_t)(16 * mt) * S + (u + 1) * 64);
        }
#pragma unroll
        for (int i = 0; i < 4; ++i) {
            if ((unsigned)(u - i * STEP) < 8u) {
                f32x4 s0 = {0.f, 0.f, 0.f, 0.f}, s1 = {0.f, 0.f, 0.f, 0.f};
                s0 = __builtin_amdgcn_mfma_f32_16x16x32_bf16(kf[0][0], qf[i][0], s0, 0, 0, 0); s0 = __builtin_amdgcn_mfma_f32_16x16x32_bf16(kf[0][1], qf[i][1], s0, 0, 0, 0);
                s1 = __builtin_amdgcn_mfma_f32_16x16x32_bf16(kf[1][0], qf[i][0], s1, 0, 0, 0); s1 = __builtin_amdgcn_mfma_f32_16x16x32_bf16(kf[1][1], qf[i][1], s1, 0, 0, 0);
                const LAS float* bp = bp0 + (u - i) * 31;
                float p0[4], p1[4];
#pragma unroll
                for (int j = 0; j < 4; ++j) { p0[j] = valid[0][j] ? __builtin_amdgcn_exp2f(s0[j] + bp[j]) : 0.f; p1[j] = valid[1][j] ? __builtin_amdgcn_exp2f(s1[j] + bp[4 + j]) : 0.f; }
                sum[i] += ((p0[0] + p0[1]) + (p0[2] + p0[3])) + ((p1[0] + p1[1]) + (p1[2] + p1[3]));
                v4u pw; pw.x = pg8::cvt_pk_bf16(p0[0], p0[1]); pw.y = pg8::cvt_pk_bf16(p0[2], p0[3]); pw.z = pg8::cvt_pk_bf16(p1[0], p1[1]); pw.w = pg8::cvt_pk_bf16(p1[2], p1[3]);
                const bf16x8 pf = __builtin_bit_cast(bf16x8, pw);
#pragma unroll
                for (int mt = 0; mt < 4; ++mt) o[i][mt] = __builtin_amdgcn_mfma_f32_16x16x32_bf16(__builtin_bit_cast(bf16x8, vf[mt]), pf, o[i][mt], 0, 0, 0);
            }
        }
    }
#pragma unroll
    for (int i = 0; i < 4; ++i) {
        float sm = sum[i]; sm += __shfl_xor(sm, 16); sm += __shfl_xor(sm, 32);
        attn_finish(o[i], sm, aogp, AC + (qtok0 + 64 * i) * 1024 + h * 64 + 4 * g);
    }
}

__device__ __forceinline__ void attn_conv_phase(const Args& A, LAS unsigned char* lds, int wave, int lane) {
    unsigned char* ws = A.ws;
    const bf16* ZQ = (const bf16*)(ws + WS_ZQ); const bf16* ZK = (const bf16*)(ws + WS_ZK); const bf16* VT = (const bf16*)(ws + WS_VT); const bf16* ZC = (const bf16*)(ws + WS_ZC);
    bf16* AC = (bf16*)(ws + WS_AC);
    LAS float* rpbL = (LAS float*)(lds + RPB_OFF);
    float cb;
    { const float mq = fabsf(A.in[I_QN][lane]), mk = fabsf(A.in[I_KN][lane]); float mqw = mq, mkw = mk, mb = 0.f;
      for (int i = lane; i < RPB_N; i += 64) mb = fmaxf(mb, fabsf(A.in[I_RPB][i]));
#pragma unroll
      for (int o_ = 1; o_ < 64; o_ <<= 1) { mqw = fmaxf(mqw, __shfl_xor(mqw, o_)); mkw = fmaxf(mkw, __shfl_xor(mkw, o_)); mb = fmaxf(mb, __shfl_xor(mb, o_)); }
      cb = 11.5416f * 1.01f * mqw * mkw + 1.4426950408889634f * mb; }
    for (int i = wave * 64 + lane; i < RPB_N; i += NWAVES * 64) rpbL[i] = A.in[I_RPB][i] * 1.4426950408889634f - cb;
    __syncthreads();
    const int l = lane & 15, g = lane >> 4;
#if PROBE_DUP == 44
#pragma unroll 1
    for (int rep_ = 0; rep_ < 2; ++rep_)
#endif
    const int G_ = (int)gridDim.x, vcu_ = (G_ % 8 == 0) ? ((int)blockIdx.x % 8) * (G_ / 8) + (int)blockIdx.x / 8 : (int)blockIdx.x;
    for (int ui_ = 0; ui_ < 5; ++ui_) {
        const int unit = (G_ == 256) ? 32 * (5 * (vcu_ >> 5) + (4 - ui_)) + (vcu_ & 31) : vcu_ + ui_ * G_;
        if (unit >= 1280) break;
        const int quad = unit >> 2, hq = unit & 3;
        int seqbase, rA, S, rows;
        if (quad < 256) { seqbase = (quad >> 3) * 2048; rA = 4 * (quad & 7); S = 2048; rows = 32; }
        else { const int q2 = quad - 256; seqbase = MP + (q2 >> 4) * 4096; rA = 4 * (q2 & 15); S = 4096; rows = 64; }
        int rs0 = rA - 4; rs0 = rs0 < 0 ? 0 : rs0; rs0 = rs0 > rows - 8 ? rows - 8 : rs0;
        int rs1 = rA - 3; rs1 = rs1 < 0 ? 0 : rs1; rs1 = rs1 > rows - 8 ? rows - 8 : rs1;
        const int h = 2 * hq + (wave & 1), qc = wave >> 1;
        const float* aogp = A.in[I_AON] + h * 64 + 4 * g;
        if (rs1 != rs0) attn_quad<1>(ZQ, ZK, VT, AC, rpbL, aogp, seqbase, S, rA, rs0, h, qc, l, g);
        else attn_quad<0>(ZQ, ZK, VT, AC, rpbL, aogp, seqbase, S, rA, rs0, h, qc, l, g);
        const int r = rA + hq;
        {
            const int ch = 8 * lane; const float* cw = A.in[I_CW];
            f32x4 w0a = *(const f32x4*)(cw + ch), w0b = *(const f32x4*)(cw + ch + 4), w1a = *(const f32x4*)(cw + 512 + ch), w1b = *(const f32x4*)(cw + 512 + ch + 4);
            f32x4 w2a = *(const f32x4*)(cw + 1024 + ch), w2b = *(const f32x4*)(cw + 1024 + ch + 4);
            f32x4 cga = *(const f32x4*)(A.in[I_CON] + ch), cgb = *(const f32x4*)(A.in[I_CON] + ch + 4);
            const int t0 = r * 64 + 8 * wave;
            f32x4 upa, upb, uca, ucb, una, unb;
#define LOAD_U(tt, ua, ub) do { const int t_ = (tt); if (t_ >= 0 && t_ < S) { const v4u x_ = *(const v4u*)(ZC + ((size_t)seqbase + t_) * 1024 + 512 + ch); \
                ua = (f32x4){bflo(x_.x), bfhi(x_.x), bflo(x_.y), bfhi(x_.y)}; ub = (f32x4){bflo(x_.z), bfhi(x_.z), bflo(x_.w), bfhi(x_.w)}; } \
                else { ua = (f32x4){0.f, 0.f, 0.f, 0.f}; ub = ua; } } while (0)
            LOAD_U(t0 - 1, upa, upb); LOAD_U(t0, uca, ucb);
#pragma unroll 2
            for (int i = 0; i < 8; ++i) {
                const int t = t0 + i;
                LOAD_U(t + 1, una, unb);
                const v4u b_ = *(const v4u*)(ZC + ((size_t)seqbase + t) * 1024 + ch);
                const f32x4 gba = (f32x4){bflo(b_.x), bfhi(b_.x), bflo(b_.y), bfhi(b_.y)}, gbb = (f32x4){bflo(b_.z), bfhi(b_.z), bflo(b_.w), bfhi(b_.w)};
                const f32x4 ya = gba * (upa * w0a + uca * w1a + una * w2a), yb = gbb * (upb * w0b + ucb * w1b + unb * w2b);
                float q2 = (ya[0] * ya[0] + ya[1] * ya[1]) + (ya[2] * ya[2] + ya[3] * ya[3]) + (yb[0] * yb[0] + yb[1] * yb[1]) + (yb[2] * yb[2] + yb[3] * yb[3]);
                q2 += __shfl_xor(q2, 1); q2 += __shfl_xor(q2, 2); q2 += __shfl_xor(q2, 4);
                const float rn = __builtin_amdgcn_rsqf(q2 * (1.0f / 64.0f) + EPSF);
                const f32x4 oa = ya * rn * cga, ob = yb * rn * cgb;
                v4u w; w.x = pg8::cvt_pk_bf16(oa[0], oa[1]); w.y = pg8::cvt_pk_bf16(oa[2], oa[3]); w.z = pg8::cvt_pk_bf16(ob[0], ob[1]); w.w = pg8::cvt_pk_bf16(ob[2], ob[3]);
                *(v4u*)(AC + ((size_t)seqbase + t) * 1024 + 512 + ch) = w;
                upa = uca; upb = ucb; uca = una; ucb = unb;
            }
#undef LOAD_U
        }
    }
    __syncthreads();
}

typedef GAS unsigned gu32;
#define XB_TMO      128
#define XB_XCNT(j)  (256  + 64 * (j))
#define XB_XSUB(j)  (1280 + 64 * (j))
#define XB_XGEN(j)  (2304 + 64 * (j))
#define XB_TOP      3328
#define XB_TOPGEN   3392
#define XCD_BAR_WORDS 3456
#define XB_SPIN_CAP (1u << 18)

__device__ __forceinline__ unsigned xb_ld(unsigned* p)              { return __hip_atomic_load(p, __ATOMIC_RELAXED, __HIP_MEMORY_SCOPE_AGENT); }
__device__ __forceinline__ unsigned xb_add(unsigned* p, unsigned v) { return __hip_atomic_fetch_add(p, v, __ATOMIC_RELAXED, __HIP_MEMORY_SCOPE_AGENT); }
__device__ __forceinline__ unsigned xb_xcc_id() { return (unsigned)__builtin_amdgcn_s_getreg((3 << 11) | 20) & 0xFu; }
#define XB_SPIN(cond, bar) do { unsigned _sp = 0; while (cond) { __builtin_amdgcn_s_sleep(1); \
    if ((++_sp & 255u) == 0u) { if (xb_ld(&(bar)[XB_TMO])) break; if (_sp > XB_SPIN_CAP) { atomicAdd(&(bar)[XB_TMO], 1u); break; } } } } while (0)

struct XcdBarrier {
    unsigned* bar; unsigned x;
    volatile LAS unsigned* st;
};

__device__ __forceinline__ XcdBarrier xcd_barrier_post(unsigned* bar, volatile LAS unsigned* st, bool t0) {
    XcdBarrier b; b.bar = bar; b.x = xb_xcc_id(); b.st = st;
    if (t0) (void)xb_add(&bar[XB_XCNT(b.x)], 1u);
    return b;
}
__device__ __forceinline__ void xcd_barrier_complete(unsigned* bar, unsigned x, unsigned& nloc, unsigned& nx) {
    const unsigned G = gridDim.x * gridDim.y * gridDim.z;
    unsigned sum, cnt, mine, sp = 0u;
    for (;;) {
        sum = 0u; cnt = 0u; mine = 0u;
#pragma unroll
        for (unsigned j = 0; j < 16; ++j) { const unsigned c = xb_ld(&bar[XB_XCNT(j)]); sum += c; cnt += (c > 0u) ? 1u : 0u; mine = (j == x) ? c : mine; }
        if (sum == G) break;
        __builtin_amdgcn_s_sleep(1);
        if ((++sp & 255u) == 0u) { if (xb_ld(&bar[XB_TMO])) break; if (sp > XB_SPIN_CAP) { atomicAdd(&bar[XB_TMO], 1u); break; } }
    }
    nloc = mine > 0u ? mine : 1u; nx = cnt > 0u ? cnt : 1u;
}

__device__ __forceinline__ void xcd_barrier(const XcdBarrier& b, bool t0) {
    asm volatile("s_waitcnt vmcnt(0)" ::: "memory");
    __syncthreads();
    if (t0) {
        unsigned* bar = b.bar;
        __builtin_amdgcn_s_waitcnt(0);
        unsigned nloc = b.st[0], nx = b.st[1];
        if (nloc == 0u) { xcd_barrier_complete(bar, b.x, nloc, nx); b.st[0] = nloc; b.st[1] = nx; }
        const unsigned old = xb_add(&bar[XB_XSUB(b.x)], 1u);
        const unsigned gen = old / nloc;
        if (old + 1u == (gen + 1u) * nloc) {
            __builtin_amdgcn_fence(__ATOMIC_RELEASE, "agent");
            asm volatile("s_waitcnt vmcnt(0)" ::: "memory");
            const unsigned og = xb_add(&bar[XB_TOP], 1u);
            const unsigned tg = og / nx;
            if (og + 1u == (tg + 1u) * nx) xb_add(&bar[XB_TOPGEN], 1u);
            else XB_SPIN(xb_ld(&bar[XB_TOPGEN]) == tg, bar);
            __builtin_amdgcn_fence(__ATOMIC_ACQUIRE, "agent");
            xb_add(&bar[XB_XGEN(b.x)], 1u);
            asm volatile("s_waitcnt vmcnt(0)" ::: "memory");
        } else {
            XB_SPIN(xb_ld(&bar[XB_XGEN(b.x)]) == gen, bar);
            __builtin_amdgcn_fence(__ATOMIC_ACQUIRE, "agent");
            asm volatile("s_waitcnt vmcnt(0)" ::: "memory");
        }
    }
    __syncthreads();
}

#ifndef PROBE_DUP
#define PROBE_DUP -1
#endif
__global__ void __launch_bounds__(NWAVES * 64, 2) enc_fwd(Args args) {
    extern __shared__ __attribute__((aligned(16))) unsigned char lds_raw[];
    LAS unsigned char* lds = (LAS unsigned char*)lds_raw;
    cg::grid_group grid = cg::this_grid();
    const int G = gridDim.x; const int bx = blockIdx.x;
    const int vcu = (G % 8 == 0) ? (bx % 8) * (G / 8) + bx / 8 : bx;
    const int NGW = G * NWAVES;
    const int wave = __builtin_amdgcn_readfirstlane((int)threadIdx.x >> 6);
#define FRESH_IDS() int lane_ = (int)__builtin_amdgcn_mbcnt_hi(~0u, __builtin_amdgcn_mbcnt_lo(~0u, 0u)); asm volatile("" : "+v"(lane_)); const int lane = lane_, gw = vcu * NWAVES + wave; (void)gw; (void)lane
    unsigned char* ws = args.ws;
    const int lo = args.ph_lo, hi = args.ph_hi;
#define IN(k) (lo <= (k) && (k) < hi)
    volatile LAS unsigned* MISC = (volatile LAS unsigned*)(lds + RING_BYTES + 1024);
    const bool t0 = (wave == 0) && ((int)__builtin_amdgcn_mbcnt_hi(~0u, __builtin_amdgcn_mbcnt_lo(~0u, 0u)) == 0);
    if (t0) { MISC[0] = 0u; MISC[1] = 0u; }
    __syncthreads();
    XcdBarrier xbar = xcd_barrier_post((unsigned*)(ws + WS_CTL) + 1024, MISC, t0 && (hi - lo) > 1);
#define SEAM(k) do { if (IN(k) && IN((k) + 1)) { if ((k) == 0) grid.sync(); else xcd_barrier(xbar, (wave == 0) && ((int)__builtin_amdgcn_mbcnt_hi(~0u, __builtin_amdgcn_mbcnt_lo(~0u, 0u)) == 0)); } } while (0)
    bf16* XB = (bf16*)(ws + WS_XB); bf16* ACT = (bf16*)(ws + WS_ACT); bf16* ACB = (bf16*)(ws + WS_AC);
    float* SS1 = (float*)(ws + WS_SS1); float* SS2 = (float*)(ws + WS_SS2);

    if (IN(0)) { FRESH_IDS(); p0_prologue(args, lds, gw, NGW, wave, lane); __syncthreads(); }
#if PROBE_DUP == 0
    if (IN(0)) { FRESH_IDS(); p0_prologue(args, lds, gw, NGW, wave, lane); __syncthreads(); }
#endif
    SEAM(0);
    if (IN(1)) { pg8::Gemm g{XB, (const bf16*)(ws + WS_W1GU), M_TOK, NGU, D, wave}; pg8::StaticOrder S; S.init(M_TOK, NGU, G, bx);
        pg8::EpiSwiGLU<false> E{ACT, FF, nullptr};
        pg8::gemm_phase<pg8::EpiSwiGLU<false>, pg8::StaticOrder, true, true>(lds, g, S, E); }
#if PROBE_DUP == 1
    if (IN(1)) { pg8::Gemm g{XB, (const bf16*)(ws + WS_W1GU), M_TOK, NGU, D, wave}; pg8::StaticOrder S; S.init(M_TOK, NGU, G, bx);
        pg8::EpiSwiGLU<false> E{ACT, FF, nullptr};
        pg8::gemm_phase<pg8::EpiSwiGLU<false>, pg8::StaticOrder, true, true>(lds, g, S, E); }
#endif
    SEAM(1);
    if (IN(2)) { pg8::Gemm g{ACT, (const bf16*)(ws + WS_W1D), M_TOK, D, FF, wave}; pg8::RevOrder S; S.init(M_TOK, D, G, bx);
        pg8::EpiResid<2, true> E{args.in[I_F1N], (const float*)(ws + WS_RS0), XB, SS1, 0.5f};
        pg8::gemm_phase<pg8::EpiResid<2, true>, pg8::RevOrder, true, true>(lds, g, S, E); }
#if PROBE_DUP == 2
    if (IN(2)) { pg8::Gemm g{ACT, (const bf16*)(ws + WS_W1D), M_TOK, D, FF, wave}; pg8::RevOrder S; S.init(M_TOK, D, G, bx);
        pg8::EpiResid<2, true> E{args.in[I_F1N], (const float*)(ws + WS_RS0), XB, SS1, 0.5f};
        pg8::gemm_phase<pg8::EpiResid<2, true>, pg8::RevOrder, true, true>(lds, g, S, E); }
#endif
    SEAM(2);
    if (IN(3)) { pg8::Gemm g{XB, (const bf16*)(ws + WS_WIN), M_TOK, DIN, D, wave}; pg8::StaticOrder S; S.init(M_TOK, DIN, G, bx);
        pg8::EpiWin E{SS1, (bf16*)(ws + WS_ZQ), (bf16*)(ws + WS_ZK), (bf16*)(ws + WS_VT), (bf16*)(ws + WS_ZC), args.in[I_QN], args.in[I_KN]};
        pg8::gemm_phase<pg8::EpiWin, pg8::StaticOrder, true, true>(lds, g, S, E); }
#if PROBE_DUP == 3
    if (IN(3)) { pg8::Gemm g{XB, (const bf16*)(ws + WS_WIN), M_TOK, DIN, D, wave}; pg8::StaticOrder S; S.init(M_TOK, DIN, G, bx);
        pg8::EpiWin E{SS1, (bf16*)(ws + WS_ZQ), (bf16*)(ws + WS_ZK), (bf16*)(ws + WS_VT), (bf16*)(ws + WS_ZC), args.in[I_QN], args.in[I_KN]};
        pg8::gemm_phase<pg8::EpiWin, pg8::StaticOrder, true, true>(lds, g, S, E); }
#endif
    SEAM(3);
    if (IN(4)) { FRESH_IDS(); attn_conv_phase(args, lds, wave, lane); }
#if PROBE_DUP == 4
    if (IN(4)) { FRESH_IDS(); attn_conv_phase(args, lds, wave, lane); }
#endif
    SEAM(4);
    if (IN(5)) { pg8::Gemm g{ACB, (const bf16*)(ws + WS_WOUT), M_TOK, D, D, wave}; pg8::StaticOrder S; S.init(M_TOK, D, G, bx);
        pg8::EpiResid<1, true> E{nullptr, nullptr, XB, SS2, 1.0f};
        pg8::gemm_phase<pg8::EpiResid<1, true>, pg8::StaticOrder, true, true>(lds, g, S, E); } SEAM(5);
    if (IN(6)) { pg8::Gemm g{XB, (const bf16*)(ws + WS_W2GU), M_TOK, NGU, D, wave}; pg8::RevOrder S; S.init(M_TOK, NGU, G, bx);
        pg8::EpiSwiGLU<true> E{ACT, FF, SS2};
        pg8::gemm_phase<pg8::EpiSwiGLU<true>, pg8::RevOrder, true, true>(lds, g, S, E); }
#if PROBE_DUP == 6
    if (IN(6)) { pg8::Gemm g{XB, (const bf16*)(ws + WS_W2GU), M_TOK, NGU, D, wave}; pg8::RevOrder S; S.init(M_TOK, NGU, G, bx);
        pg8::EpiSwiGLU<true> E{ACT, FF, SS2};
        pg8::gemm_phase<pg8::EpiSwiGLU<true>, pg8::RevOrder, true, true>(lds, g, S, E); }
#endif
    SEAM(6);
    if (IN(7)) { pg8::Gemm g{ACT, (const bf16*)(ws + WS_W2D), M_TOK, D, FF, wave}; pg8::StaticOrder S; S.init(M_TOK, D, G, bx);
        pg8::EpiResid<1, false> E{nullptr, nullptr, XB, nullptr, 0.5f};
        pg8::gemm_phase<pg8::EpiResid<1, false>, pg8::StaticOrder, true, true>(lds, g, S, E); } SEAM(7);
    if (IN(8)) { FRESH_IDS(); final_norm_phase(args, gw, NGW, lane); }
#undef IN
#undef SEAM
}

#ifndef MK_N_LAUNCHES
#define MK_N_LAUNCHES 1
#endif
extern "C" void kernel_launch(void* const* d_in, const int* in_sizes, int n_in, void* d_out, int out_size, void* d_ws, size_t ws_size, hipStream_t stream) {
    static int grid = 0;
    if (grid == 0) {
        if (n_in != 20 || in_sizes[0] != MP * D || out_size != M_TOK * D || ws_size < WS_END) { fprintf(stderr, "kernel_launch: unexpected shapes (n_in %d, in0 %d, out %d, ws %zu)\n", n_in, n_in > 0 ? in_sizes[0] : -1, out_size, ws_size); grid = -1; return; }
        int dev = 0, cus = 0, per_cu = 0;
        if (hipGetDevice(&dev) != hipSuccess || hipDeviceGetAttribute(&cus, hipDeviceAttributeMultiprocessorCount, dev) != hipSuccess) { grid = -1; return; }
        if (hipFuncSetAttribute((const void*)enc_fwd, hipFuncAttributeMaxDynamicSharedMemorySize, LDS_BYTES) != hipSuccess) { fprintf(stderr, "kernel_launch: hipFuncSetAttribute failed\n"); grid = -1; return; }
        if (hipOccupancyMaxActiveBlocksPerMultiprocessor(&per_cu, (const void*)enc_fwd, NWAVES * 64, LDS_BYTES) != hipSuccess || per_cu < 1) { fprintf(stderr, "kernel_launch: occupancy query says %d\n", per_cu); per_cu = 1; }
        (void)hipGetLastError();
        if (cus * per_cu < 256) { fprintf(stderr, "kernel_launch: needs 256 co-resident workgroups, device offers %d\n", cus * per_cu); grid = -1; return; }
        grid = 256;
    }
    if (grid < 0) return;
    if (hipMemsetAsync((char*)d_ws + WS_CTL, 0, CTL_ZERO_BYTES, stream) != hipSuccess) { fprintf(stderr, "kernel_launch: memset failed\n"); return; }
    Args a{};
    for (int i = 0; i < 20; ++i) a.in[i] = (const float*)d_in[i];
    a.out = (float*)d_out; a.ws = (unsigned char*)d_ws;
#if MK_N_LAUNCHES == 1
    a.ph_lo = 0; a.ph_hi = 9;
    void* kargs[] = {&a};
    hipError_t e = hipLaunchCooperativeKernel((const void*)enc_fwd, dim3(grid), dim3(NWAVES * 64), kargs, LDS_BYTES, stream);
    if (e != hipSuccess) fprintf(stderr, "kernel_launch: cooperative launch failed: %s (grid %d)\n", hipGetErrorString(e), grid);
#else
    for (int p = 0; p < 9; ++p) {
        a.ph_lo = p; a.ph_hi = p + 1;
        hipLaunchKernelGGL(enc_fwd, dim3(grid), dim3(NWAVES * 64), LDS_BYTES, stream, a);
    }
#endif
}
```

```cpp
#include <hip/hip_runtime.h>
#include <hip/hip_cooperative_groups.h>
#include <cstdio>
#include <cstdint>
#include <cmath>
namespace cg = cooperative_groups;
namespace pg8 {
#define PG8_LAS __attribute__((address_space(3)))
typedef unsigned short bf16_t;
typedef short bf16x8 __attribute__((ext_vector_type(8)));
typedef float f32x4 __attribute__((ext_vector_type(4)));
typedef unsigned u32x4 __attribute__((ext_vector_type(4)));
constexpr int BM = 256, BK = 64, HALF = 128, HTB = HALF * BK * 2  , STAGE_BYTES = 8 * HTB, NXCD = 8, WGM = 8;

__host__ __device__ __forceinline__ int lds_byte(int r, int c) { const int st = (r >> 4) * 2 + (c >> 5), rr = r & 15, cc = c & 31, ob = rr * 64 + cc * 2; return st * 1024 + (ob ^ (((ob >> 9) & 1) << 5)); }
__host__ __device__ __forceinline__ void stage_rc(int b, int& R, int& C) { const int st = b / 1024, sb = b % 1024, swz = sb ^ (((sb >> 9) & 1) << 5); R = (st >> 1) * 16 + swz / 64; C = (st & 1) * 32 + (swz % 64) / 2; }
__host__ __device__ __forceinline__ int perm32(int rho) { const int n = rho >> 4, i = rho & 15; return 8 * (i >> 2) + 4 * n + (i & 3); }

struct Unit { int pm, pn; };
struct Gemm { const bf16_t* A; const bf16_t* Bt; int M, N, K, wid; };

struct StaticOrder {
    int nM, nN, nwg, G, c;
    __host__ __device__ void init(int M, int N, int G_, int c_) { nM = M / BM; nN = N / BM; nwg = nM * nN; G = G_; c = c_; }
    __host__ __device__ bool next(int i, Unit& u) const {
        const long L = (long)i * G + c; if (L >= nwg) return false;
        int wgid = (int)L; { const int q = nwg / NXCD, r = nwg % NXCD, xcd = wgid % NXCD, off = wgid / NXCD; wgid = (xcd < r ? xcd * (q + 1) : r * (q + 1) + (xcd - r) * q) + off; }
        const int nig = WGM * nN, gid = wgid / nig, fm = gid * WGM, gsz = (nM - fm) < WGM ? (nM - fm) : WGM;
        u.pm = fm + ((wgid % nig) % gsz); u.pn = (wgid % nig) / gsz; return true;
    }
    __device__ __forceinline__ void a_ready(const Unit&) const {}
    __device__ __forceinline__ void done(const Unit&) const {}
};
struct RevOrder : StaticOrder {
    __host__ __device__ bool next(int i, Unit& u) const { if (!StaticOrder::next(i, u)) return false; if (nM == 320) u.pm = 40 * (u.pm / 40) + 39 - (u.pm % 40); return true; }
};
__device__ __forceinline__ unsigned cvt_pk_bf16(float lo, float hi) { unsigned r; asm volatile("v_cvt_pk_bf16_f32 %0, %1, %2" : "=v"(r) : "v"(lo), "v"(hi)); return r; }
typedef float f32x2 __attribute__((ext_vector_type(2)));
constexpr float RMS_EPS = 1e-6f;
typedef unsigned u32x2 __attribute__((ext_vector_type(2)));
__device__ __forceinline__ float row_rstd16(const float* ssrow) {
    const f32x4 a = *(const f32x4*)(ssrow), b = *(const f32x4*)(ssrow + 4), c = *(const f32x4*)(ssrow + 8), d = *(const f32x4*)(ssrow + 12);
    const float s = ((a[0] + a[1]) + (a[2] + a[3])) + ((b[0] + b[1]) + (b[2] + b[3])) + ((c[0] + c[1]) + (c[2] + c[3])) + ((d[0] + d[1]) + (d[2] + d[3]));
    return __builtin_amdgcn_rsqf(s * (1.0f / 1024.0f) + RMS_EPS);
}
__device__ __forceinline__ float row_rstd16_coop(const float* ssrow, int fq) {
    const f32x4 a = *(const f32x4*)(ssrow + 4 * fq);
    float s = (a[0] + a[1]) + (a[2] + a[3]);
    s += __shfl_xor(s, 16); s += __shfl_xor(s, 32);
    return __builtin_amdgcn_rsqf(s * (1.0f / 1024.0f) + RMS_EPS);
}
__device__ __forceinline__ float silu_mul(float gl, float ul) { return gl * ul * __builtin_amdgcn_rcpf(1.0f + __builtin_amdgcn_exp2f(-gl)); }

template <bool HAS_RSTD> struct EpiSwiGLU {
    static constexpr bool PERM = true, AFTER_DRAIN = false;
    bf16_t* O; int ldc; const float* ss;
    __device__ __forceinline__ void operator()(const f32x4 (&acc)[2][2][4][2], const Unit& u, int wr, int wc, int fr, int fq) const {
        const int row0 = u.pm * BM + wr * 64 + fr, col0 = u.pn * HALF + wc * 32 + 8 * fq;
        float rsv[8];
#pragma unroll
        for (int i = 0; i < 8; ++i) rsv[i] = HAS_RSTD ? row_rstd16_coop(ss + (size_t)(row0 + (i >> 2) * HALF + (i & 3) * 16) * 16, fq) : 1.0f;
#pragma unroll
        for (int ai = 0; ai < 2; ++ai)
#pragma unroll
            for (int m = 0; m < 4; ++m) {
                const int row = row0 + ai * HALF + m * 16;
                const float rs = rsv[ai * 4 + m];
                const f32x4 g0 = acc[ai][0][m][0] * rs, g1 = acc[ai][0][m][1] * rs, u0 = acc[ai][1][m][0] * rs, u1 = acc[ai][1][m][1] * rs;
                u32x4 w;
                w.x = cvt_pk_bf16(silu_mul(g0[0], u0[0]), silu_mul(g0[1], u0[1])); w.y = cvt_pk_bf16(silu_mul(g0[2], u0[2]), silu_mul(g0[3], u0[3]));
                w.z = cvt_pk_bf16(silu_mul(g1[0], u1[0]), silu_mul(g1[1], u1[1])); w.w = cvt_pk_bf16(silu_mul(g1[2], u1[2]), silu_mul(g1[3], u1[3]));
                *(u32x4*)(O + (size_t)row * ldc + col0) = w;
            }
    }
};

__device__ __forceinline__ u32x4 xchg8(u32x4 v) {
    u32x4 r;
    r.x = (unsigned)__builtin_amdgcn_update_dpp(0, (int)v.x, 0x128, 0xf, 0xf, false); r.y = (unsigned)__builtin_amdgcn_update_dpp(0, (int)v.y, 0x128, 0xf, 0xf, false);
    r.z = (unsigned)__builtin_amdgcn_update_dpp(0, (int)v.z, 0x128, 0xf, 0xf, false); r.w = (unsigned)__builtin_amdgcn_update_dpp(0, (int)v.w, 0x128, 0xf, 0xf, false);
    return r;
}
__device__ __forceinline__ void store_rows16(bf16_t* base, int ld, u32x4 w0, u32x4 w1, int fr, int fq) {
    const bool hi = (fr & 8) != 0;
    const u32x4 rcv = xchg8(hi ? w0 : w1);
    bf16_t* p = base + (size_t)(fr & 7) * ld + (hi ? 32 : 0) + 8 * fq;
    *(u32x4*)p = hi ? rcv : w0; *(u32x4*)(p + (size_t)8 * ld) = hi ? w1 : rcv;
}
__device__ __forceinline__ void load_rows16_issue(const bf16_t* base, int ld, int fr, int fq, u32x4& la, u32x4& lb) {
    const bf16_t* p = base + (size_t)(fr & 7) * ld + ((fr & 8) ? 32 : 0) + 8 * fq;
    la = *(const u32x4*)p; lb = *(const u32x4*)(p + (size_t)8 * ld);
}
__device__ __forceinline__ void load_rows16_finish(u32x4 la, u32x4 lb, int fr, u32x4& r0, u32x4& r1) {
    const bool hi = (fr & 8) != 0;
    const u32x4 rcv = xchg8(hi ? la : lb);
    r0 = hi ? rcv : la; r1 = hi ? lb : rcv;
}

template <int RES_MODE, bool WRITE_SS> struct EpiResid {
    static constexpr bool PERM = true, AFTER_DRAIN = false;
    const float* g; const float* rstd0;
    bf16_t* xb; float* ss; float alpha;
    __device__ __forceinline__ void operator()(const f32x4 (&acc)[2][2][4][2], const Unit& u, int wr, int wc, int fr, int fq) const {
        const int rowg = u.pm * BM + wr * 64, colw = u.pn * BM + wc * 64;
        f32x4 gi[2][2]; float ri[8];
        if (RES_MODE == 2) {
#pragma unroll
            for (int bj = 0; bj < 2; ++bj)
#pragma unroll
                for (int n = 0; n < 2; ++n) { const f32x4 gv = *(const f32x4*)(g + colw + 32 * bj + 8 * fq + 4 * n); gi[bj][n] = (f32x4){__builtin_amdgcn_rcpf(gv[0]), __builtin_amdgcn_rcpf(gv[1]), __builtin_amdgcn_rcpf(gv[2]), __builtin_amdgcn_rcpf(gv[3])}; }
#pragma unroll
            for (int i = 0; i < 8; ++i) ri[i] = __builtin_amdgcn_rcpf(rstd0[rowg + (i >> 2) * HALF + (i & 3) * 16 + fr]);
        }
        bf16_t* xw = xb + (size_t)rowg * 1024 + colw;
        u32x4 la[2][4], lb[2][4];
#pragma unroll
        for (int ai = 0; ai < 2; ++ai)
#pragma unroll
            for (int m = 0; m < 4; ++m) load_rows16_issue(xw + (size_t)(ai * HALF + m * 16) * 1024, 1024, fr, fq, la[ai][m], lb[ai][m]);
#pragma unroll
        for (int ai = 0; ai < 2; ++ai)
#pragma unroll
            for (int m = 0; m < 4; ++m) {
                u32x4 q[2]; load_rows16_finish(la[ai][m], lb[ai][m], fr, q[0], q[1]);
                u32x4 w[2]; float s = 0.f;
#pragma unroll
                for (int bj = 0; bj < 2; ++bj) {
                    f32x4 r0 = (f32x4){__builtin_bit_cast(float, q[bj].x << 16), __builtin_bit_cast(float, q[bj].x & 0xffff0000u), __builtin_bit_cast(float, q[bj].y << 16), __builtin_bit_cast(float, q[bj].y & 0xffff0000u)};
                    f32x4 r1 = (f32x4){__builtin_bit_cast(float, q[bj].z << 16), __builtin_bit_cast(float, q[bj].z & 0xffff0000u), __builtin_bit_cast(float, q[bj].w << 16), __builtin_bit_cast(float, q[bj].w & 0xffff0000u)};
                    if (RES_MODE == 2) { r0 = r0 * gi[bj][0] * ri[ai * 4 + m]; r1 = r1 * gi[bj][1] * ri[ai * 4 + m]; }
                    const f32x4 v0 = r0 + acc[ai][bj][m][0] * alpha, v1 = r1 + acc[ai][bj][m][1] * alpha;
                    w[bj].x = cvt_pk_bf16(v0[0], v0[1]); w[bj].y = cvt_pk_bf16(v0[2], v0[3]); w[bj].z = cvt_pk_bf16(v1[0], v1[1]); w[bj].w = cvt_pk_bf16(v1[2], v1[3]);
                    if (WRITE_SS) s += (v0[0] * v0[0] + v0[1] * v0[1]) + (v0[2] * v0[2] + v0[3] * v0[3]) + (v1[0] * v1[0] + v1[1] * v1[1]) + (v1[2] * v1[2] + v1[3] * v1[3]);
                }
                store_rows16(xw + (size_t)(ai * HALF + m * 16) * 1024, 1024, w[0], w[1], fr, fq);
                if (WRITE_SS) { s += __shfl_xor(s, 16); s += __shfl_xor(s, 32); if (fq == 0) ss[(size_t)(rowg + ai * HALF + m * 16 + fr) * 16 + u.pn * 4 + wc] = s; }
            }
    }
};

struct EpiWin {
    static constexpr bool PERM = true, AFTER_DRAIN = false;
    const float* ss; bf16_t *ZQ, *ZK, *VT, *ZC; const float *qg, *kg;
    __device__ __forceinline__ void operator()(const f32x4 (&acc)[2][2][4][2], const Unit& u, int wr, int wc, int fr, int fq) const {
        const int row0 = u.pm * BM + wr * 64 + fr, pn = u.pn;
        float rsv[8];
#pragma unroll
        for (int i = 0; i < 8; ++i) rsv[i] = row_rstd16_coop(ss + (size_t)(row0 + (i >> 2) * HALF + (i & 3) * 16) * 16, fq);
        if (pn < 4) {
            const bool isq = pn < 2; const float* gp = (isq ? qg : kg) + 8 * fq; const float gs = isq ? 0.125f * 1.4426950408889634f : 1.0f;
            f32x4 gn[2][2];
#pragma unroll
            for (int bj = 0; bj < 2; ++bj)
#pragma unroll
                for (int n = 0; n < 2; ++n) gn[bj][n] = *(const f32x4*)(gp + 32 * bj + 4 * n) * gs;
            bf16_t* Z = (isq ? ZQ : ZK) + (pn & 1) * 256 + wc * 64 + (size_t)(u.pm * BM + wr * 64) * 512;
#pragma unroll
            for (int ai = 0; ai < 2; ++ai)
#pragma unroll
                for (int m = 0; m < 4; ++m) {
                    const int row = row0 + ai * HALF + m * 16; const float rs = rsv[ai * 4 + m];
                    f32x4 v[2][2]; float s = 0.f;
#pragma unroll
                    for (int bj = 0; bj < 2; ++bj)
#pragma unroll
                        for (int n = 0; n < 2; ++n) { v[bj][n] = acc[ai][bj][m][n] * rs; const f32x4 x = v[bj][n]; s += (x[0] * x[0] + x[1] * x[1]) + (x[2] * x[2] + x[3] * x[3]); }
                    s += __shfl_xor(s, 16); s += __shfl_xor(s, 32);
                    const float rn = __builtin_amdgcn_rsqf(s * (1.0f / 64.0f) + RMS_EPS);
                    u32x4 w[2];
#pragma unroll
                    for (int bj = 0; bj < 2; ++bj) {
                        const f32x4 a = v[bj][0] * gn[bj][0] * rn, b = v[bj][1] * gn[bj][1] * rn;
                        w[bj].x = cvt_pk_bf16(a[0], a[1]); w[bj].y = cvt_pk_bf16(a[2], a[3]); w[bj].z = cvt_pk_bf16(b[0], b[1]); w[bj].w = cvt_pk_bf16(b[2], b[3]);
                    }
                    store_rows16(Z + (size_t)(ai * HALF + m * 16) * 512, 512, w[0], w[1], fr, fq);
                }
        } else if (pn < 6) {
            const int rowt = u.pm * BM; const int S = (rowt < 65536) ? 2048 : 4096; const int h = 4 * (pn - 4) + wc;
#pragma unroll
            for (int ai = 0; ai < 2; ++ai)
#pragma unroll
                for (int m = 0; m < 4; ++m) {
                    const int row = row0 + ai * HALF + m * 16; const float rs = rsv[ai * 4 + m];
                    const int t = row & (S - 1); bf16_t* vp = VT + (size_t)(row - t) * 512 + (size_t)(h * 64 + 8 * fq) * S + t;
#pragma unroll
                    for (int bj = 0; bj < 2; ++bj)
#pragma unroll
                        for (int n = 0; n < 2; ++n) {
                            const f32x4 x = acc[ai][bj][m][n] * rs; const unsigned p0 = cvt_pk_bf16(x[0], x[1]), p1 = cvt_pk_bf16(x[2], x[3]);
                            bf16_t* q = vp + (size_t)(32 * bj + 4 * n) * S;
                            q[0] = (bf16_t)(p0 & 0xffffu); q[(size_t)S] = (bf16_t)(p0 >> 16); q[(size_t)2 * S] = (bf16_t)(p1 & 0xffffu); q[(size_t)3 * S] = (bf16_t)(p1 >> 16);
                        }
                }
        } else if (pn < 8) {
            bf16_t* Z = ZC + (pn - 6) * 256 + wc * 64 + (size_t)(u.pm * BM + wr * 64) * 1024;
#pragma unroll
            for (int ai = 0; ai < 2; ++ai)
#pragma unroll
                for (int m = 0; m < 4; ++m) {
                    const float rs = rsv[ai * 4 + m];
                    u32x4 w[2];
#pragma unroll
                    for (int bj = 0; bj < 2; ++bj) {
                        const f32x4 a = acc[ai][bj][m][0] * rs, b = acc[ai][bj][m][1] * rs;
                        w[bj].x = cvt_pk_bf16(a[0], a[1]); w[bj].y = cvt_pk_bf16(a[2], a[3]); w[bj].z = cvt_pk_bf16(b[0], b[1]); w[bj].w = cvt_pk_bf16(b[2], b[3]);
                    }
                    store_rows16(Z + (size_t)(ai * HALF + m * 16) * 1024, 1024, w[0], w[1], fr, fq);
                }
        } else {
            bf16_t* Z = ZC + 512 + (pn - 8) * 128 + wc * 32 + 8 * fq + (size_t)row0 * 1024;
#pragma unroll
            for (int ai = 0; ai < 2; ++ai)
#pragma unroll
                for (int m = 0; m < 4; ++m) {
                    const float rs = rsv[ai * 4 + m], rs2 = rs * rs;
                    const f32x4 a = acc[ai][0][m][0] * acc[ai][1][m][0] * rs2, b = acc[ai][0][m][1] * acc[ai][1][m][1] * rs2;
                    u32x4 w; w.x = cvt_pk_bf16(a[0], a[1]); w.y = cvt_pk_bf16(a[2], a[3]); w.z = cvt_pk_bf16(b[0], b[1]); w.w = cvt_pk_bf16(b[2], b[3]);
                    *(u32x4*)(Z + (size_t)(ai * HALF + m * 16) * 1024) = w;
                }
        }
    }
};

template <class Epi, class Sched, bool ALIGN_EPI = false, bool SP2 = false>
__device__ __forceinline__ void gemm_phase(PG8_LAS unsigned char* lds, const Gemm g, const Sched& S, const Epi& E) {
    const int wid = g.wid, lane = (int)__builtin_amdgcn_mbcnt_hi(~0u, __builtin_amdgcn_mbcnt_lo(~0u, 0u)), tid = wid * 64 + lane, wr = wid >> 2, wc = wid & 3, fr = lane & 15, fq = lane >> 4;
    const int K = g.K, nt = K / BK;
    unsigned voffA[2], voffB[2];
#pragma unroll
    for (int i = 0; i < 2; ++i) { int R, C; stage_rc(tid * 16 + i * 8192, R, C); const int Rb = Epi::PERM ? ((R & ~31) + perm32(R & 31)) : R;
        voffA[i] = (unsigned)(R * K + C) * 2u; voffB[i] = (unsigned)(Rb * K + C) * 2u; }
    const size_t kstep = (size_t)(BK * 2);
    const size_t hstep = (size_t)HALF * K * 2;
    const size_t tstep = 2 * hstep;
    const unsigned ldsw = (unsigned)wid * 1024u;
    const int aoff = lds_byte(wr * 64 + fr, fq * 8), boff = lds_byte(wc * 32 + fr, fq * 8);
#define PG8_SA(b, h) (((b) * 2 + (h)) * HTB)
#define PG8_SB(b, h) ((4 + (b) * 2 + (h)) * HTB)
#define PG8_STAGE(bufoff, gbase, voff) do { _Pragma("unroll") for (int _i = 0; _i < 2; ++_i) \
        __builtin_amdgcn_global_load_lds((const unsigned*)((const char*)(gbase) + (voff)[_i]), (PG8_LAS unsigned*)(lds + (bufoff) + ldsw + _i * 8192), 16, 0, 0); } while (0)
#define PG8_LDA(dst, b, h) do { _Pragma("unroll") for (int m = 0; m < 4; ++m) _Pragma("unroll") for (int k = 0; k < 2; ++k) dst[m][k] = *(const PG8_LAS bf16x8*)(lds + PG8_SA(b, h) + aoff + m * 2048 + k * 1024); } while (0)
#define PG8_LDB(dst, b, h) do { _Pragma("unroll") for (int n = 0; n < 2; ++n) _Pragma("unroll") for (int k = 0; k < 2; ++k) dst[n][k] = *(const PG8_LAS bf16x8*)(lds + PG8_SB(b, h) + boff + n * 2048 + k * 1024); } while (0)
#define PG8_MMA(ai, bj, At, Bt) do { __builtin_amdgcn_s_setprio(1); _Pragma("unroll") for (int m = 0; m < 4; ++m) _Pragma("unroll") for (int n = 0; n < 2; ++n) _Pragma("unroll") for (int k = 0; k < 2; ++k) \
        acc[ai][bj][m][n] = __builtin_amdgcn_mfma_f32_16x16x32_bf16(Bt[n][k], At[m][k], acc[ai][bj][m][n], 0, 0, 0); __builtin_amdgcn_s_setprio(0); } while (0)
#define PG8_WAIT_V(n) asm volatile("s_waitcnt vmcnt(" #n ")" ::: "memory")
#define PG8_WAIT_L(n) asm volatile("s_waitcnt lgkmcnt(" #n ")" ::: "memory")
#define PG8_BAR __builtin_amdgcn_s_barrier()
#define PG8_SCHED __builtin_amdgcn_sched_barrier(0)
    Unit cur, nxt; int ui = 0;
    if (!S.next(0, cur)) return;
    f32x4 acc[2][2][4][2];
#pragma unroll
    for (int a = 0; a < 2; ++a)
#pragma unroll
        for (int b = 0; b < 2; ++b)
#pragma unroll
            for (int m = 0; m < 4; ++m)
#pragma unroll
                for (int n = 0; n < 2; ++n) acc[a][b][m][n] = (f32x4){0.f, 0.f, 0.f, 0.f};
    bf16x8 At[4][2], B0[2][2], B1[2][2];
    const char* cA = (const char*)g.A + (size_t)cur.pm * tstep; const char* cB = (const char*)g.Bt + (size_t)cur.pn * tstep;
    S.a_ready(cur);
    if constexpr (SP2) {
        PG8_STAGE(PG8_SB(0, 0), cB, voffB); PG8_STAGE(PG8_SB(0, 1), cB + hstep, voffB); PG8_STAGE(PG8_SA(0, 0), cA, voffA); PG8_STAGE(PG8_SA(0, 1), cA + hstep, voffA);
        if (wr == 1) PG8_BAR;
        PG8_WAIT_V(2); PG8_BAR;
        PG8_STAGE(PG8_SB(1, 0), cB + kstep, voffB); PG8_STAGE(PG8_SA(1, 0), cA + kstep, voffA); PG8_STAGE(PG8_SB(1, 1), cB + hstep + kstep, voffB);
        PG8_WAIT_V(6); PG8_BAR;
    } else {
        PG8_STAGE(PG8_SB(0, 0), cB, voffB); PG8_STAGE(PG8_SA(0, 0), cA, voffA); PG8_STAGE(PG8_SB(0, 1), cB + hstep, voffB); PG8_STAGE(PG8_SA(0, 1), cA + hstep, voffA);
        if (wr == 1) PG8_BAR;
        PG8_WAIT_V(4); PG8_BAR;
        PG8_STAGE(PG8_SB(1, 0), cB + kstep, voffB); PG8_STAGE(PG8_SA(1, 0), cA + kstep, voffA); PG8_STAGE(PG8_SB(1, 1), cB + hstep + kstep, voffB);
        PG8_WAIT_V(6); PG8_BAR;
    }
    for (;;) {
        const bool has_next = S.next(ui + 1, nxt);
        const char* nA = has_next ? (const char*)g.A + (size_t)nxt.pm * tstep : cA; const char* nB = has_next ? (const char*)g.Bt + (size_t)nxt.pn * tstep : cB;
        for (int t = 0; t < nt; t += 2) {
            const bool last = (t == nt - 2);
            const char* a1 = cA + (size_t)(t + 1) * kstep;
            const char* a2 = last ? nA : cA + (size_t)(t + 2) * kstep; const char* b2 = last ? nB : cB + (size_t)(t + 2) * kstep;
            const char* a3 = a2 + kstep; const char* b3 = b2 + kstep;
            if (last && has_next) S.a_ready(nxt);
            if constexpr (SP2) {
            PG8_LDB(B0, 0, 0); PG8_LDB(B1, 0, 1); PG8_SCHED; PG8_LDA(At, 0, 0); PG8_STAGE(PG8_SA(1, 1), a1 + hstep, voffA);
            PG8_WAIT_V(8); PG8_WAIT_L(0); PG8_BAR; PG8_MMA(0, 0, At, B0); PG8_MMA(0, 1, At, B1); PG8_BAR; PG8_SCHED;
            PG8_LDA(At, 0, 1); PG8_STAGE(PG8_SB(0, 0), b2, voffB); PG8_STAGE(PG8_SB(0, 1), b2 + hstep, voffB); PG8_STAGE(PG8_SA(0, 0), a2, voffA);
            PG8_WAIT_V(8); PG8_WAIT_L(0); PG8_BAR; PG8_MMA(1, 0, At, B0); PG8_MMA(1, 1, At, B1); PG8_BAR; PG8_SCHED;
            PG8_LDB(B0, 1, 0); PG8_LDB(B1, 1, 1); PG8_SCHED; PG8_LDA(At, 1, 0); PG8_STAGE(PG8_SA(0, 1), a2 + hstep, voffA);
            PG8_WAIT_V(8); PG8_WAIT_L(0); PG8_BAR; PG8_MMA(0, 0, At, B0); PG8_MMA(0, 1, At, B1); PG8_BAR; PG8_SCHED;
            PG8_LDA(At, 1, 1); PG8_STAGE(PG8_SB(1, 0), b3, voffB); PG8_STAGE(PG8_SB(1, 1), b3 + hstep, voffB); PG8_STAGE(PG8_SA(1, 0), a3, voffA);
            PG8_WAIT_V(8); PG8_WAIT_L(0); PG8_BAR; PG8_MMA(1, 0, At, B0); PG8_MMA(1, 1, At, B1); PG8_BAR; PG8_SCHED;
            } else {
            PG8_LDB(B0, 0, 0); PG8_SCHED; PG8_LDA(At, 0, 0); PG8_STAGE(PG8_SA(1, 1), a1 + hstep, voffA);
            PG8_WAIT_L(8); PG8_BAR; PG8_WAIT_L(0); PG8_MMA(0, 0, At, B0); PG8_BAR; PG8_SCHED;
            PG8_LDB(B1, 0, 1); PG8_STAGE(PG8_SB(0, 0), b2, voffB);
            PG8_BAR; PG8_WAIT_L(0); PG8_MMA(0, 1, At, B1); PG8_BAR;
            PG8_LDA(At, 0, 1); PG8_STAGE(PG8_SA(0, 0), a2, voffA);
            PG8_BAR; PG8_WAIT_L(0); PG8_MMA(1, 0, At, B0); PG8_BAR; PG8_SCHED;
            PG8_STAGE(PG8_SB(0, 1), b2 + hstep, voffB);
            PG8_WAIT_V(6); PG8_BAR; PG8_MMA(1, 1, At, B1); PG8_BAR;
            PG8_LDB(B0, 1, 0); PG8_SCHED; PG8_LDA(At, 1, 0); PG8_STAGE(PG8_SA(0, 1), a2 + hstep, voffA);
            PG8_WAIT_L(8); PG8_BAR; PG8_WAIT_L(0); PG8_MMA(0, 0, At, B0); PG8_BAR; PG8_SCHED;
            PG8_LDB(B1, 1, 1); PG8_STAGE(PG8_SB(1, 0), b3, voffB);
            PG8_BAR; PG8_WAIT_L(0); PG8_MMA(0, 1, At, B1); PG8_BAR;
            PG8_LDA(At, 1, 1); PG8_STAGE(PG8_SA(1, 0), a3, voffA);
            PG8_BAR; PG8_WAIT_L(0); PG8_MMA(1, 0, At, B0); PG8_BAR; PG8_SCHED;
            PG8_STAGE(PG8_SB(1, 1), b3 + hstep, voffB);
            PG8_WAIT_V(6); PG8_BAR; PG8_MMA(1, 1, At, B1); PG8_BAR;
            }
        }
        if constexpr (ALIGN_EPI) { if (wr == 0) PG8_BAR; }
        if constexpr (!Epi::AFTER_DRAIN) { E(acc, cur, wr, wc, fr, fq); S.done(cur); }
        if (!has_next) break;
#pragma unroll
        for (int a = 0; a < 2; ++a)
#pragma unroll
            for (int b = 0; b < 2; ++b)
#pragma unroll
                for (int m = 0; m < 4; ++m)
#pragma unroll
                    for (int n = 0; n < 2; ++n) acc[a][b][m][n] = (f32x4){0.f, 0.f, 0.f, 0.f};
        cur = nxt; cA = nA; cB = nB; ++ui;
        if constexpr (ALIGN_EPI) { if (wr == 1) PG8_BAR; }
    }
    PG8_WAIT_V(0);
    if constexpr (!ALIGN_EPI) { if (wr == 0) PG8_BAR; }
    PG8_BAR;
    if constexpr (Epi::AFTER_DRAIN) { E.fused(acc, cur, wr, wc, fr, fq, lds, wid, lane); S.done(cur); }
#undef PG8_SA
#undef PG8_SB
#undef PG8_STAGE
#undef PG8_LDA
#undef PG8_LDB
#undef PG8_MMA
#undef PG8_WAIT_V
#undef PG8_WAIT_L
#undef PG8_BAR
#undef PG8_SCHED
}
}
#define GAS __attribute__((address_space(1)))
#define LAS __attribute__((address_space(3)))
typedef unsigned short bf16;
typedef unsigned v4u __attribute__((ext_vector_type(4)));
typedef unsigned v2u __attribute__((ext_vector_type(2)));
typedef float f32x4 __attribute__((ext_vector_type(4)));
typedef short bf16x8 __attribute__((ext_vector_type(8)));
typedef short s16x4 __attribute__((ext_vector_type(4)));
#define LDS_WAIT() asm volatile("s_waitcnt lgkmcnt(0)" ::: "memory")

constexpr int NWAVES = 8;
constexpr int M_TOK = 81920, MP = 65536, D = 1024, FF = 2816, NGU = 2 * FF, DIN = 3072;
constexpr float EPSF = 1e-6f;
constexpr size_t MiB = 1u << 20;
constexpr size_t WS_CTL = 0, CTL_ZERO_BYTES = 65536;
constexpr size_t WS_W1GU = 1 * MiB, WS_W1D = 12 * MiB, WS_WIN = 18 * MiB, WS_WOUT = 24 * MiB, WS_W2GU = 26 * MiB, WS_W2D = 37 * MiB;
constexpr size_t WS_SS1 = 44 * MiB, WS_SS2 = 50 * MiB, WS_RS0 = 56 * MiB;
constexpr size_t WS_XB = 64 * MiB;
constexpr size_t WS_ACT = 224 * MiB;
constexpr size_t WS_ZQ = WS_ACT, WS_ZK = WS_ACT + 80 * MiB, WS_VT = WS_ACT + 160 * MiB, WS_ZC = WS_ACT + 240 * MiB;
constexpr size_t WS_AC = 704 * MiB;
constexpr size_t WS_END = 864 * MiB;
constexpr int RING_BYTES = 131072, LDS_BYTES = 147456;

__device__ __forceinline__ unsigned f2bf(float f) { unsigned u = __builtin_bit_cast(unsigned, f); return (u + 0x7fffu + ((u >> 16) & 1u)) >> 16; }
__device__ __forceinline__ unsigned pk2(float lo, float hi) { return pg8::cvt_pk_bf16(lo, hi); }
__device__ __forceinline__ float bflo(unsigned w) { return __builtin_bit_cast(float, w << 16); }
__device__ __forceinline__ float bfhi(unsigned w) { return __builtin_bit_cast(float, w & 0xffff0000u); }
__device__ __forceinline__ float wave_sum(float v) {
#pragma unroll
    for (int o = 1; o < 64; o <<= 1) v += __shfl_xor(v, o);
    return v;
}

__device__ __forceinline__ void p0_transpose_item(const float* W, int K, int N, bf16* WT, const float* gain, int kind, LAS float* scr, int item, int lane) {
    const int nblk = N / 32, kb = item / nblk, nb = item % nblk, k0 = 64 * kb, n0 = 32 * nb;
    int rowbase = n0;
    const float kscale = (kind == 1) ? 1.4426950408889634f : (kind == 2) ? 0.6931471805599453f : 1.0f;
    if (kind == 1) rowbase = (n0 >> 7) * 256 + (n0 & 127);
    else if (kind == 2) rowbase = (n0 >> 7) * 256 + 128 + (n0 & 127);
    else if (kind == 3 || (kind == 4 && n0 < 2048)) rowbase = (n0 & ~255) + 128 * ((n0 >> 5) & 1) + 32 * ((n0 >> 6) & 3);
    else if (kind == 4) { const int isx = n0 >= 2560, ch0 = (n0 - 2048) & 511; rowbase = 256 * (8 + (ch0 >> 7)) + 128 * isx + 32 * ((ch0 >> 5) & 3); }
#pragma unroll 8
    for (int i = 0; i < 32; ++i) { const int kk = 2 * i + (lane >> 5); const float g = (gain ? gain[k0 + kk] : 1.0f) * kscale; scr[kk * 33 + (lane & 31)] = W[(size_t)(k0 + kk) * N + n0 + (lane & 31)] * g; }
    LDS_WAIT(); asm volatile("" ::: "memory");
    const int c = lane & 7;
#pragma unroll
    for (int j = 0; j < 4; ++j) { const int n = (lane >> 3) + 8 * j; const LAS float* s = scr + (8 * c) * 33 + n;
        v4u o; o.x = pk2(s[0 * 33], s[1 * 33]); o.y = pk2(s[2 * 33], s[3 * 33]); o.z = pk2(s[4 * 33], s[5 * 33]); o.w = pk2(s[6 * 33], s[7 * 33]);
        *(v4u*)(WT + (size_t)(rowbase + n) * K + k0 + 8 * c) = o; }
    LDS_WAIT(); asm volatile("" ::: "memory");
}

struct Args {
    const float* in[20]; float* out; unsigned char* ws; int ph_lo, ph_hi;
};
enum { I_XP = 0, I_XS, I_F1N, I_F1G, I_F1U, I_F1D, I_MIXN, I_WIN, I_QN, I_KN, I_RPB, I_CW, I_AON, I_CON, I_WOUT, I_F2N, I_F2G, I_F2U, I_F2D, I_FINN };

__device__ __forceinline__ void p0_prologue(const Args& A, LAS unsigned char* lds, int gw, int NGW, int wave, int lane) {
    unsigned char* ws = A.ws;
    LAS float* scr = (LAS float*)(lds + wave * 16384);
    constexpr int I_G = (D / 64) * (FF / 32), I_DN = (FF / 64) * (D / 32), I_IN = (D / 64) * (DIN / 32), I_OUT = (D / 64) * (D / 32);
    constexpr int NITEMS = 2 * (2 * I_G + I_DN) + I_IN + I_OUT;
    for (int it = gw; it < NITEMS; it += NGW) {
        int r = it;
        if (r < I_G) { p0_transpose_item(A.in[I_F1G], D, FF, (bf16*)(ws + WS_W1GU), nullptr, 1, scr, r, lane); continue; } r -= I_G;
        if (r < I_G) { p0_transpose_item(A.in[I_F1U], D, FF, (bf16*)(ws + WS_W1GU), nullptr, 2, scr, r, lane); continue; } r -= I_G;
        if (r < I_DN) { p0_transpose_item(A.in[I_F1D], FF, D, (bf16*)(ws + WS_W1D), nullptr, 3, scr, r, lane); continue; } r -= I_DN;
        if (r < I_G) { p0_transpose_item(A.in[I_F2G], D, FF, (bf16*)(ws + WS_W2GU), A.in[I_F2N], 1, scr, r, lane); continue; } r -= I_G;
        if (r < I_G) { p0_transpose_item(A.in[I_F2U], D, FF, (bf16*)(ws + WS_W2GU), A.in[I_F2N], 2, scr, r, lane); continue; } r -= I_G;
        if (r < I_DN) { p0_transpose_item(A.in[I_F2D], FF, D, (bf16*)(ws + WS_W2D), nullptr, 3, scr, r, lane); continue; } r -= I_DN;
        if (r < I_IN) { p0_transpose_item(A.in[I_WIN], D, DIN, (bf16*)(ws + WS_WIN), A.in[I_MIXN], 4, scr, r, lane); continue; } r -= I_IN;
        p0_transpose_item(A.in[I_WOUT], D, D, (bf16*)(ws + WS_WOUT), nullptr, 3, scr, r, lane);
    }
    const f32x4* gp = (const f32x4*)A.in[I_F1N] + lane;
    f32x4 gv[4];
#pragma unroll
    for (int j = 0; j < 4; ++j) gv[j] = gp[64 * j];
    bf16* XN = (bf16*)(ws + WS_XB);
    for (int m = gw; m < M_TOK; m += 2 * NGW) {
        const int m2 = m + NGW;
        const float* xrow = (m < MP) ? A.in[I_XP] + (size_t)m * D : A.in[I_XS] + (size_t)(m - MP) * D;
        const float* xrow2 = (m2 < MP) ? A.in[I_XP] + (size_t)m2 * D : A.in[I_XS] + (size_t)(m2 - MP) * D;
        const f32x4* xr = (const f32x4*)xrow + lane; const f32x4* xr2 = (const f32x4*)xrow2 + lane; f32x4 v[4], v2[4]; float s = 0.f, s2 = 0.f;
#pragma unroll
        for (int j = 0; j < 4; ++j) { v[j] = xr[64 * j]; v2[j] = xr2[64 * j]; }
#pragma unroll
        for (int j = 0; j < 4; ++j) { s += (v[j].x * v[j].x + v[j].y * v[j].y) + (v[j].z * v[j].z + v[j].w * v[j].w); s2 += (v2[j].x * v2[j].x + v2[j].y * v2[j].y) + (v2[j].z * v2[j].z + v2[j].w * v2[j].w); }
        const float rstd = __builtin_amdgcn_rsqf(wave_sum(s) * (1.0f / D) + EPSF), rstd2 = __builtin_amdgcn_rsqf(wave_sum(s2) * (1.0f / D) + EPSF);
        unsigned long long* o8 = (unsigned long long*)(XN + (size_t)m * D) + lane; unsigned long long* o82 = (unsigned long long*)(XN + (size_t)m2 * D) + lane;
        if (lane == 0) { float* rs0 = (float*)(ws + WS_RS0); rs0[m] = rstd; rs0[m2] = rstd2; }
#pragma unroll
        for (int j = 0; j < 4; ++j) { const f32x4 y = v[j] * rstd * gv[j]; o8[64 * j] = (unsigned long long)pk2(y.x, y.y) | ((unsigned long long)pk2(y.z, y.w) << 32);
            const f32x4 y2 = v2[j] * rstd2 * gv[j]; o82[64 * j] = (unsigned long long)pk2(y2.x, y2.y) | ((unsigned long long)pk2(y2.z, y2.w) << 32); }
    }
}

__device__ __forceinline__ void final_norm_phase(const Args& A, int gw, int NGW, int lane) {
    const float* gp = A.in[I_FINN] + 8 * lane;
    const f32x4 g0 = *(const f32x4*)(gp), g1 = *(const f32x4*)(gp + 4), g2 = *(const f32x4*)(gp + 512), g3 = *(const f32x4*)(gp + 516);
    const bf16* XB = (const bf16*)(A.ws + WS_XB);
    for (int m = gw; m < M_TOK; m += 4 * NGW) {
        v4u a[4], b[4];
#pragma unroll
        for (int i = 0; i < 4; ++i) { const bf16* xr = XB + (size_t)(m + i * NGW) * D + 8 * lane; a[i] = *(const v4u*)(xr); b[i] = *(const v4u*)(xr + 512); }
#pragma unroll
        for (int i = 0; i < 4; ++i) {
            const f32x4 v0 = (f32x4){bflo(a[i].x), bfhi(a[i].x), bflo(a[i].y), bfhi(a[i].y)}, v1 = (f32x4){bflo(a[i].z), bfhi(a[i].z), bflo(a[i].w), bfhi(a[i].w)};
            const f32x4 v2 = (f32x4){bflo(b[i].x), bfhi(b[i].x), bflo(b[i].y), bfhi(b[i].y)}, v3 = (f32x4){bflo(b[i].z), bfhi(b[i].z), bflo(b[i].w), bfhi(b[i].w)};
            const float s = (v0.x * v0.x + v0.y * v0.y) + (v0.z * v0.z + v0.w * v0.w) + (v1.x * v1.x + v1.y * v1.y) + (v1.z * v1.z + v1.w * v1.w)
                          + (v2.x * v2.x + v2.y * v2.y) + (v2.z * v2.z + v2.w * v2.w) + (v3.x * v3.x + v3.y * v3.y) + (v3.z * v3.z + v3.w * v3.w);
            const float rstd = __builtin_amdgcn_rsqf(wave_sum(s) * (1.0f / D) + EPSF);
            float* o = A.out + (size_t)(m + i * NGW) * D + 8 * lane;
            *(f32x4*)(o) = v0 * rstd * g0; *(f32x4*)(o + 4) = v1 * rstd * g1; *(f32x4*)(o + 512) = v2 * rstd * g2; *(f32x4*)(o + 516) = v3 * rstd * g3;
        }
    }
}

constexpr int RPB_OFF = 256, RPB_N = 8 * 15 * 31;
__device__ __forceinline__ void attn_finish(f32x4 (&o)[4], float sum, const float* aogp  , bf16* op) {
    const float il = __builtin_amdgcn_rcpf(sum); float q2 = 0.f;
#pragma unroll
    for (int mt = 0; mt < 4; ++mt) { o[mt] = o[mt] * il; q2 += (o[mt][0] * o[mt][0] + o[mt][1] * o[mt][1]) + (o[mt][2] * o[mt][2] + o[mt][3] * o[mt][3]); }
    q2 += __shfl_xor(q2, 16); q2 += __shfl_xor(q2, 32);
    const float rn = __builtin_amdgcn_rsqf(q2 * (1.0f / 64.0f) + EPSF);
#pragma unroll
    for (int mt = 0; mt < 4; ++mt) { const f32x4 y = o[mt] * rn * *(const f32x4*)(aogp + 16 * mt); v2u w; w.x = pg8::cvt_pk_bf16(y[0], y[1]); w.y = pg8::cvt_pk_bf16(y[2], y[3]); *(v2u*)(op + 16 * mt) = w; }
}
template <int STEP>
__device__ __forceinline__ void attn_quad(const bf16* ZQ, const bf16* ZK, const bf16* VT, bf16* AC, const LAS float* rpbL, const float* aogp,
                                          int seqbase, int S, int rA, int rs0, int h, int qc, int l, int g) {
    constexpr int NU = 8 + 3 * STEP;
    const int w0 = (qc == 0) ? 0 : (qc == 1) ? 8 : (qc == 2) ? 24 : 32;
    const int c = 16 * qc + l; int cs = c - 8; cs = cs < 0 ? 0 : cs; cs = cs > 48 ? 48 : cs;
    const size_t qtok0 = (size_t)seqbase + rA * 64 + c;
    bf16x8 qf[4][2];
#pragma unroll
    for (int i = 0; i < 4; ++i)
#pragma unroll
        for (int ks = 0; ks < 2; ++ks) qf[i][ks] = *(const bf16x8*)(ZQ + (qtok0 + 64 * i) * 512 + h * 64 + ks * 32 + 8 * g);
    const bf16* kp = ZK + ((size_t)seqbase + rs0 * 64 + w0 + 8 * (l >> 2) + (l & 3)) * 512 + h * 64 + 8 * g;
    const bf16* vp = VT + (size_t)seqbase * 512 + (size_t)(h * 64 + l) * S + rs0 * 64 + w0 + 8 * g;
    const int kc0 = w0 + 8 * g;
    bool valid[2][4];
#pragma unroll
    for (int hf = 0; hf < 2; ++hf)
#pragma unroll
        for (int j = 0; j < 4; ++j) valid[hf][j] = (unsigned)(kc0 + 4 * hf + j - cs) < 16u;
    const LAS float* bp0 = rpbL + h * 465 + (rs0 - rA + 7) * 31 + (kc0 - c + 15);
    f32x4 o[4][4]; float sum[4];
#pragma unroll
    for (int i = 0; i < 4; ++i) { sum[i] = 0.f;
#pragma unroll
        for (int mt = 0; mt < 4; ++mt) o[i][mt] = (f32x4){0.f, 0.f, 0.f, 0.f}; }
    bf16x8 kn[2][2]; v4u vn[4];
#pragma unroll
    for (int hf = 0; hf < 2; ++hf) { const bf16* kt = kp + (size_t)(hf * 4) * 512; kn[hf][0] = *(const bf16x8*)(kt); kn[hf][1] = *(const bf16x8*)(kt + 32); }
#pragma unroll
    for (int mt = 0; mt < 4; ++mt) vn[mt] = *(const v4u*)(vp + (size_t)(16 * mt) * S);
#pragma unroll 1
    for (int u = 0; u < NU; ++u) {
        bf16x8 kf[2][2]; v4u vf[4];
#pragma unroll
        for (int hf = 0; hf < 2; ++hf) { kf[hf][0] = kn[hf][0]; kf[hf][1] = kn[hf][1]; }
#pragma unroll
        for (int mt = 0; mt < 4; ++mt) vf[mt] = vn[mt];
        if (u + 1 < NU) {
#pragma unroll
            for (int hf = 0; hf < 2; ++hf) { const bf16* kt = kp + (size_t)((u + 1) * 64 + hf * 4) * 512; kn[hf][0] = *(const bf16x8*)(kt); kn[hf][1] = *(const bf16x8*)(kt + 32); }
#pragma unroll
            for (int mt = 0; mt < 4; ++mt) vn[mt] = *(const v4u*)(vp + (size_t)(16 * mt) * S + (u + 1) * 64);
        }
#pragma unroll
        for (int i = 0; i < 4; ++i) {
            if ((unsigned)(u - i * STEP) < 8u) {
                f32x4 s0 = {0.f, 0.f, 0.f, 0.f}, s1 = {0.f, 0.f, 0.f, 0.f};
                s0 = __builtin_amdgcn_mfma_f32_16x16x32_bf16(kf[0][0], qf[i][0], s0, 0, 0, 0); s0 = __builtin_amdgcn_mfma_f32_16x16x32_bf16(kf[0][1], qf[i][1], s0, 0, 0, 0);
                s1 = __builtin_amdgcn_mfma_f32_16x16x32_bf16(kf[1][0], qf[i][0], s1, 0, 0, 0); s1 = __builtin_amdgcn_mfma_f32_16x16x32_bf16(kf[1][1], qf[i][1], s1, 0, 0, 0);
                const LAS float* bp = bp0 + (u - i) * 31;
                float p0[4], p1[4];
#pragma unroll
                for (int j = 0; j < 4; ++j) { p0[j] = valid[0][j] ? __builtin_amdgcn_exp2f(s0[j] + bp[j]) : 0.f; p1[j] = valid[1][j] ? __builtin_amdgcn_exp2f(s1[j] + bp[4 + j]) : 0.f; }
                sum[i] += ((p0[0] + p0[1]) + (p0[2] + p0[3])) + ((p1[0] + p1[1]) + (p1[2] + p1[3]));
                v4u pw; pw.x = pg8::cvt_pk_bf16(p0[0], p0[1]); pw.y = pg8::cvt_pk_bf16(p0[2], p0[3]); pw.z = pg8::cvt_pk_bf16(p1[0], p1[1]); pw.w = pg8::cvt_pk_bf16(p1[2], p1[3]);
                const bf16x8 pf = __builtin_bit_cast(bf16x8, pw);
#pragma unroll
                for (int mt = 0; mt < 4; ++mt) o[i][mt] = __builtin_amdgcn_mfma_f32_16x16x32_bf16(__builtin_bit_cast(bf16x8, vf[mt]), pf, o[i][mt], 0, 0, 0);
            }
        }
    }
#pragma unroll
    for (int i = 0; i < 4; ++i) {
        float sm = sum[i]; sm += __shfl_xor(sm, 16); sm += __shfl_xor(sm, 32);
        attn_finish(o[i], sm, aogp, AC + (qtok0 + 64 * i) * 1024 + h * 64 + 4 * g);
    }
}

__device__ __forceinline__ void attn_conv_phase(const Args& A, LAS unsigned char* lds, int wave, int lane) {
    unsigned char* ws = A.ws;
    const bf16* ZQ = (const bf16*)(ws + WS_ZQ); const bf16* ZK = (const bf16*)(ws + WS_ZK); const bf16* VT = (const bf16*)(ws + WS_VT); const bf16* ZC = (const bf16*)(ws + WS_ZC);
    bf16* AC = (bf16*)(ws + WS_AC);
    LAS float* rpbL = (LAS float*)(lds + RPB_OFF);
    float cb;
    { const float mq = fabsf(A.in[I_QN][lane]), mk = fabsf(A.in[I_KN][lane]); float mqw = mq, mkw = mk, mb = 0.f;
      for (int i = lane; i < RPB_N; i += 64) mb = fmaxf(mb, fabsf(A.in[I_RPB][i]));
#pragma unroll
      for (int o_ = 1; o_ < 64; o_ <<= 1) { mqw = fmaxf(mqw, __shfl_xor(mqw, o_)); mkw = fmaxf(mkw, __shfl_xor(mkw, o_)); mb = fmaxf(mb, __shfl_xor(mb, o_)); }
      cb = 11.5416f * 1.01f * mqw * mkw + 1.4426950408889634f * mb; }
    for (int i = wave * 64 + lane; i < RPB_N; i += NWAVES * 64) rpbL[i] = A.in[I_RPB][i] * 1.4426950408889634f - cb;
    __syncthreads();
    const int l = lane & 15, g = lane >> 4;
#if PROBE_DUP == 44
#pragma unroll 1
    for (int rep_ = 0; rep_ < 2; ++rep_)
#endif
    const int G_ = (int)gridDim.x, vcu_ = (G_ % 8 == 0) ? ((int)blockIdx.x % 8) * (G_ / 8) + (int)blockIdx.x / 8 : (int)blockIdx.x;
    for (int ui_ = 0; ui_ < 5; ++ui_) {
        const int unit = (G_ == 256) ? 32 * (5 * (vcu_ >> 5) + (4 - ui_)) + (vcu_ & 31) : vcu_ + ui_ * G_;
        if (unit >= 1280) break;
        const int quad = unit >> 2, hq = unit & 3;
        int seqbase, rA, S, rows;
        if (quad < 256) { seqbase = (quad >> 3) * 2048; rA = 4 * (quad & 7); S = 2048; rows = 32; }
        else { const int q2 = quad - 256; seqbase = MP + (q2 >> 4) * 4096; rA = 4 * (q2 & 15); S = 4096; rows = 64; }
        int rs0 = rA - 4; rs0 = rs0 < 0 ? 0 : rs0; rs0 = rs0 > rows - 8 ? rows - 8 : rs0;
        int rs1 = rA - 3; rs1 = rs1 < 0 ? 0 : rs1; rs1 = rs1 > rows - 8 ? rows - 8 : rs1;
        const int h = 2 * hq + (wave & 1), qc = wave >> 1;
        const float* aogp = A.in[I_AON] + h * 64 + 4 * g;
        if (rs1 != rs0) attn_quad<1>(ZQ, ZK, VT, AC, rpbL, aogp, seqbase, S, rA, rs0, h, qc, l, g);
        else attn_quad<0>(ZQ, ZK, VT, AC, rpbL, aogp, seqbase, S, rA, rs0, h, qc, l, g);
        const int r = rA + hq;
        {
            const int ch = 8 * lane; const float* cw = A.in[I_CW];
            f32x4 w0a = *(const f32x4*)(cw + ch), w0b = *(const f32x4*)(cw + ch + 4), w1a = *(const f32x4*)(cw + 512 + ch), w1b = *(const f32x4*)(cw + 512 + ch + 4);
            f32x4 w2a = *(const f32x4*)(cw + 1024 + ch), w2b = *(const f32x4*)(cw + 1024 + ch + 4);
            f32x4 cga = *(const f32x4*)(A.in[I_CON] + ch), cgb = *(const f32x4*)(A.in[I_CON] + ch + 4);
            const int t0 = r * 64 + 8 * wave;
            f32x4 upa, upb, uca, ucb, una, unb;
#define LOAD_U(tt, ua, ub) do { const int t_ = (tt); if (t_ >= 0 && t_ < S) { const v4u x_ = *(const v4u*)(ZC + ((size_t)seqbase + t_) * 1024 + 512 + ch); \
                ua = (f32x4){bflo(x_.x), bfhi(x_.x), bflo(x_.y), bfhi(x_.y)}; ub = (f32x4){bflo(x_.z), bfhi(x_.z), bflo(x_.w), bfhi(x_.w)}; } \
                else { ua = (f32x4){0.f, 0.f, 0.f, 0.f}; ub = ua; } } while (0)
            LOAD_U(t0 - 1, upa, upb); LOAD_U(t0, uca, ucb);
#pragma unroll 2
            for (int i = 0; i < 8; ++i) {
                const int t = t0 + i;
                LOAD_U(t + 1, una, unb);
                const v4u b_ = *(const v4u*)(ZC + ((size_t)seqbase + t) * 1024 + ch);
                const f32x4 gba = (f32x4){bflo(b_.x), bfhi(b_.x), bflo(b_.y), bfhi(b_.y)}, gbb = (f32x4){bflo(b_.z), bfhi(b_.z), bflo(b_.w), bfhi(b_.w)};
                const f32x4 ya = gba * (upa * w0a + uca * w1a + una * w2a), yb = gbb * (upb * w0b + ucb * w1b + unb * w2b);
                float q2 = (ya[0] * ya[0] + ya[1] * ya[1]) + (ya[2] * ya[2] + ya[3] * ya[3]) + (yb[0] * yb[0] + yb[1] * yb[1]) + (yb[2] * yb[2] + yb[3] * yb[3]);
                q2 += __shfl_xor(q2, 1); q2 += __shfl_xor(q2, 2); q2 += __shfl_xor(q2, 4);
                const float rn = __builtin_amdgcn_rsqf(q2 * (1.0f / 64.0f) + EPSF);
                const f32x4 oa = ya * rn * cga, ob = yb * rn * cgb;
                v4u w; w.x = pg8::cvt_pk_bf16(oa[0], oa[1]); w.y = pg8::cvt_pk_bf16(oa[2], oa[3]); w.z = pg8::cvt_pk_bf16(ob[0], ob[1]); w.w = pg8::cvt_pk_bf16(ob[2], ob[3]);
                *(v4u*)(AC + ((size_t)seqbase + t) * 1024 + 512 + ch) = w;
                upa = uca; upb = ucb; uca = una; ucb = unb;
            }
#undef LOAD_U
        }
    }
    __syncthreads();
}

typedef GAS unsigned gu32;
#define XB_TMO      128
#define XB_XCNT(j)  (256  + 64 * (j))
#define XB_XSUB(j)  (1280 + 64 * (j))
#define XB_XGEN(j)  (2304 + 64 * (j))
#define XB_TOP      3328
#define XB_TOPGEN   3392
#define XCD_BAR_WORDS 3456
#define XB_SPIN_CAP (1u << 18)

__device__ __forceinline__ unsigned xb_ld(unsigned* p)              { return __hip_atomic_load(p, __ATOMIC_RELAXED, __HIP_MEMORY_SCOPE_AGENT); }
__device__ __forceinline__ unsigned xb_add(unsigned* p, unsigned v) { return __hip_atomic_fetch_add(p, v, __ATOMIC_RELAXED, __HIP_MEMORY_SCOPE_AGENT); }
__device__ __forceinline__ unsigned xb_xcc_id() { return (unsigned)__builtin_amdgcn_s_getreg((3 << 11) | 20) & 0xFu; }
#define XB_SPIN(cond, bar) do { unsigned _sp = 0; while (cond) { __builtin_amdgcn_s_sleep(1); \
    if ((++_sp & 255u) == 0u) { if (xb_ld(&(bar)[XB_TMO])) break; if (_sp > XB_SPIN_CAP) { atomicAdd(&(bar)[XB_TMO], 1u); break; } } } } while (0)

struct XcdBarrier {
    unsigned* bar; unsigned x;
    volatile LAS unsigned* st;
};

__device__ __forceinline__ XcdBarrier xcd_barrier_post(unsigned* bar, volatile LAS unsigned* st, bool t0) {
    XcdBarrier b; b.bar = bar; b.x = xb_xcc_id(); b.st = st;
    if (t0) (void)xb_add(&bar[XB_XCNT(b.x)], 1u);
    return b;
}
__device__ __forceinline__ void xcd_barrier_complete(unsigned* bar, unsigned x, unsigned& nloc, unsigned& nx) {
    const unsigned G = gridDim.x * gridDim.y * gridDim.z;
    unsigned sum, cnt, mine, sp = 0u;
    for (;;) {
        sum = 0u; cnt = 0u; mine = 0u;
#pragma unroll
        for (unsigned j = 0; j < 16; ++j) { const unsigned c = xb_ld(&bar[XB_XCNT(j)]); sum += c; cnt += (c > 0u) ? 1u : 0u; mine = (j == x) ? c : mine; }
        if (sum == G) break;
        __builtin_amdgcn_s_sleep(1);
        if ((++sp & 255u) == 0u) { if (xb_ld(&bar[XB_TMO])) break; if (sp > XB_SPIN_CAP) { atomicAdd(&bar[XB_TMO], 1u); break; } }
    }
    nloc = mine > 0u ? mine : 1u; nx = cnt > 0u ? cnt : 1u;
}

__device__ __forceinline__ void xcd_barrier(const XcdBarrier& b, bool t0) {
    asm volatile("s_waitcnt vmcnt(0)" ::: "memory");
    __syncthreads();
    if (t0) {
        unsigned* bar = b.bar;
        __builtin_amdgcn_s_waitcnt(0);
        unsigned nloc = b.st[0], nx = b.st[1];
        if (nloc == 0u) { xcd_barrier_complete(bar, b.x, nloc, nx); b.st[0] = nloc; b.st[1] = nx; }
        const unsigned old = xb_add(&bar[XB_XSUB(b.x)], 1u);
        const unsigned gen = old / nloc;
        if (old + 1u == (gen + 1u) * nloc) {
            __builtin_amdgcn_fence(__ATOMIC_RELEASE, "agent");
            asm volatile("s_waitcnt vmcnt(0)" ::: "memory");
            const unsigned og = xb_add(&bar[XB_TOP], 1u);
            const unsigned tg = og / nx;
            if (og + 1u == (tg + 1u) * nx) xb_add(&bar[XB_TOPGEN], 1u);
            else XB_SPIN(xb_ld(&bar[XB_TOPGEN]) == tg, bar);
            __builtin_amdgcn_fence(__ATOMIC_ACQUIRE, "agent");
            xb_add(&bar[XB_XGEN(b.x)], 1u);
            asm volatile("s_waitcnt vmcnt(0)" ::: "memory");
        } else {
            XB_SPIN(xb_ld(&bar[XB_XGEN(b.x)]) == gen, bar);
            __builtin_amdgcn_fence(__ATOMIC_ACQUIRE, "agent");
            asm volatile("s_waitcnt vmcnt(0)" ::: "memory");
        }
    }
    __syncthreads();
}

#ifndef PROBE_DUP
#define PROBE_DUP -1
#endif
__global__ void __launch_bounds__(NWAVES * 64, 2) enc_fwd(Args args) {
    extern __shared__ __attribute__((aligned(16))) unsigned char lds_raw[];
    LAS unsigned char* lds = (LAS unsigned char*)lds_raw;
    cg::grid_group grid = cg::this_grid();
    const int G = gridDim.x; const int bx = blockIdx.x;
    const int vcu = (G % 8 == 0) ? (bx % 8) * (G / 8) + bx / 8 : bx;
    const int NGW = G * NWAVES;
    const int wave = __builtin_amdgcn_readfirstlane((int)threadIdx.x >> 6);
#define FRESH_IDS() int lane_ = (int)__builtin_amdgcn_mbcnt_hi(~0u, __builtin_amdgcn_mbcnt_lo(~0u, 0u)); asm volatile("" : "+v"(lane_)); const int lane = lane_, gw = vcu * NWAVES + wave; (void)gw; (void)lane
    unsigned char* ws = args.ws;
    const int lo = args.ph_lo, hi = args.ph_hi;
#define IN(k) (lo <= (k) && (k) < hi)
    volatile LAS unsigned* MISC = (volatile LAS unsigned*)(lds + RING_BYTES + 1024);
    const bool t0 = (wave == 0) && ((int)__builtin_amdgcn_mbcnt_hi(~0u, __builtin_amdgcn_mbcnt_lo(~0u, 0u)) == 0);
    if (t0) { MISC[0] = 0u; MISC[1] = 0u; }
    __syncthreads();
    XcdBarrier xbar = xcd_barrier_post((unsigned*)(ws + WS_CTL) + 1024, MISC, t0 && (hi - lo) > 1);
#define SEAM(k) do { if (IN(k) && IN((k) + 1)) { if ((k) == 0) grid.sync(); else xcd_barrier(xbar, (wave == 0) && ((int)__builtin_amdgcn_mbcnt_hi(~0u, __builtin_amdgcn_mbcnt_lo(~0u, 0u)) == 0)); } } while (0)
    bf16* XB = (bf16*)(ws + WS_XB); bf16* ACT = (bf16*)(ws + WS_ACT); bf16* ACB = (bf16*)(ws + WS_AC);
    float* SS1 = (float*)(ws + WS_SS1); float* SS2 = (float*)(ws + WS_SS2);

    if (IN(0)) { FRESH_IDS(); p0_prologue(args, lds, gw, NGW, wave, lane); __syncthreads(); }
#if PROBE_DUP == 0
    if (IN(0)) { FRESH_IDS(); p0_prologue(args, lds, gw, NGW, wave, lane); __syncthreads(); }
#endif
    SEAM(0);
    if (IN(1)) { pg8::Gemm g{XB, (const bf16*)(ws + WS_W1GU), M_TOK, NGU, D, wave}; pg8::StaticOrder S; S.init(M_TOK, NGU, G, bx);
        pg8::EpiSwiGLU<false> E{ACT, FF, nullptr};
        pg8::gemm_phase<pg8::EpiSwiGLU<false>, pg8::StaticOrder, true, true>(lds, g, S, E); }
#if PROBE_DUP == 1
    if (IN(1)) { pg8::Gemm g{XB, (const bf16*)(ws + WS_W1GU), M_TOK, NGU, D, wave}; pg8::StaticOrder S; S.init(M_TOK, NGU, G, bx);
        pg8::EpiSwiGLU<false> E{ACT, FF, nullptr};
        pg8::gemm_phase<pg8::EpiSwiGLU<false>, pg8::StaticOrder, true, true>(lds, g, S, E); }
#endif
    SEAM(1);
    if (IN(2)) { pg8::Gemm g{ACT, (const bf16*)(ws + WS_W1D), M_TOK, D, FF, wave}; pg8::RevOrder S; S.init(M_TOK, D, G, bx);
        pg8::EpiResid<2, true> E{args.in[I_F1N], (const float*)(ws + WS_RS0), XB, SS1, 0.5f};
        pg8::gemm_phase<pg8::EpiResid<2, true>, pg8::RevOrder, true, true>(lds, g, S, E); }
#if PROBE_DUP == 2
    if (IN(2)) { pg8::Gemm g{ACT, (const bf16*)(ws + WS_W1D), M_TOK, D, FF, wave}; pg8::RevOrder S; S.init(M_TOK, D, G, bx);
        pg8::EpiResid<2, true> E{args.in[I_F1N], (const float*)(ws + WS_RS0), XB, SS1, 0.5f};
        pg8::gemm_phase<pg8::EpiResid<2, true>, pg8::RevOrder, true, true>(lds, g, S, E); }
#endif
    SEAM(2);
    if (IN(3)) { pg8::Gemm g{XB, (const bf16*)(ws + WS_WIN), M_TOK, DIN, D, wave}; pg8::StaticOrder S; S.init(M_TOK, DIN, G, bx);
        pg8::EpiWin E{SS1, (bf16*)(ws + WS_ZQ), (bf16*)(ws + WS_ZK), (bf16*)(ws + WS_VT), (bf16*)(ws + WS_ZC), args.in[I_QN], args.in[I_KN]};
        pg8::gemm_phase<pg8::EpiWin, pg8::StaticOrder, true, true>(lds, g, S, E); }
#if PROBE_DUP == 3
    if (IN(3)) { pg8::Gemm g{XB, (const bf16*)(ws + WS_WIN), M_TOK, DIN, D, wave}; pg8::StaticOrder S; S.init(M_TOK, DIN, G, bx);
        pg8::EpiWin E{SS1, (bf16*)(ws + WS_ZQ), (bf16*)(ws + WS_ZK), (bf16*)(ws + WS_VT), (bf16*)(ws + WS_ZC), args.in[I_QN], args.in[I_KN]};
        pg8::gemm_phase<pg8::EpiWin, pg8::StaticOrder, true, true>(lds, g, S, E); }
#endif
    SEAM(3);
    if (IN(4)) { FRESH_IDS(); attn_conv_phase(args, lds, wave, lane); }
#if PROBE_DUP == 4
    if (IN(4)) { FRESH_IDS(); attn_conv_phase(args, lds, wave, lane); }
#endif
    SEAM(4);
    if (IN(5)) { pg8::Gemm g{ACB, (const bf16*)(ws + WS_WOUT), M_TOK, D, D, wave}; pg8::StaticOrder S; S.init(M_TOK, D, G, bx);
        pg8::EpiResid<1, true> E{nullptr, nullptr, XB, SS2, 1.0f};
        pg8::gemm_phase<pg8::EpiResid<1, true>, pg8::StaticOrder, true, true>(lds, g, S, E); } SEAM(5);
    if (IN(6)) { pg8::Gemm g{XB, (const bf16*)(ws + WS_W2GU), M_TOK, NGU, D, wave}; pg8::RevOrder S; S.init(M_TOK, NGU, G, bx);
        pg8::EpiSwiGLU<true> E{ACT, FF, SS2};
        pg8::gemm_phase<pg8::EpiSwiGLU<true>, pg8::RevOrder, true, true>(lds, g, S, E); }
#if PROBE_DUP == 6
    if (IN(6)) { pg8::Gemm g{XB, (const bf16*)(ws + WS_W2GU), M_TOK, NGU, D, wave}; pg8::RevOrder S; S.init(M_TOK, NGU, G, bx);
        pg8::EpiSwiGLU<true> E{ACT, FF, SS2};
        pg8::gemm_phase<pg8::EpiSwiGLU<true>, pg8::RevOrder, true, true>(lds, g, S, E); }
#endif
    SEAM(6);
    if (IN(7)) { pg8::Gemm g{ACT, (const bf16*)(ws + WS_W2D), M_TOK, D, FF, wave}; pg8::StaticOrder S; S.init(M_TOK, D, G, bx);
        pg8::EpiResid<1, false> E{nullptr, nullptr, XB, nullptr, 0.5f};
        pg8::gemm_phase<pg8::EpiResid<1, false>, pg8::StaticOrder, true, true>(lds, g, S, E); } SEAM(7);
    if (IN(8)) { FRESH_IDS(); final_norm_phase(args, gw, NGW, lane); }
#undef IN
#undef SEAM
}

#ifndef MK_N_LAUNCHES
#define MK_N_LAUNCHES 1
#endif
extern "C" void kernel_launch(void* const* d_in, const int* in_sizes, int n_in, void* d_out, int out_size, void* d_ws, size_t ws_size, hipStream_t stream) {
    static int grid = 0;
    if (grid == 0) {
        if (n_in != 20 || in_sizes[0] != MP * D || out_size != M_TOK * D || ws_size < WS_END) { fprintf(stderr, "kernel_launch: unexpected shapes (n_in %d, in0 %d, out %d, ws %zu)\n", n_in, n_in > 0 ? in_sizes[0] : -1, out_size, ws_size); grid = -1; return; }
        int dev = 0, cus = 0, per_cu = 0;
        if (hipGetDevice(&dev) != hipSuccess || hipDeviceGetAttribute(&cus, hipDeviceAttributeMultiprocessorCount, dev) != hipSuccess) { grid = -1; return; }
        if (hipFuncSetAttribute((const void*)enc_fwd, hipFuncAttributeMaxDynamicSharedMemorySize, LDS_BYTES) != hipSuccess) { fprintf(stderr, "kernel_launch: hipFuncSetAttribute failed\n"); grid = -1; return; }
        if (hipOccupancyMaxActiveBlocksPerMultiprocessor(&per_cu, (const void*)enc_fwd, NWAVES * 64, LDS_BYTES) != hipSuccess || per_cu < 1) { fprintf(stderr, "kernel_launch: occupancy query says %d\n", per_cu); per_cu = 1; }
        (void)hipGetLastError();
        if (cus * per_cu < 256) { fprintf(stderr, "kernel_launch: needs 256 co-resident workgroups, device offers %d\n", cus * per_cu); grid = -1; return; }
        grid = 256;
    }
    if (grid < 0) return;
    if (hipMemsetAsync((char*)d_ws + WS_CTL, 0, CTL_ZERO_BYTES, stream) != hipSuccess) { fprintf(stderr, "kernel_launch: memset failed\n"); return; }
    Args a{};
    for (int i = 0; i < 20; ++i) a.in[i] = (const float*)d_in[i];
    a.out = (float*)d_out; a.ws = (unsigned char*)d_ws;
#if MK_N_LAUNCHES == 1
    a.ph_lo = 0; a.ph_hi = 9;
    void* kargs[] = {&a};
    hipError_t e = hipLaunchCooperativeKernel((const void*)enc_fwd, dim3(grid), dim3(NWAVES * 64), kargs, LDS_BYTES, stream);
    if (e != hipSuccess) fprintf(stderr, "kernel_launch: cooperative launch failed: %s (grid %d)\n", hipGetErrorString(e), grid);
#else
    for (int p = 0; p < 9; ++p) {
        a.ph_lo = p; a.ph_hi = p + 1;
        hipLaunchKernelGGL(enc_fwd, dim3(grid), dim3(NWAVES * 64), LDS_BYTES, stream, a);
    }
#endif
}
```

```cpp
#include <hip/hip_runtime.h>
#include <hip/hip_cooperative_groups.h>
#include <cstdio>
#include <cstdint>
#include <cmath>
namespace cg = cooperative_groups;
namespace pg8 {
#define PG8_LAS __attribute__((address_space(3)))
typedef unsigned short bf16_t;
typedef short bf16x8 __attribute__((ext_vector_type(8)));
typedef float f32x4 __attribute__((ext_vector_type(4)));
typedef unsigned u32x4 __attribute__((ext_vector_type(4)));
constexpr int BM = 256, BK = 64, HALF = 128, HTB = HALF * BK * 2  , STAGE_BYTES = 8 * HTB, NXCD = 8, WGM = 8;

__host__ __device__ __forceinline__ int lds_byte(int r, int c) { const int st = (r >> 4) * 2 + (c >> 5), rr = r & 15, cc = c & 31, ob = rr * 64 + cc * 2; return st * 1024 + (ob ^ (((ob >> 9) & 1) << 5)); }
__host__ __device__ __forceinline__ void stage_rc(int b, int& R, int& C) { const int st = b / 1024, sb = b % 1024, swz = sb ^ (((sb >> 9) & 1) << 5); R = (st >> 1) * 16 + swz / 64; C = (st & 1) * 32 + (swz % 64) / 2; }
__host__ __device__ __forceinline__ int perm32(int rho) { const int n = rho >> 4, i = rho & 15; return 8 * (i >> 2) + 4 * n + (i & 3); }

struct Unit { int pm, pn; };
struct Gemm { const bf16_t* A; const bf16_t* Bt; int M, N, K, wid; };

struct StaticOrder {
    int nM, nN, nwg, G, c;
    __host__ __device__ void init(int M, int N, int G_, int c_) { nM = M / BM; nN = N / BM; nwg = nM * nN; G = G_; c = c_; }
    __host__ __device__ bool next(int i, Unit& u) const {
        const long L = (long)i * G + c; if (L >= nwg) return false;
        int wgid = (int)L; { const int q = nwg / NXCD, r = nwg % NXCD, xcd = wgid % NXCD, off = wgid / NXCD; wgid = (xcd < r ? xcd * (q + 1) : r * (q + 1) + (xcd - r) * q) + off; }
        const int nig = WGM * nN, gid = wgid / nig, fm = gid * WGM, gsz = (nM - fm) < WGM ? (nM - fm) : WGM;
        u.pm = fm + ((wgid % nig) % gsz); u.pn = (wgid % nig) / gsz; return true;
    }
    __device__ __forceinline__ void a_ready(const Unit&) const {}
    __device__ __forceinline__ void done(const Unit&) const {}
};
struct RevOrder : StaticOrder {
    __host__ __device__ bool next(int i, Unit& u) const { if (!StaticOrder::next(i, u)) return false; if (nM == 320) u.pm = 40 * (u.pm / 40) + 39 - (u.pm % 40); return true; }
};
__device__ __forceinline__ unsigned cvt_pk_bf16(float lo, float hi) { unsigned r; asm volatile("v_cvt_pk_bf16_f32 %0, %1, %2" : "=v"(r) : "v"(lo), "v"(hi)); return r; }
typedef float f32x2 __attribute__((ext_vector_type(2)));
constexpr float RMS_EPS = 1e-6f;
typedef unsigned u32x2 __attribute__((ext_vector_type(2)));
__device__ __forceinline__ float row_rstd16(const float* ssrow) {
    const f32x4 a = *(const f32x4*)(ssrow), b = *(const f32x4*)(ssrow + 4), c = *(const f32x4*)(ssrow + 8), d = *(const f32x4*)(ssrow + 12);
    const float s = ((a[0] + a[1]) + (a[2] + a[3])) + ((b[0] + b[1]) + (b[2] + b[3])) + ((c[0] + c[1]) + (c[2] + c[3])) + ((d[0] + d[1]) + (d[2] + d[3]));
    return __builtin_amdgcn_rsqf(s * (1.0f / 1024.0f) + RMS_EPS);
}
__device__ __forceinline__ float row_rstd16_coop(const float* ssrow, int fq) {
    const f32x4 a = *(const f32x4*)(ssrow + 4 * fq);
    float s = (a[0] + a[1]) + (a[2] + a[3]);
    s += __shfl_xor(s, 16); s += __shfl_xor(s, 32);
    return __builtin_amdgcn_rsqf(s * (1.0f / 1024.0f) + RMS_EPS);
}
__device__ __forceinline__ float silu_mul(float gl, float ul) { return gl * ul * __builtin_amdgcn_rcpf(1.0f + __builtin_amdgcn_exp2f(-gl)); }
__device__ __forceinline__ unsigned silu_mul_pk(f32x2 gl, f32x2 ul) {
    f32x2 e; e.x = __builtin_amdgcn_exp2f(-gl.x); e.y = __builtin_amdgcn_exp2f(-gl.y);
    const f32x2 d = e + 1.0f;
    f32x2 r; r.x = __builtin_amdgcn_rcpf(d.x); r.y = __builtin_amdgcn_rcpf(d.y);
    const f32x2 o = (gl * ul) * r;
    return cvt_pk_bf16(o.x, o.y);
}

template <bool HAS_RSTD> struct EpiSwiGLU {
    static constexpr bool PERM = true, AFTER_DRAIN = false;
    bf16_t* O; int ldc; const float* ss;
    __device__ __forceinline__ void operator()(const f32x4 (&acc)[2][2][4][2], const Unit& u, int wr, int wc, int fr, int fq) const {
        const int row0 = u.pm * BM + wr * 64 + fr, col0 = u.pn * HALF + wc * 32 + 8 * fq;
        float rsv[8];
#pragma unroll
        for (int i = 0; i < 8; ++i) rsv[i] = HAS_RSTD ? row_rstd16_coop(ss + (size_t)(row0 + (i >> 2) * HALF + (i & 3) * 16) * 16, fq) : 1.0f;
#pragma unroll
        for (int ai = 0; ai < 2; ++ai)
#pragma unroll
            for (int m = 0; m < 4; ++m) {
                const int row = row0 + ai * HALF + m * 16;
                const float rs = rsv[ai * 4 + m];
                const f32x4 g0 = acc[ai][0][m][0] * rs, g1 = acc[ai][0][m][1] * rs, u0 = acc[ai][1][m][0] * rs, u1 = acc[ai][1][m][1] * rs;
                u32x4 w;
                w.x = silu_mul_pk((f32x2){g0[0], g0[1]}, (f32x2){u0[0], u0[1]}); w.y = silu_mul_pk((f32x2){g0[2], g0[3]}, (f32x2){u0[2], u0[3]});
                w.z = silu_mul_pk((f32x2){g1[0], g1[1]}, (f32x2){u1[0], u1[1]}); w.w = silu_mul_pk((f32x2){g1[2], g1[3]}, (f32x2){u1[2], u1[3]});
                *(u32x4*)(O + (size_t)row * ldc + col0) = w;
            }
    }
};

__device__ __forceinline__ u32x4 xchg8(u32x4 v) {
    u32x4 r;
    r.x = (unsigned)__builtin_amdgcn_update_dpp(0, (int)v.x, 0x128, 0xf, 0xf, false); r.y = (unsigned)__builtin_amdgcn_update_dpp(0, (int)v.y, 0x128, 0xf, 0xf, false);
    r.z = (unsigned)__builtin_amdgcn_update_dpp(0, (int)v.z, 0x128, 0xf, 0xf, false); r.w = (unsigned)__builtin_amdgcn_update_dpp(0, (int)v.w, 0x128, 0xf, 0xf, false);
    return r;
}
__device__ __forceinline__ void store_rows16(bf16_t* base, int ld, u32x4 w0, u32x4 w1, int fr, int fq) {
    const bool hi = (fr & 8) != 0;
    const u32x4 rcv = xchg8(hi ? w0 : w1);
    bf16_t* p = base + (size_t)(fr & 7) * ld + (hi ? 32 : 0) + 8 * fq;
    *(u32x4*)p = hi ? rcv : w0; *(u32x4*)(p + (size_t)8 * ld) = hi ? w1 : rcv;
}
__device__ __forceinline__ void load_rows16_issue(const bf16_t* base, int ld, int fr, int fq, u32x4& la, u32x4& lb) {
    const bf16_t* p = base + (size_t)(fr & 7) * ld + ((fr & 8) ? 32 : 0) + 8 * fq;
    la = *(const u32x4*)p; lb = *(const u32x4*)(p + (size_t)8 * ld);
}
__device__ __forceinline__ void load_rows16_finish(u32x4 la, u32x4 lb, int fr, u32x4& r0, u32x4& r1) {
    const bool hi = (fr & 8) != 0;
    const u32x4 rcv = xchg8(hi ? la : lb);
    r0 = hi ? rcv : la; r1 = hi ? lb : rcv;
}

template <int RES_MODE, bool WRITE_SS> struct EpiResid {
    static constexpr bool PERM = true, AFTER_DRAIN = false;
    const float* g; const float* rstd0;
    bf16_t* xb; float* ss; float alpha;
    __device__ __forceinline__ void operator()(const f32x4 (&acc)[2][2][4][2], const Unit& u, int wr, int wc, int fr, int fq) const {
        const int rowg = u.pm * BM + wr * 64, colw = u.pn * BM + wc * 64;
        f32x4 gi[2][2]; float ri[8];
        if (RES_MODE == 2) {
#pragma unroll
            for (int bj = 0; bj < 2; ++bj)
#pragma unroll
                for (int n = 0; n < 2; ++n) { const f32x4 gv = *(const f32x4*)(g + colw + 32 * bj + 8 * fq + 4 * n); gi[bj][n] = (f32x4){__builtin_amdgcn_rcpf(gv[0]), __builtin_amdgcn_rcpf(gv[1]), __builtin_amdgcn_rcpf(gv[2]), __builtin_amdgcn_rcpf(gv[3])}; }
#pragma unroll
            for (int i = 0; i < 8; ++i) ri[i] = __builtin_amdgcn_rcpf(rstd0[rowg + (i >> 2) * HALF + (i & 3) * 16 + fr]);
        }
        bf16_t* xw = xb + (size_t)rowg * 1024 + colw;
        u32x4 la[2][4], lb[2][4];
#pragma unroll
        for (int ai = 0; ai < 2; ++ai)
#pragma unroll
            for (int m = 0; m < 4; ++m) load_rows16_issue(xw + (size_t)(ai * HALF + m * 16) * 1024, 1024, fr, fq, la[ai][m], lb[ai][m]);
#pragma unroll
        for (int ai = 0; ai < 2; ++ai)
#pragma unroll
            for (int m = 0; m < 4; ++m) {
                u32x4 q[2]; load_rows16_finish(la[ai][m], lb[ai][m], fr, q[0], q[1]);
                u32x4 w[2]; float s = 0.f;
#pragma unroll
                for (int bj = 0; bj < 2; ++bj) {
                    f32x4 r0 = (f32x4){__builtin_bit_cast(float, q[bj].x << 16), __builtin_bit_cast(float, q[bj].x & 0xffff0000u), __builtin_bit_cast(float, q[bj].y << 16), __builtin_bit_cast(float, q[bj].y & 0xffff0000u)};
                    f32x4 r1 = (f32x4){__builtin_bit_cast(float, q[bj].z << 16), __builtin_bit_cast(float, q[bj].z & 0xffff0000u), __builtin_bit_cast(float, q[bj].w << 16), __builtin_bit_cast(float, q[bj].w & 0xffff0000u)};
                    if (RES_MODE == 2) { r0 = r0 * gi[bj][0] * ri[ai * 4 + m]; r1 = r1 * gi[bj][1] * ri[ai * 4 + m]; }
                    const f32x4 v0 = r0 + acc[ai][bj][m][0] * alpha, v1 = r1 + acc[ai][bj][m][1] * alpha;
                    w[bj].x = cvt_pk_bf16(v0[0], v0[1]); w[bj].y = cvt_pk_bf16(v0[2], v0[3]); w[bj].z = cvt_pk_bf16(v1[0], v1[1]); w[bj].w = cvt_pk_bf16(v1[2], v1[3]);
                    if (WRITE_SS) s += (v0[0] * v0[0] + v0[1] * v0[1]) + (v0[2] * v0[2] + v0[3] * v0[3]) + (v1[0] * v1[0] + v1[1] * v1[1]) + (v1[2] * v1[2] + v1[3] * v1[3]);
                }
                store_rows16(xw + (size_t)(ai * HALF + m * 16) * 1024, 1024, w[0], w[1], fr, fq);
                if (WRITE_SS) { s += __shfl_xor(s, 16); s += __shfl_xor(s, 32); if (fq == 0) ss[(size_t)(rowg + ai * HALF + m * 16 + fr) * 16 + u.pn * 4 + wc] = s; }
            }
    }
};

struct EpiWin {
    static constexpr bool PERM = true, AFTER_DRAIN = false;
    const float* ss; bf16_t *ZQ, *ZK, *VT, *ZC; const float *qg, *kg;
    __device__ __forceinline__ void operator()(const f32x4 (&acc)[2][2][4][2], const Unit& u, int wr, int wc, int fr, int fq) const {
        const int row0 = u.pm * BM + wr * 64 + fr, pn = u.pn;
        float rsv[8];
#pragma unroll
        for (int i = 0; i < 8; ++i) rsv[i] = row_rstd16_coop(ss + (size_t)(row0 + (i >> 2) * HALF + (i & 3) * 16) * 16, fq);
        if (pn < 4) {
            const bool isq = pn < 2; const float* gp = (isq ? qg : kg) + 8 * fq; const float gs = isq ? 0.125f * 1.4426950408889634f : 1.0f;
            f32x4 gn[2][2];
#pragma unroll
            for (int bj = 0; bj < 2; ++bj)
#pragma unroll
                for (int n = 0; n < 2; ++n) gn[bj][n] = *(const f32x4*)(gp + 32 * bj + 4 * n) * gs;
            bf16_t* Z = (isq ? ZQ : ZK) + (pn & 1) * 256 + wc * 64 + (size_t)(u.pm * BM + wr * 64) * 512;
#pragma unroll
            for (int ai = 0; ai < 2; ++ai)
#pragma unroll
                for (int m = 0; m < 4; ++m) {
                    const int row = row0 + ai * HALF + m * 16; const float rs = rsv[ai * 4 + m];
                    f32x4 v[2][2]; float s = 0.f;
#pragma unroll
                    for (int bj = 0; bj < 2; ++bj)
#pragma unroll
                        for (int n = 0; n < 2; ++n) { v[bj][n] = acc[ai][bj][m][n] * rs; const f32x4 x = v[bj][n]; s += (x[0] * x[0] + x[1] * x[1]) + (x[2] * x[2] + x[3] * x[3]); }
                    s += __shfl_xor(s, 16); s += __shfl_xor(s, 32);
                    const float rn = __builtin_amdgcn_rsqf(s * (1.0f / 64.0f) + RMS_EPS);
                    u32x4 w[2];
#pragma unroll
                    for (int bj = 0; bj < 2; ++bj) {
                        const f32x4 a = v[bj][0] * gn[bj][0] * rn, b = v[bj][1] * gn[bj][1] * rn;
                        w[bj].x = cvt_pk_bf16(a[0], a[1]); w[bj].y = cvt_pk_bf16(a[2], a[3]); w[bj].z = cvt_pk_bf16(b[0], b[1]); w[bj].w = cvt_pk_bf16(b[2], b[3]);
                    }
                    store_rows16(Z + (size_t)(ai * HALF + m * 16) * 512, 512, w[0], w[1], fr, fq);
                }
        } else if (pn < 6) {
            const int rowt = u.pm * BM; const int S = (rowt < 65536) ? 2048 : 4096; const int h = 4 * (pn - 4) + wc;
#pragma unroll
            for (int ai = 0; ai < 2; ++ai)
#pragma unroll
                for (int m = 0; m < 4; ++m) {
                    const int row = row0 + ai * HALF + m * 16; const float rs = rsv[ai * 4 + m];
                    const int t = row & (S - 1); bf16_t* vp = VT + (size_t)(row - t) * 512 + (size_t)(h * 64 + 8 * fq) * S + t;
#pragma unroll
                    for (int bj = 0; bj < 2; ++bj)
#pragma unroll
                        for (int n = 0; n < 2; ++n) {
                            const f32x4 x = acc[ai][bj][m][n] * rs; const unsigned p0 = cvt_pk_bf16(x[0], x[1]), p1 = cvt_pk_bf16(x[2], x[3]);
                            bf16_t* q = vp + (size_t)(32 * bj + 4 * n) * S;
                            q[0] = (bf16_t)(p0 & 0xffffu); q[(size_t)S] = (bf16_t)(p0 >> 16); q[(size_t)2 * S] = (bf16_t)(p1 & 0xffffu); q[(size_t)3 * S] = (bf16_t)(p1 >> 16);
                        }
                }
        } else if (pn < 8) {
            bf16_t* Z = ZC + (pn - 6) * 256 + wc * 64 + (size_t)(u.pm * BM + wr * 64) * 1024;
#pragma unroll
            for (int ai = 0; ai < 2; ++ai)
#pragma unroll
                for (int m = 0; m < 4; ++m) {
                    const float rs = rsv[ai * 4 + m];
                    u32x4 w[2];
#pragma unroll
                    for (int bj = 0; bj < 2; ++bj) {
                        const f32x4 a = acc[ai][bj][m][0] * rs, b = acc[ai][bj][m][1] * rs;
                        w[bj].x = cvt_pk_bf16(a[0], a[1]); w[bj].y = cvt_pk_bf16(a[2], a[3]); w[bj].z = cvt_pk_bf16(b[0], b[1]); w[bj].w = cvt_pk_bf16(b[2], b[3]);
                    }
                    store_rows16(Z + (size_t)(ai * HALF + m * 16) * 1024, 1024, w[0], w[1], fr, fq);
                }
        } else {
            bf16_t* Z = ZC + 512 + (pn - 8) * 128 + wc * 32 + 8 * fq + (size_t)row0 * 1024;
#pragma unroll
            for (int ai = 0; ai < 2; ++ai)
#pragma unroll
                for (int m = 0; m < 4; ++m) {
                    const float rs = rsv[ai * 4 + m], rs2 = rs * rs;
                    const f32x4 a = acc[ai][0][m][0] * acc[ai][1][m][0] * rs2, b = acc[ai][0][m][1] * acc[ai][1][m][1] * rs2;
                    u32x4 w; w.x = cvt_pk_bf16(a[0], a[1]); w.y = cvt_pk_bf16(a[2], a[3]); w.z = cvt_pk_bf16(b[0], b[1]); w.w = cvt_pk_bf16(b[2], b[3]);
                    *(u32x4*)(Z + (size_t)(ai * HALF + m * 16) * 1024) = w;
                }
        }
    }
};

template <class Epi, class Sched, bool ALIGN_EPI = false, bool SP2 = false>
__device__ __forceinline__ void gemm_phase(PG8_LAS unsigned char* lds, const Gemm g, const Sched& S, const Epi& E) {
    const int wid = g.wid, lane = (int)__builtin_amdgcn_mbcnt_hi(~0u, __builtin_amdgcn_mbcnt_lo(~0u, 0u)), tid = wid * 64 + lane, wr = wid >> 2, wc = wid & 3, fr = lane & 15, fq = lane >> 4;
    const int K = g.K, nt = K / BK;
    unsigned voffA[2], voffB[2];
#pragma unroll
    for (int i = 0; i < 2; ++i) { int R, C; stage_rc(tid * 16 + i * 8192, R, C); const int Rb = Epi::PERM ? ((R & ~31) + perm32(R & 31)) : R;
        voffA[i] = (unsigned)(R * K + C) * 2u; voffB[i] = (unsigned)(Rb * K + C) * 2u; }
    const size_t kstep = (size_t)(BK * 2);
    const size_t hstep = (size_t)HALF * K * 2;
    const size_t tstep = 2 * hstep;
    const unsigned ldsw = (unsigned)wid * 1024u;
    const int aoff = lds_byte(wr * 64 + fr, fq * 8), boff = lds_byte(wc * 32 + fr, fq * 8);
#define PG8_SA(b, h) (((b) * 2 + (h)) * HTB)
#define PG8_SB(b, h) ((4 + (b) * 2 + (h)) * HTB)
#define PG8_STAGE(bufoff, gbase, voff) do { _Pragma("unroll") for (int _i = 0; _i < 2; ++_i) \
        __builtin_amdgcn_global_load_lds((const unsigned*)((const char*)(gbase) + (voff)[_i]), (PG8_LAS unsigned*)(lds + (bufoff) + ldsw + _i * 8192), 16, 0, 0); } while (0)
#define PG8_LDA(dst, b, h) do { _Pragma("unroll") for (int m = 0; m < 4; ++m) _Pragma("unroll") for (int k = 0; k < 2; ++k) dst[m][k] = *(const PG8_LAS bf16x8*)(lds + PG8_SA(b, h) + aoff + m * 2048 + k * 1024); } while (0)
#define PG8_LDB(dst, b, h) do { _Pragma("unroll") for (int n = 0; n < 2; ++n) _Pragma("unroll") for (int k = 0; k < 2; ++k) dst[n][k] = *(const PG8_LAS bf16x8*)(lds + PG8_SB(b, h) + boff + n * 2048 + k * 1024); } while (0)
#define PG8_MMA(ai, bj, At, Bt) do { __builtin_amdgcn_s_setprio(1); _Pragma("unroll") for (int m = 0; m < 4; ++m) _Pragma("unroll") for (int n = 0; n < 2; ++n) _Pragma("unroll") for (int k = 0; k < 2; ++k) \
        acc[ai][bj][m][n] = __builtin_amdgcn_mfma_f32_16x16x32_bf16(Bt[n][k], At[m][k], acc[ai][bj][m][n], 0, 0, 0); __builtin_amdgcn_s_setprio(0); } while (0)
#define PG8_WAIT_V(n) asm volatile("s_waitcnt vmcnt(" #n ")" ::: "memory")
#define PG8_WAIT_L(n) asm volatile("s_waitcnt lgkmcnt(" #n ")" ::: "memory")
#define PG8_BAR __builtin_amdgcn_s_barrier()
#define PG8_SCHED __builtin_amdgcn_sched_barrier(0)
    Unit cur, nxt; int ui = 0;
    if (!S.next(0, cur)) return;
    f32x4 acc[2][2][4][2];
#pragma unroll
    for (int a = 0; a < 2; ++a)
#pragma unroll
        for (int b = 0; b < 2; ++b)
#pragma unroll
            for (int m = 0; m < 4; ++m)
#pragma unroll
                for (int n = 0; n < 2; ++n) acc[a][b][m][n] = (f32x4){0.f, 0.f, 0.f, 0.f};
    bf16x8 At[4][2], B0[2][2], B1[2][2];
    const char* cA = (const char*)g.A + (size_t)cur.pm * tstep; const char* cB = (const char*)g.Bt + (size_t)cur.pn * tstep;
    S.a_ready(cur);
    if constexpr (SP2) {
        PG8_STAGE(PG8_SB(0, 0), cB, voffB); PG8_STAGE(PG8_SB(0, 1), cB + hstep, voffB); PG8_STAGE(PG8_SA(0, 0), cA, voffA); PG8_STAGE(PG8_SA(0, 1), cA + hstep, voffA);
        if (wr == 1) PG8_BAR;
        PG8_WAIT_V(2); PG8_BAR;
        PG8_STAGE(PG8_SB(1, 0), cB + kstep, voffB); PG8_STAGE(PG8_SA(1, 0), cA + kstep, voffA); PG8_STAGE(PG8_SB(1, 1), cB + hstep + kstep, voffB);
        PG8_WAIT_V(6); PG8_BAR;
    } else {
        PG8_STAGE(PG8_SB(0, 0), cB, voffB); PG8_STAGE(PG8_SA(0, 0), cA, voffA); PG8_STAGE(PG8_SB(0, 1), cB + hstep, voffB); PG8_STAGE(PG8_SA(0, 1), cA + hstep, voffA);
        if (wr == 1) PG8_BAR;
        PG8_WAIT_V(4); PG8_BAR;
        PG8_STAGE(PG8_SB(1, 0), cB + kstep, voffB); PG8_STAGE(PG8_SA(1, 0), cA + kstep, voffA); PG8_STAGE(PG8_SB(1, 1), cB + hstep + kstep, voffB);
        PG8_WAIT_V(6); PG8_BAR;
    }
    for (;;) {
        const bool has_next = S.next(ui + 1, nxt);
        const char* nA = has_next ? (const char*)g.A + (size_t)nxt.pm * tstep : cA; const char* nB = has_next ? (const char*)g.Bt + (size_t)nxt.pn * tstep : cB;
        for (int t = 0; t < nt; t += 2) {
            const bool last = (t == nt - 2);
            const char* a1 = cA + (size_t)(t + 1) * kstep;
            const char* a2 = last ? nA : cA + (size_t)(t + 2) * kstep; const char* b2 = last ? nB : cB + (size_t)(t + 2) * kstep;
            const char* a3 = a2 + kstep; const char* b3 = b2 + kstep;
            if (last && has_next) S.a_ready(nxt);
            if constexpr (SP2) {
            PG8_LDB(B0, 0, 0); PG8_LDB(B1, 0, 1); PG8_SCHED; PG8_LDA(At, 0, 0); PG8_STAGE(PG8_SA(1, 1), a1 + hstep, voffA);
            PG8_WAIT_V(8); PG8_WAIT_L(0); PG8_BAR; PG8_MMA(0, 0, At, B0); PG8_MMA(0, 1, At, B1); PG8_BAR; PG8_SCHED;
            PG8_LDA(At, 0, 1); PG8_STAGE(PG8_SB(0, 0), b2, voffB); PG8_STAGE(PG8_SB(0, 1), b2 + hstep, voffB); PG8_STAGE(PG8_SA(0, 0), a2, voffA);
            PG8_WAIT_V(8); PG8_WAIT_L(0); PG8_BAR; PG8_MMA(1, 0, At, B0); PG8_MMA(1, 1, At, B1); PG8_BAR; PG8_SCHED;
            PG8_LDB(B0, 1, 0); PG8_LDB(B1, 1, 1); PG8_SCHED; PG8_LDA(At, 1, 0); PG8_STAGE(PG8_SA(0, 1), a2 + hstep, voffA);
            PG8_WAIT_V(8); PG8_WAIT_L(0); PG8_BAR; PG8_MMA(0, 0, At, B0); PG8_MMA(0, 1, At, B1); PG8_BAR; PG8_SCHED;
            PG8_LDA(At, 1, 1); PG8_STAGE(PG8_SB(1, 0), b3, voffB); PG8_STAGE(PG8_SB(1, 1), b3 + hstep, voffB); PG8_STAGE(PG8_SA(1, 0), a3, voffA);
            PG8_WAIT_V(8); PG8_WAIT_L(0); PG8_BAR; PG8_MMA(1, 0, At, B0); PG8_MMA(1, 1, At, B1); PG8_BAR; PG8_SCHED;
            } else {
            PG8_LDB(B0, 0, 0); PG8_SCHED; PG8_LDA(At, 0, 0); PG8_STAGE(PG8_SA(1, 1), a1 + hstep, voffA);
            PG8_WAIT_L(8); PG8_BAR; PG8_WAIT_L(0); PG8_MMA(0, 0, At, B0); PG8_BAR; PG8_SCHED;
            PG8_LDB(B1, 0, 1); PG8_STAGE(PG8_SB(0, 0), b2, voffB);
            PG8_BAR; PG8_WAIT_L(0); PG8_MMA(0, 1, At, B1); PG8_BAR;
            PG8_LDA(At, 0, 1); PG8_STAGE(PG8_SA(0, 0), a2, voffA);
            PG8_BAR; PG8_WAIT_L(0); PG8_MMA(1, 0, At, B0); PG8_BAR; PG8_SCHED;
            PG8_STAGE(PG8_SB(0, 1), b2 + hstep, voffB);
            PG8_WAIT_V(6); PG8_BAR; PG8_MMA(1, 1, At, B1); PG8_BAR;
            PG8_LDB(B0, 1, 0); PG8_SCHED; PG8_LDA(At, 1, 0); PG8_STAGE(PG8_SA(0, 1), a2 + hstep, voffA);
            PG8_WAIT_L(8); PG8_BAR; PG8_WAIT_L(0); PG8_MMA(0, 0, At, B0); PG8_BAR; PG8_SCHED;
            PG8_LDB(B1, 1, 1); PG8_STAGE(PG8_SB(1, 0), b3, voffB);
            PG8_BAR; PG8_WAIT_L(0); PG8_MMA(0, 1, At, B1); PG8_BAR;
            PG8_LDA(At, 1, 1); PG8_STAGE(PG8_SA(1, 0), a3, voffA);
            PG8_BAR; PG8_WAIT_L(0); PG8_MMA(1, 0, At, B0); PG8_BAR; PG8_SCHED;
            PG8_STAGE(PG8_SB(1, 1), b3 + hstep, voffB);
            PG8_WAIT_V(6); PG8_BAR; PG8_MMA(1, 1, At, B1); PG8_BAR;
            }
        }
        if constexpr (ALIGN_EPI) { if (wr == 0) PG8_BAR; }
        if constexpr (!Epi::AFTER_DRAIN) { E(acc, cur, wr, wc, fr, fq); S.done(cur); }
        if (!has_next) break;
#pragma unroll
        for (int a = 0; a < 2; ++a)
#pragma unroll
            for (int b = 0; b < 2; ++b)
#pragma unroll
                for (int m = 0; m < 4; ++m)
#pragma unroll
                    for (int n = 0; n < 2; ++n) acc[a][b][m][n] = (f32x4){0.f, 0.f, 0.f, 0.f};
        cur = nxt; cA = nA; cB = nB; ++ui;
        if constexpr (ALIGN_EPI) { if (wr == 1) PG8_BAR; }
    }
    PG8_WAIT_V(0);
    if constexpr (!ALIGN_EPI) { if (wr == 0) PG8_BAR; }
    PG8_BAR;
    if constexpr (Epi::AFTER_DRAIN) { E.fused(acc, cur, wr, wc, fr, fq, lds, wid, lane); S.done(cur); }
#undef PG8_SA
#undef PG8_SB
#undef PG8_STAGE
#undef PG8_LDA
#undef PG8_LDB
#undef PG8_MMA
#undef PG8_WAIT_V
#undef PG8_WAIT_L
#undef PG8_BAR
#undef PG8_SCHED
}
}
#define GAS __attribute__((address_space(1)))
#define LAS __attribute__((address_space(3)))
typedef unsigned short bf16;
typedef unsigned v4u __attribute__((ext_vector_type(4)));
typedef unsigned v2u __attribute__((ext_vector_type(2)));
typedef float f32x4 __attribute__((ext_vector_type(4)));
typedef short bf16x8 __attribute__((ext_vector_type(8)));
typedef short s16x4 __attribute__((ext_vector_type(4)));
#define LDS_WAIT() asm volatile("s_waitcnt lgkmcnt(0)" ::: "memory")

constexpr int NWAVES = 8;
constexpr int M_TOK = 81920, MP = 65536, D = 1024, FF = 2816, NGU = 2 * FF, DIN = 3072;
constexpr float EPSF = 1e-6f;
constexpr size_t MiB = 1u << 20;
constexpr size_t WS_CTL = 0, CTL_ZERO_BYTES = 65536;
constexpr size_t WS_W1GU = 1 * MiB, WS_W1D = 12 * MiB, WS_WIN = 18 * MiB, WS_WOUT = 24 * MiB, WS_W2GU = 26 * MiB, WS_W2D = 37 * MiB;
constexpr size_t WS_SS1 = 44 * MiB, WS_SS2 = 50 * MiB, WS_RS0 = 56 * MiB;
constexpr size_t WS_XB = 64 * MiB;
constexpr size_t WS_ACT = 224 * MiB;
constexpr size_t WS_ZQ = WS_ACT, WS_ZK = WS_ACT + 80 * MiB, WS_VT = WS_ACT + 160 * MiB, WS_ZC = WS_ACT + 240 * MiB;
constexpr size_t WS_AC = 704 * MiB;
constexpr size_t WS_END = 864 * MiB;
constexpr int RING_BYTES = 131072, LDS_BYTES = 147456;

__device__ __forceinline__ unsigned f2bf(float f) { unsigned u = __builtin_bit_cast(unsigned, f); return (u + 0x7fffu + ((u >> 16) & 1u)) >> 16; }
__device__ __forceinline__ unsigned pk2(float lo, float hi) { return pg8::cvt_pk_bf16(lo, hi); }
__device__ __forceinline__ float bflo(unsigned w) { return __builtin_bit_cast(float, w << 16); }
__device__ __forceinline__ float bfhi(unsigned w) { return __builtin_bit_cast(float, w & 0xffff0000u); }
__device__ __forceinline__ float wave_sum(float v) {
#pragma unroll
    for (int o = 1; o < 64; o <<= 1) v += __shfl_xor(v, o);
    return v;
}

__device__ __forceinline__ void p0_transpose_item(const float* W, int K, int N, bf16* WT, const float* gain, int kind, LAS float* scr, int item, int lane) {
    const int nblk = N / 32, kb = item / nblk, nb = item % nblk, k0 = 64 * kb, n0 = 32 * nb;
    int rowbase = n0;
    const float kscale = (kind == 1) ? 1.4426950408889634f : (kind == 2) ? 0.6931471805599453f : 1.0f;
    if (kind == 1) rowbase = (n0 >> 7) * 256 + (n0 & 127);
    else if (kind == 2) rowbase = (n0 >> 7) * 256 + 128 + (n0 & 127);
    else if (kind == 3 || (kind == 4 && n0 < 2048)) rowbase = (n0 & ~255) + 128 * ((n0 >> 5) & 1) + 32 * ((n0 >> 6) & 3);
    else if (kind == 4) { const int isx = n0 >= 2560, ch0 = (n0 - 2048) & 511; rowbase = 256 * (8 + (ch0 >> 7)) + 128 * isx + 32 * ((ch0 >> 5) & 3); }
#pragma unroll 8
    for (int i = 0; i < 32; ++i) { const int kk = 2 * i + (lane >> 5); const float g = (gain ? gain[k0 + kk] : 1.0f) * kscale; scr[kk * 33 + (lane & 31)] = W[(size_t)(k0 + kk) * N + n0 + (lane & 31)] * g; }
    LDS_WAIT(); asm volatile("" ::: "memory");
    const int c = lane & 7;
#pragma unroll
    for (int j = 0; j < 4; ++j) { const int n = (lane >> 3) + 8 * j; const LAS float* s = scr + (8 * c) * 33 + n;
        v4u o; o.x = pk2(s[0 * 33], s[1 * 33]); o.y = pk2(s[2 * 33], s[3 * 33]); o.z = pk2(s[4 * 33], s[5 * 33]); o.w = pk2(s[6 * 33], s[7 * 33]);
        *(v4u*)(WT + (size_t)(rowbase + n) * K + k0 + 8 * c) = o; }
    LDS_WAIT(); asm volatile("" ::: "memory");
}

struct Args {
    const float* in[20]; float* out; unsigned char* ws; int ph_lo, ph_hi;
};
enum { I_XP = 0, I_XS, I_F1N, I_F1G, I_F1U, I_F1D, I_MIXN, I_WIN, I_QN, I_KN, I_RPB, I_CW, I_AON, I_CON, I_WOUT, I_F2N, I_F2G, I_F2U, I_F2D, I_FINN };

__device__ __forceinline__ void p0_prologue(const Args& A, LAS unsigned char* lds, int gw, int NGW, int wave, int lane) {
    unsigned char* ws = A.ws;
    LAS float* scr = (LAS float*)(lds + wave * 16384);
    constexpr int I_G = (D / 64) * (FF / 32), I_DN = (FF / 64) * (D / 32), I_IN = (D / 64) * (DIN / 32), I_OUT = (D / 64) * (D / 32);
    constexpr int NITEMS = 2 * (2 * I_G + I_DN) + I_IN + I_OUT;
    for (int it = gw; it < NITEMS; it += NGW) {
        int r = it;
        if (r < I_G) { p0_transpose_item(A.in[I_F1G], D, FF, (bf16*)(ws + WS_W1GU), nullptr, 1, scr, r, lane); continue; } r -= I_G;
        if (r < I_G) { p0_transpose_item(A.in[I_F1U], D, FF, (bf16*)(ws + WS_W1GU), nullptr, 2, scr, r, lane); continue; } r -= I_G;
        if (r < I_DN) { p0_transpose_item(A.in[I_F1D], FF, D, (bf16*)(ws + WS_W1D), nullptr, 3, scr, r, lane); continue; } r -= I_DN;
        if (r < I_G) { p0_transpose_item(A.in[I_F2G], D, FF, (bf16*)(ws + WS_W2GU), A.in[I_F2N], 1, scr, r, lane); continue; } r -= I_G;
        if (r < I_G) { p0_transpose_item(A.in[I_F2U], D, FF, (bf16*)(ws + WS_W2GU), A.in[I_F2N], 2, scr, r, lane); continue; } r -= I_G;
        if (r < I_DN) { p0_transpose_item(A.in[I_F2D], FF, D, (bf16*)(ws + WS_W2D), nullptr, 3, scr, r, lane); continue; } r -= I_DN;
        if (r < I_IN) { p0_transpose_item(A.in[I_WIN], D, DIN, (bf16*)(ws + WS_WIN), A.in[I_MIXN], 4, scr, r, lane); continue; } r -= I_IN;
        p0_transpose_item(A.in[I_WOUT], D, D, (bf16*)(ws + WS_WOUT), nullptr, 3, scr, r, lane);
    }
    const f32x4* gp = (const f32x4*)A.in[I_F1N] + lane;
    f32x4 gv[4];
#pragma unroll
    for (int j = 0; j < 4; ++j) gv[j] = gp[64 * j];
    bf16* XN = (bf16*)(ws + WS_XB);
    for (int m = gw; m < M_TOK; m += 2 * NGW) {
        const int m2 = m + NGW;
        const float* xrow = (m < MP) ? A.in[I_XP] + (size_t)m * D : A.in[I_XS] + (size_t)(m - MP) * D;
        const float* xrow2 = (m2 < MP) ? A.in[I_XP] + (size_t)m2 * D : A.in[I_XS] + (size_t)(m2 - MP) * D;
        const f32x4* xr = (const f32x4*)xrow + lane; const f32x4* xr2 = (const f32x4*)xrow2 + lane; f32x4 v[4], v2[4]; float s = 0.f, s2 = 0.f;
#pragma unroll
        for (int j = 0; j < 4; ++j) { v[j] = xr[64 * j]; v2[j] = xr2[64 * j]; }
#pragma unroll
        for (int j = 0; j < 4; ++j) { s += (v[j].x * v[j].x + v[j].y * v[j].y) + (v[j].z * v[j].z + v[j].w * v[j].w); s2 += (v2[j].x * v2[j].x + v2[j].y * v2[j].y) + (v2[j].z * v2[j].z + v2[j].w * v2[j].w); }
        const float rstd = __builtin_amdgcn_rsqf(wave_sum(s) * (1.0f / D) + EPSF), rstd2 = __builtin_amdgcn_rsqf(wave_sum(s2) * (1.0f / D) + EPSF);
        unsigned long long* o8 = (unsigned long long*)(XN + (size_t)m * D) + lane; unsigned long long* o82 = (unsigned long long*)(XN + (size_t)m2 * D) + lane;
        if (lane == 0) { float* rs0 = (float*)(ws + WS_RS0); rs0[m] = rstd; rs0[m2] = rstd2; }
#pragma unroll
        for (int j = 0; j < 4; ++j) { const f32x4 y = v[j] * rstd * gv[j]; o8[64 * j] = (unsigned long long)pk2(y.x, y.y) | ((unsigned long long)pk2(y.z, y.w) << 32);
            const f32x4 y2 = v2[j] * rstd2 * gv[j]; o82[64 * j] = (unsigned long long)pk2(y2.x, y2.y) | ((unsigned long long)pk2(y2.z, y2.w) << 32); }
    }
}

__device__ __forceinline__ void final_norm_phase(const Args& A, int gw, int NGW, int lane) {
    const float* gp = A.in[I_FINN] + 8 * lane;
    const f32x4 g0 = *(const f32x4*)(gp), g1 = *(const f32x4*)(gp + 4), g2 = *(const f32x4*)(gp + 512), g3 = *(const f32x4*)(gp + 516);
    const bf16* XB = (const bf16*)(A.ws + WS_XB);
    for (int m = gw; m < M_TOK; m += 4 * NGW) {
        v4u a[4], b[4];
#pragma unroll
        for (int i = 0; i < 4; ++i) { const bf16* xr = XB + (size_t)(m + i * NGW) * D + 8 * lane; a[i] = *(const v4u*)(xr); b[i] = *(const v4u*)(xr + 512); }
#pragma unroll
        for (int i = 0; i < 4; ++i) {
            const f32x4 v0 = (f32x4){bflo(a[i].x), bfhi(a[i].x), bflo(a[i].y), bfhi(a[i].y)}, v1 = (f32x4){bflo(a[i].z), bfhi(a[i].z), bflo(a[i].w), bfhi(a[i].w)};
            const f32x4 v2 = (f32x4){bflo(b[i].x), bfhi(b[i].x), bflo(b[i].y), bfhi(b[i].y)}, v3 = (f32x4){bflo(b[i].z), bfhi(b[i].z), bflo(b[i].w), bfhi(b[i].w)};
            const float s = (v0.x * v0.x + v0.y * v0.y) + (v0.z * v0.z + v0.w * v0.w) + (v1.x * v1.x + v1.y * v1.y) + (v1.z * v1.z + v1.w * v1.w)
                          + (v2.x * v2.x + v2.y * v2.y) + (v2.z * v2.z + v2.w * v2.w) + (v3.x * v3.x + v3.y * v3.y) + (v3.z * v3.z + v3.w * v3.w);
            const float rstd = __builtin_amdgcn_rsqf(wave_sum(s) * (1.0f / D) + EPSF);
            float* o = A.out + (size_t)(m + i * NGW) * D + 8 * lane;
            *(f32x4*)(o) = v0 * rstd * g0; *(f32x4*)(o + 4) = v1 * rstd * g1; *(f32x4*)(o + 512) = v2 * rstd * g2; *(f32x4*)(o + 516) = v3 * rstd * g3;
        }
    }
}

constexpr int RPB_OFF = 256, RPB_N = 8 * 15 * 31;
__device__ __forceinline__ void attn_finish(f32x4 (&o)[4], float sum, const float* aogp  , bf16* op) {
    const float il = __builtin_amdgcn_rcpf(sum); float q2 = 0.f;
#pragma unroll
    for (int mt = 0; mt < 4; ++mt) { o[mt] = o[mt] * il; q2 += (o[mt][0] * o[mt][0] + o[mt][1] * o[mt][1]) + (o[mt][2] * o[mt][2] + o[mt][3] * o[mt][3]); }
    q2 += __shfl_xor(q2, 16); q2 += __shfl_xor(q2, 32);
    const float rn = __builtin_amdgcn_rsqf(q2 * (1.0f / 64.0f) + EPSF);
#pragma unroll
    for (int mt = 0; mt < 4; ++mt) { const f32x4 y = o[mt] * rn * *(const f32x4*)(aogp + 16 * mt); v2u w; w.x = pg8::cvt_pk_bf16(y[0], y[1]); w.y = pg8::cvt_pk_bf16(y[2], y[3]); *(v2u*)(op + 16 * mt) = w; }
}
template <int STEP>
__device__ __forceinline__ void attn_quad(const bf16* ZQ, const bf16* ZK, const bf16* VT, bf16* AC, const LAS float* rpbL, const float* aogp,
                                          int seqbase, int S, int rA, int rs0, int h, int qc, int l, int g) {
    constexpr int NU = 8 + 3 * STEP;
    const int w0 = (qc == 0) ? 0 : (qc == 1) ? 8 : (qc == 2) ? 24 : 32;
    const int c = 16 * qc + l; int cs = c - 8; cs = cs < 0 ? 0 : cs; cs = cs > 48 ? 48 : cs;
    const size_t qtok0 = (size_t)seqbase + rA * 64 + c;
    bf16x8 qf[4][2];
#pragma unroll
    for (int i = 0; i < 4; ++i)
#pragma unroll
        for (int ks = 0; ks < 2; ++ks) qf[i][ks] = *(const bf16x8*)(ZQ + (qtok0 + 64 * i) * 512 + h * 64 + ks * 32 + 8 * g);
    const bf16* kp = ZK + ((size_t)seqbase + rs0 * 64 + w0 + 8 * (l >> 2) + (l & 3)) * 512 + h * 64 + 8 * g;
    const bf16* vp = VT + (size_t)seqbase * 512 + (size_t)(h * 64 + l) * S + rs0 * 64 + w0 + 8 * g;
    const int kc0 = w0 + 8 * g;
    bool valid[2][4];
#pragma unroll
    for (int hf = 0; hf < 2; ++hf)
#pragma unroll
        for (int j = 0; j < 4; ++j) valid[hf][j] = (unsigned)(kc0 + 4 * hf + j - cs) < 16u;
    const LAS float* bp0 = rpbL + h * 465 + (rs0 - rA + 7) * 31 + (kc0 - c + 15);
    f32x4 o[4][4]; float sum[4];
#pragma unroll
    for (int i = 0; i < 4; ++i) { sum[i] = 0.f;
#pragma unroll
        for (int mt = 0; mt < 4; ++mt) o[i][mt] = (f32x4){0.f, 0.f, 0.f, 0.f}; }
    bf16x8 kn[2][2]; v4u vn[4];
#pragma unroll
    for (int hf = 0; hf < 2; ++hf) { const bf16* kt = kp + (size_t)(hf * 4) * 512; kn[hf][0] = *(const bf16x8*)(kt); kn[hf][1] = *(const bf16x8*)(kt + 32); }
#pragma unroll
    for (int mt = 0; mt < 4; ++mt) vn[mt] = *(const v4u*)(vp + (size_t)(16 * mt) * S);
#pragma unroll 1
    for (int u = 0; u < NU; ++u) {
        bf16x8 kf[2][2]; v4u vf[4];
#pragma unroll
        for (int hf = 0; hf < 2; ++hf) { kf[hf][0] = kn[hf][0]; kf[hf][1] = kn[hf][1]; }
#pragma unroll
        for (int mt = 0; mt < 4; ++mt) vf[mt] = vn[mt];
        if (u + 1 < NU) {
#pragma unroll
            for (int hf = 0; hf < 2; ++hf) { const bf16* kt = kp + (size_t)((u + 1) * 64 + hf * 4) * 512; kn[hf][0] = *(const bf16x8*)(kt); kn[hf][1] = *(const bf16x8*)(kt + 32); }
#pragma unroll
            for (int mt = 0; mt < 4; ++mt) vn[mt] = *(const v4u*)(vp + (size_t)(16 * mt) * S + (u + 1) * 64);
        }
#pragma unroll
        for (int i = 0; i < 4; ++i) {
            if ((unsigned)(u - i * STEP) < 8u) {
                f32x4 s0 = {0.f, 0.f, 0.f, 0.f}, s1 = {0.f, 0.f, 0.f, 0.f};
                s0 = __builtin_amdgcn_mfma_f32_16x16x32_bf16(kf[0][0], qf[i][0], s0, 0, 0, 0); s0 = __builtin_amdgcn_mfma_f32_16x16x32_bf16(kf[0][1], qf[i][1], s0, 0, 0, 0);
                s1 = __builtin_amdgcn_mfma_f32_16x16x32_bf16(kf[1][0], qf[i][0], s1, 0, 0, 0); s1 = __builtin_amdgcn_mfma_f32_16x16x32_bf16(kf[1][1], qf[i][1], s1, 0, 0, 0);
                const LAS float* bp = bp0 + (u - i) * 31;
                float p0[4], p1[4];
#pragma unroll
                for (int j = 0; j < 4; ++j) { p0[j] = valid[0][j] ? __builtin_amdgcn_exp2f(s0[j] + bp[j]) : 0.f; p1[j] = valid[1][j] ? __builtin_amdgcn_exp2f(s1[j] + bp[4 + j]) : 0.f; }
                sum[i] += ((p0[0] + p0[1]) + (p0[2] + p0[3])) + ((p1[0] + p1[1]) + (p1[2] + p1[3]));
                v4u pw; pw.x = pg8::cvt_pk_bf16(p0[0], p0[1]); pw.y = pg8::cvt_pk_bf16(p0[2], p0[3]); pw.z = pg8::cvt_pk_bf16(p1[0], p1[1]); pw.w = pg8::cvt_pk_bf16(p1[2], p1[3]);
                const bf16x8 pf = __builtin_bit_cast(bf16x8, pw);
#pragma unroll
                for (int mt = 0; mt < 4; ++mt) o[i][mt] = __builtin_amdgcn_mfma_f32_16x16x32_bf16(__builtin_bit_cast(bf16x8, vf[mt]), pf, o[i][mt], 0, 0, 0);
            }
        }
    }
#pragma unroll
    for (int i = 0; i < 4; ++i) {
        float sm = sum[i]; sm += __shfl_xor(sm, 16); sm += __shfl_xor(sm, 32);
        attn_finish(o[i], sm, aogp, AC + (qtok0 + 64 * i) * 1024 + h * 64 + 4 * g);
    }
}

__device__ __forceinline__ void attn_conv_phase(const Args& A, LAS unsigned char* lds, int wave, int lane) {
    unsigned char* ws = A.ws;
    const bf16* ZQ = (const bf16*)(ws + WS_ZQ); const bf16* ZK = (const bf16*)(ws + WS_ZK); const bf16* VT = (const bf16*)(ws + WS_VT); const bf16* ZC = (const bf16*)(ws + WS_ZC);
    bf16* AC = (bf16*)(ws + WS_AC);
    LAS float* rpbL = (LAS float*)(lds + RPB_OFF);
    float cb;
    { const float mq = fabsf(A.in[I_QN][lane]), mk = fabsf(A.in[I_KN][lane]); float mqw = mq, mkw = mk, mb = 0.f;
      for (int i = lane; i < RPB_N; i += 64) mb = fmaxf(mb, fabsf(A.in[I_RPB][i]));
#pragma unroll
      for (int o_ = 1; o_ < 64; o_ <<= 1) { mqw = fmaxf(mqw, __shfl_xor(mqw, o_)); mkw = fmaxf(mkw, __shfl_xor(mkw, o_)); mb = fmaxf(mb, __shfl_xor(mb, o_)); }
      cb = 11.5416f * 1.01f * mqw * mkw + 1.4426950408889634f * mb; }
    for (int i = wave * 64 + lane; i < RPB_N; i += NWAVES * 64) rpbL[i] = A.in[I_RPB][i] * 1.4426950408889634f - cb;
    __syncthreads();
    const int l = lane & 15, g = lane >> 4;
#if PROBE_DUP == 44
#pragma unroll 1
    for (int rep_ = 0; rep_ < 2; ++rep_)
#endif
    const int G_ = (int)gridDim.x, vcu_ = (G_ % 8 == 0) ? ((int)blockIdx.x % 8) * (G_ / 8) + (int)blockIdx.x / 8 : (int)blockIdx.x;
    for (int ui_ = 0; ui_ < 5; ++ui_) {
        const int unit = (G_ == 256) ? 32 * (5 * (vcu_ >> 5) + (4 - ui_)) + (vcu_ & 31) : vcu_ + ui_ * G_;
        if (unit >= 1280) break;
        const int quad = unit >> 2, hq = unit & 3;
        int seqbase, rA, S, rows;
        if (quad < 256) { seqbase = (quad >> 3) * 2048; rA = 4 * (quad & 7); S = 2048; rows = 32; }
        else { const int q2 = quad - 256; seqbase = MP + (q2 >> 4) * 4096; rA = 4 * (q2 & 15); S = 4096; rows = 64; }
        int rs0 = rA - 4; rs0 = rs0 < 0 ? 0 : rs0; rs0 = rs0 > rows - 8 ? rows - 8 : rs0;
        int rs1 = rA - 3; rs1 = rs1 < 0 ? 0 : rs1; rs1 = rs1 > rows - 8 ? rows - 8 : rs1;
        const int h = 2 * hq + (wave & 1), qc = wave >> 1;
        const float* aogp = A.in[I_AON] + h * 64 + 4 * g;
        if (rs1 != rs0) attn_quad<1>(ZQ, ZK, VT, AC, rpbL, aogp, seqbase, S, rA, rs0, h, qc, l, g);
        else attn_quad<0>(ZQ, ZK, VT, AC, rpbL, aogp, seqbase, S, rA, rs0, h, qc, l, g);
        const int r = rA + hq;
        {
            const int ch = 8 * lane; const float* cw = A.in[I_CW];
            f32x4 w0a = *(const f32x4*)(cw + ch), w0b = *(const f32x4*)(cw + ch + 4), w1a = *(const f32x4*)(cw + 512 + ch), w1b = *(const f32x4*)(cw + 512 + ch + 4);
            f32x4 w2a = *(const f32x4*)(cw + 1024 + ch), w2b = *(const f32x4*)(cw + 1024 + ch + 4);
            f32x4 cga = *(const f32x4*)(A.in[I_CON] + ch), cgb = *(const f32x4*)(A.in[I_CON] + ch + 4);
            const int t0 = r * 64 + 8 * wave;
            f32x4 upa, upb, uca, ucb, una, unb;
#define LOAD_U(tt, ua, ub) do { const int t_ = (tt); if (t_ >= 0 && t_ < S) { const v4u x_ = *(const v4u*)(ZC + ((size_t)seqbase + t_) * 1024 + 512 + ch); \
                ua = (f32x4){bflo(x_.x), bfhi(x_.x), bflo(x_.y), bfhi(x_.y)}; ub = (f32x4){bflo(x_.z), bfhi(x_.z), bflo(x_.w), bfhi(x_.w)}; } \
                else { ua = (f32x4){0.f, 0.f, 0.f, 0.f}; ub = ua; } } while (0)
            LOAD_U(t0 - 1, upa, upb); LOAD_U(t0, uca, ucb);
#pragma unroll 2
            for (int i = 0; i < 8; ++i) {
                const int t = t0 + i;
                LOAD_U(t + 1, una, unb);
                const v4u b_ = *(const v4u*)(ZC + ((size_t)seqbase + t) * 1024 + ch);
                const f32x4 gba = (f32x4){bflo(b_.x), bfhi(b_.x), bflo(b_.y), bfhi(b_.y)}, gbb = (f32x4){bflo(b_.z), bfhi(b_.z), bflo(b_.w), bfhi(b_.w)};
                const f32x4 ya = gba * (upa * w0a + uca * w1a + una * w2a), yb = gbb * (upb * w0b + ucb * w1b + unb * w2b);
                float q2 = (ya[0] * ya[0] + ya[1] * ya[1]) + (ya[2] * ya[2] + ya[3] * ya[3]) + (yb[0] * yb[0] + yb[1] * yb[1]) + (yb[2] * yb[2] + yb[3] * yb[3]);
                q2 += __shfl_xor(q2, 1); q2 += __shfl_xor(q2, 2); q2 += __shfl_xor(q2, 4);
                const float rn = __builtin_amdgcn_rsqf(q2 * (1.0f / 64.0f) + EPSF);
                const f32x4 oa = ya * rn * cga, ob = yb * rn * cgb;
                v4u w; w.x = pg8::cvt_pk_bf16(oa[0], oa[1]); w.y = pg8::cvt_pk_bf16(oa[2], oa[3]); w.z = pg8::cvt_pk_bf16(ob[0], ob[1]); w.w = pg8::cvt_pk_bf16(ob[2], ob[3]);
                *(v4u*)(AC + ((size_t)seqbase + t) * 1024 + 512 + ch) = w;
                upa = uca; upb = ucb; uca = una; ucb = unb;
            }
#undef LOAD_U
        }
    }
    __syncthreads();
}

typedef GAS unsigned gu32;
#define XB_TMO      128
#define XB_XCNT(j)  (256  + 64 * (j))
#define XB_XSUB(j)  (1280 + 64 * (j))
#define XB_XGEN(j)  (2304 + 64 * (j))
#define XB_TOP      3328
#define XB_TOPGEN   3392
#define XCD_BAR_WORDS 3456
#define XB_SPIN_CAP (1u << 18)

__device__ __forceinline__ unsigned xb_ld(unsigned* p)              { return __hip_atomic_load(p, __ATOMIC_RELAXED, __HIP_MEMORY_SCOPE_AGENT); }
__device__ __forceinline__ unsigned xb_add(unsigned* p, unsigned v) { return __hip_atomic_fetch_add(p, v, __ATOMIC_RELAXED, __HIP_MEMORY_SCOPE_AGENT); }
__device__ __forceinline__ unsigned xb_xcc_id() { return (unsigned)__builtin_amdgcn_s_getreg((3 << 11) | 20) & 0xFu; }
#define XB_SPIN(cond, bar) do { unsigned _sp = 0; while (cond) { __builtin_amdgcn_s_sleep(1); \
    if ((++_sp & 255u) == 0u) { if (xb_ld(&(bar)[XB_TMO])) break; if (_sp > XB_SPIN_CAP) { atomicAdd(&(bar)[XB_TMO], 1u); break; } } } } while (0)

struct XcdBarrier {
    unsigned* bar; unsigned x;
    volatile LAS unsigned* st;
};

__device__ __forceinline__ XcdBarrier xcd_barrier_post(unsigned* bar, volatile LAS unsigned* st, bool t0) {
    XcdBarrier b; b.bar = bar; b.x = xb_xcc_id(); b.st = st;
    if (t0) (void)xb_add(&bar[XB_XCNT(b.x)], 1u);
    return b;
}
__device__ __forceinline__ void xcd_barrier_complete(unsigned* bar, unsigned x, unsigned& nloc, unsigned& nx) {
    const unsigned G = gridDim.x * gridDim.y * gridDim.z;
    unsigned sum, cnt, mine, sp = 0u;
    for (;;) {
        sum = 0u; cnt = 0u; mine = 0u;
#pragma unroll
        for (unsigned j = 0; j < 16; ++j) { const unsigned c = xb_ld(&bar[XB_XCNT(j)]); sum += c; cnt += (c > 0u) ? 1u : 0u; mine = (j == x) ? c : mine; }
        if (sum == G) break;
        __builtin_amdgcn_s_sleep(1);
        if ((++sp & 255u) == 0u) { if (xb_ld(&bar[XB_TMO])) break; if (sp > XB_SPIN_CAP) { atomicAdd(&bar[XB_TMO], 1u); break; } }
    }
    nloc = mine > 0u ? mine : 1u; nx = cnt > 0u ? cnt : 1u;
}

__device__ __forceinline__ void xcd_barrier(const XcdBarrier& b, bool t0) {
    asm volatile("s_waitcnt vmcnt(0)" ::: "memory");
    __syncthreads();
    if (t0) {
        unsigned* bar = b.bar;
        __builtin_amdgcn_s_waitcnt(0);
        unsigned nloc = b.st[0], nx = b.st[1];
        if (nloc == 0u) { xcd_barrier_complete(bar, b.x, nloc, nx); b.st[0] = nloc; b.st[1] = nx; }
        const unsigned old = xb_add(&bar[XB_XSUB(b.x)], 1u);
        const unsigned gen = old / nloc;
        if (old + 1u == (gen + 1u) * nloc) {
            __builtin_amdgcn_fence(__ATOMIC_RELEASE, "agent");
            asm volatile("s_waitcnt vmcnt(0)" ::: "memory");
            const unsigned og = xb_add(&bar[XB_TOP], 1u);
            const unsigned tg = og / nx;
            if (og + 1u == (tg + 1u) * nx) xb_add(&bar[XB_TOPGEN], 1u);
            else XB_SPIN(xb_ld(&bar[XB_TOPGEN]) == tg, bar);
            __builtin_amdgcn_fence(__ATOMIC_ACQUIRE, "agent");
            xb_add(&bar[XB_XGEN(b.x)], 1u);
            asm volatile("s_waitcnt vmcnt(0)" ::: "memory");
        } else {
            XB_SPIN(xb_ld(&bar[XB_XGEN(b.x)]) == gen, bar);
            __builtin_amdgcn_fence(__ATOMIC_ACQUIRE, "agent");
            asm volatile("s_waitcnt vmcnt(0)" ::: "memory");
        }
    }
    __syncthreads();
}

#ifndef PROBE_DUP
#define PROBE_DUP -1
#endif
__global__ void __launch_bounds__(NWAVES * 64, 2) enc_fwd(Args args) {
    extern __shared__ __attribute__((aligned(16))) unsigned char lds_raw[];
    LAS unsigned char* lds = (LAS unsigned char*)lds_raw;
    cg::grid_group grid = cg::this_grid();
    const int G = gridDim.x; const int bx = blockIdx.x;
    const int vcu = (G % 8 == 0) ? (bx % 8) * (G / 8) + bx / 8 : bx;
    const int NGW = G * NWAVES;
    const int wave = __builtin_amdgcn_readfirstlane((int)threadIdx.x >> 6);
#define FRESH_IDS() int lane_ = (int)__builtin_amdgcn_mbcnt_hi(~0u, __builtin_amdgcn_mbcnt_lo(~0u, 0u)); asm volatile("" : "+v"(lane_)); const int lane = lane_, gw = vcu * NWAVES + wave; (void)gw; (void)lane
    unsigned char* ws = args.ws;
    const int lo = args.ph_lo, hi = args.ph_hi;
#define IN(k) (lo <= (k) && (k) < hi)
    volatile LAS unsigned* MISC = (volatile LAS unsigned*)(lds + RING_BYTES + 1024);
    const bool t0 = (wave == 0) && ((int)__builtin_amdgcn_mbcnt_hi(~0u, __builtin_amdgcn_mbcnt_lo(~0u, 0u)) == 0);
    if (t0) { MISC[0] = 0u; MISC[1] = 0u; }
    __syncthreads();
    XcdBarrier xbar = xcd_barrier_post((unsigned*)(ws + WS_CTL) + 1024, MISC, t0 && (hi - lo) > 1);
#define SEAM(k) do { if (IN(k) && IN((k) + 1)) { if ((k) == 0) grid.sync(); else xcd_barrier(xbar, (wave == 0) && ((int)__builtin_amdgcn_mbcnt_hi(~0u, __builtin_amdgcn_mbcnt_lo(~0u, 0u)) == 0)); } } while (0)
    bf16* XB = (bf16*)(ws + WS_XB); bf16* ACT = (bf16*)(ws + WS_ACT); bf16* ACB = (bf16*)(ws + WS_AC);
    float* SS1 = (float*)(ws + WS_SS1); float* SS2 = (float*)(ws + WS_SS2);

    if (IN(0)) { FRESH_IDS(); p0_prologue(args, lds, gw, NGW, wave, lane); __syncthreads(); }
#if PROBE_DUP == 0
    if (IN(0)) { FRESH_IDS(); p0_prologue(args, lds, gw, NGW, wave, lane); __syncthreads(); }
#endif
    SEAM(0);
    if (IN(1)) { pg8::Gemm g{XB, (const bf16*)(ws + WS_W1GU), M_TOK, NGU, D, wave}; pg8::StaticOrder S; S.init(M_TOK, NGU, G, bx);
        pg8::EpiSwiGLU<false> E{ACT, FF, nullptr};
        pg8::gemm_phase<pg8::EpiSwiGLU<false>, pg8::StaticOrder, true, true>(lds, g, S, E); }
#if PROBE_DUP == 1
    if (IN(1)) { pg8::Gemm g{XB, (const bf16*)(ws + WS_W1GU), M_TOK, NGU, D, wave}; pg8::StaticOrder S; S.init(M_TOK, NGU, G, bx);
        pg8::EpiSwiGLU<false> E{ACT, FF, nullptr};
        pg8::gemm_phase<pg8::EpiSwiGLU<false>, pg8::StaticOrder, true, true>(lds, g, S, E); }
#endif
    SEAM(1);
    if (IN(2)) { pg8::Gemm g{ACT, (const bf16*)(ws + WS_W1D), M_TOK, D, FF, wave}; pg8::RevOrder S; S.init(M_TOK, D, G, bx);
        pg8::EpiResid<2, true> E{args.in[I_F1N], (const float*)(ws + WS_RS0), XB, SS1, 0.5f};
        pg8::gemm_phase<pg8::EpiResid<2, true>, pg8::RevOrder, true, true>(lds, g, S, E); }
#if PROBE_DUP == 2
    if (IN(2)) { pg8::Gemm g{ACT, (const bf16*)(ws + WS_W1D), M_TOK, D, FF, wave}; pg8::RevOrder S; S.init(M_TOK, D, G, bx);
        pg8::EpiResid<2, true> E{args.in[I_F1N], (const float*)(ws + WS_RS0), XB, SS1, 0.5f};
        pg8::gemm_phase<pg8::EpiResid<2, true>, pg8::RevOrder, true, true>(lds, g, S, E); }
#endif
    SEAM(2);
    if (IN(3)) { pg8::Gemm g{XB, (const bf16*)(ws + WS_WIN), M_TOK, DIN, D, wave}; pg8::StaticOrder S; S.init(M_TOK, DIN, G, bx);
        pg8::EpiWin E{SS1, (bf16*)(ws + WS_ZQ), (bf16*)(ws + WS_ZK), (bf16*)(ws + WS_VT), (bf16*)(ws + WS_ZC), args.in[I_QN], args.in[I_KN]};
        pg8::gemm_phase<pg8::EpiWin, pg8::StaticOrder, true, true>(lds, g, S, E); }
#if PROBE_DUP == 3
    if (IN(3)) { pg8::Gemm g{XB, (const bf16*)(ws + WS_WIN), M_TOK, DIN, D, wave}; pg8::StaticOrder S; S.init(M_TOK, DIN, G, bx);
        pg8::EpiWin E{SS1, (bf16*)(ws + WS_ZQ), (bf16*)(ws + WS_ZK), (bf16*)(ws + WS_VT), (bf16*)(ws + WS_ZC), args.in[I_QN], args.in[I_KN]};
        pg8::gemm_phase<pg8::EpiWin, pg8::StaticOrder, true, true>(lds, g, S, E); }
#endif
    SEAM(3);
    if (IN(4)) { FRESH_IDS(); attn_conv_phase(args, lds, wave, lane); }
#if PROBE_DUP == 4
    if (IN(4)) { FRESH_IDS(); attn_conv_phase(args, lds, wave, lane); }
#endif
    SEAM(4);
    if (IN(5)) { pg8::Gemm g{ACB, (const bf16*)(ws + WS_WOUT), M_TOK, D, D, wave}; pg8::StaticOrder S; S.init(M_TOK, D, G, bx);
        pg8::EpiResid<1, true> E{nullptr, nullptr, XB, SS2, 1.0f};
        pg8::gemm_phase<pg8::EpiResid<1, true>, pg8::StaticOrder, true, true>(lds, g, S, E); } SEAM(5);
    if (IN(6)) { pg8::Gemm g{XB, (const bf16*)(ws + WS_W2GU), M_TOK, NGU, D, wave}; pg8::RevOrder S; S.init(M_TOK, NGU, G, bx);
        pg8::EpiSwiGLU<true> E{ACT, FF, SS2};
        pg8::gemm_phase<pg8::EpiSwiGLU<true>, pg8::RevOrder, true, true>(lds, g, S, E); }
#if PROBE_DUP == 6
    if (IN(6)) { pg8::Gemm g{XB, (const bf16*)(ws + WS_W2GU), M_TOK, NGU, D, wave}; pg8::RevOrder S; S.init(M_TOK, NGU, G, bx);
        pg8::EpiSwiGLU<true> E{ACT, FF, SS2};
        pg8::gemm_phase<pg8::EpiSwiGLU<true>, pg8::RevOrder, true, true>(lds, g, S, E); }
#endif
    SEAM(6);
    if (IN(7)) { pg8::Gemm g{ACT, (const bf16*)(ws + WS_W2D), M_TOK, D, FF, wave}; pg8::StaticOrder S; S.init(M_TOK, D, G, bx);
        pg8::EpiResid<1, false> E{nullptr, nullptr, XB, nullptr, 0.5f};
        pg8::gemm_phase<pg8::EpiResid<1, false>, pg8::StaticOrder, true, true>(lds, g, S, E); } SEAM(7);
    if (IN(8)) { FRESH_IDS(); final_norm_phase(args, gw, NGW, lane); }
#undef IN
#undef SEAM
}

#ifndef MK_N_LAUNCHES
#define MK_N_LAUNCHES 1
#endif
extern "C" void kernel_launch(void* const* d_in, const int* in_sizes, int n_in, void* d_out, int out_size, void* d_ws, size_t ws_size, hipStream_t stream) {
    static int grid = 0;
    if (grid == 0) {
        if (n_in != 20 || in_sizes[0] != MP * D || out_size != M_TOK * D || ws_size < WS_END) { fprintf(stderr, "kernel_launch: unexpected shapes (n_in %d, in0 %d, out %d, ws %zu)\n", n_in, n_in > 0 ? in_sizes[0] : -1, out_size, ws_size); grid = -1; return; }
        int dev = 0, cus = 0, per_cu = 0;
        if (hipGetDevice(&dev) != hipSuccess || hipDeviceGetAttribute(&cus, hipDeviceAttributeMultiprocessorCount, dev) != hipSuccess) { grid = -1; return; }
        if (hipFuncSetAttribute((const void*)enc_fwd, hipFuncAttributeMaxDynamicSharedMemorySize, LDS_BYTES) != hipSuccess) { fprintf(stderr, "kernel_launch: hipFuncSetAttribute failed\n"); grid = -1; return; }
        if (hipOccupancyMaxActiveBlocksPerMultiprocessor(&per_cu, (const void*)enc_fwd, NWAVES * 64, LDS_BYTES) != hipSuccess || per_cu < 1) { fprintf(stderr, "kernel_launch: occupancy query says %d\n", per_cu); per_cu = 1; }
        (void)hipGetLastError();
        if (cus * per_cu < 256) { fprintf(stderr, "kernel_launch: needs 256 co-resident workgroups, device offers %d\n", cus * per_cu); grid = -1; return; }
        grid = 256;
    }
    if (grid < 0) return;
    if (hipMemsetAsync((char*)d_ws + WS_CTL, 0, CTL_ZERO_BYTES, stream) != hipSuccess) { fprintf(stderr, "kernel_launch: memset failed\n"); return; }
    Args a{};
    for (int i = 0; i < 20; ++i) a.in[i] = (const float*)d_in[i];
    a.out = (float*)d_out; a.ws = (unsigned char*)d_ws;
#if MK_N_LAUNCHES == 1
    a.ph_lo = 0; a.ph_hi = 9;
    void* kargs[] = {&a};
    hipError_t e = hipLaunchCooperativeKernel((const void*)enc_fwd, dim3(grid), dim3(NWAVES * 64), kargs, LDS_BYTES, stream);
    if (e != hipSuccess) fprintf(stderr, "kernel_launch: cooperative launch failed: %s (grid %d)\n", hipGetErrorString(e), grid);
#else
    for (int p = 0; p < 9; ++p) {
        a.ph_lo = p; a.ph_hi = p + 1;
        hipLaunchKernelGGL(enc_fwd, dim3(grid), dim3(NWAVES * 64), LDS_BYTES, stream, a);
    }
#endif
}
```
